# Optimizing an MI355X kernel written in HIP

```python
import math
import jax, jax.numpy as jnp
from jax import lax
import numpy as np

D_MODEL = 1024
BATCH = 8
SEQ = 2048
DEPTH = 4

N_MIXERS = 4
RMS_EPS = 1e-6
HEAD_DIM = 64
N_BUCKETS = 32
MAX_DISTANCE = 1024
N_BIAS_HEADS = D_MODEL // HEAD_DIM
POOL_WINDOWS = (2, 4, 8, 16)
N_POOL_GROUPS = len(POOL_WINDOWS)
POOL_GROUP = D_MODEL // N_POOL_GROUPS
DIL_PAIRS = ((128, 1), (512, 4), (2048, 16))
DIL_HEADS = D_MODEL // HEAD_DIM
DIFF_HEADS = D_MODEL // (2 * HEAD_DIM)
Q_BLOCK = 128
GQA_Q_HEADS = D_MODEL // HEAD_DIM
GQA_KV_HEADS = 4
GQA_WINDOW = 128
D_FF = 7 * D_MODEL // 2
N_EXPERTS = 8
TOP_K = 2

kernel_name = "hybrid_interleaved_encoder"


def _rmsnorm(x, g):
    xf = x.astype(jnp.float32)
    y = xf * lax.rsqrt(jnp.mean(xf * xf, axis=-1, keepdims=True) + RMS_EPS)
    return (y * g.astype(jnp.float32)).astype(x.dtype)


def _rel_bucket(rel):
    half = N_BUCKETS // 2
    max_exact = half // 2
    n = jnp.abs(rel)
    big = max_exact + (jnp.log(jnp.maximum(n, 1).astype(jnp.float32) / max_exact)
                       / math.log(MAX_DISTANCE / max_exact) * (half - max_exact)).astype(jnp.int32)
    big = jnp.minimum(big, half - 1)
    return jnp.where(rel > 0, half, 0) + jnp.where(n < max_exact, n, big)


def _block_len(length):
    for c in (64, 32, 16, 8):
        if length % c == 0:
            return c
    return length


def _pool_mixer(h, w_in, w_group, scale, w_out):
    b, s, _ = h.shape
    u = (h @ w_in).reshape(b, s, N_POOL_GROUPS, POOL_GROUP)
    cs = jnp.cumsum(u.astype(jnp.float32), axis=1)
    cs = jnp.concatenate([jnp.zeros_like(cs[:, :1]), cs], axis=1)
    pos = jnp.arange(s)
    pooled = []
    for g, w in enumerate(POOL_WINDOWS):
        lo = jnp.clip(pos - w // 2, 0, s)
        hi = jnp.clip(pos + (w - w // 2), 0, s)
        cnt = (hi - lo).astype(jnp.float32)
        pooled.append((cs[:, hi, g] - cs[:, lo, g]) / cnt[None, :, None])
    pooled = jnp.stack(pooled, axis=2).astype(u.dtype)
    mixed = pooled - u
    y = jnp.einsum('bsgc,gcd->bsgd', mixed, w_group).reshape(b, s, -1) * scale
    return y @ w_out


def _strided_band_attention(q, k, v, dil, half, rel_bias):
    b, s, h, c = q.shape
    L = s // dil
    qb = _block_len(L)
    nb = L // qb
    kb = qb + 2 * half

    def split(t):
        return t.reshape(b, L, dil, h, c).transpose(0, 2, 3, 1, 4)

    qs, ks, vs = split(q), split(k), split(v)
    pad = ((0, 0), (0, 0), (0, 0), (half, half), (0, 0))
    idx = jnp.arange(nb)[:, None] * qb + jnp.arange(kb)[None, :]
    kw = jnp.pad(ks, pad)[:, :, :, idx]
    vw = jnp.pad(vs, pad)[:, :, :, idx]
    qr = qs.reshape(b, dil, h, nb, qb, c)
    logits = jnp.einsum('brhnqc,brhnkc->brhnqk', qr, kw).astype(jnp.float32) * (c ** -0.5)
    rel = jnp.arange(kb)[None, :] - half - jnp.arange(qb)[:, None]
    kpos = idx - half
    valid = (jnp.abs(rel) <= half)[None] & ((kpos >= 0) & (kpos < L))[:, None, :]
    bias = rel_bias[_rel_bucket(rel * dil)].astype(jnp.float32).transpose(2, 0, 1)
    logits = jnp.where(valid, logits + bias[:, None], -jnp.inf)
    lse = jax.nn.logsumexp(logits, axis=-1)
    p = jnp.exp(logits - lse[..., None]).astype(v.dtype)
    o = jnp.einsum('brhnqk,brhnkc->brhnqc', p, vw)
    o = o.reshape(b, dil, h, L, c).transpose(0, 3, 1, 2, 4).reshape(b, s, h, c)
    lse = lse.reshape(b, dil, h, L).transpose(0, 3, 1, 2).reshape(b, s, h)
    return o, lse


def _dilated_mixer(hn, w_in, w_out, rel_bias):
    b, s, _ = hn.shape
    n_groups = len(DIL_PAIRS)
    qkv = (hn @ w_in).reshape(b, s, n_groups, 3, DIL_HEADS, HEAD_DIM)
    outs, lses = [], []
    for g, (win, dil) in enumerate(DIL_PAIRS):
        o, lse = _strided_band_attention(qkv[:, :, g, 0], qkv[:, :, g, 1], qkv[:, :, g, 2],
                                         dil, win // (2 * dil), rel_bias)
        outs.append(o)
        lses.append(lse)
    wts = jax.nn.softmax(jnp.stack(lses, axis=0), axis=0)
    o = jnp.sum(jnp.stack(outs, axis=0) * wts[..., None].astype(hn.dtype), axis=0)
    return o.reshape(b, s, -1) @ w_out


def _diff_mixer(hn, w_in, lam_vecs, subln, w_out, rel_bias, layer):
    b, s, d = hn.shape
    qkv = hn @ w_in
    q = qkv[..., :d].reshape(b, s, DIFF_HEADS, 2, HEAD_DIM)
    k = qkv[..., d:2 * d].reshape(b, s, DIFF_HEADS, 2, HEAD_DIM)
    v = qkv[..., 2 * d:].reshape(b, s, DIFF_HEADS, 2 * HEAD_DIM)
    lam_init = 0.8 - 0.6 * math.exp(-0.3 * layer)
    lv = lam_vecs.astype(jnp.float32)
    lam = jnp.exp(jnp.sum(lv[0] * lv[1])) - jnp.exp(jnp.sum(lv[2] * lv[3])) + lam_init
    scale = HEAD_DIM ** -0.5
    nq = s // Q_BLOCK
    qblocks = jnp.moveaxis(q.reshape(b, nq, Q_BLOCK, DIFF_HEADS, 2, HEAD_DIM), 1, 0)
    kpos = jnp.arange(s)

    def one_block(args):
        qblk, n = args
        rel = kpos[None, :] - (n * Q_BLOCK + jnp.arange(Q_BLOCK))[:, None]
        bias = rel_bias[_rel_bucket(rel)].astype(jnp.float32)
        bias = bias.reshape(Q_BLOCK, s, DIFF_HEADS, 2).transpose(2, 3, 0, 1)
        logits = jnp.einsum('bqhjc,bkhjc->bhjqk', qblk, k).astype(jnp.float32) * scale + bias
        p = jax.nn.softmax(logits, axis=-1)
        a = (p[:, :, 0] - lam * p[:, :, 1]).astype(v.dtype)
        return jnp.einsum('bhqk,bkhc->bqhc', a, v)

    o = lax.map(one_block, (qblocks, jnp.arange(nq)))
    o = jnp.moveaxis(o, 0, 1).reshape(b, s, DIFF_HEADS, 2 * HEAD_DIM)
    o = _rmsnorm(o, subln) * (1.0 - lam_init)
    return o.reshape(b, s, d) @ w_out


def _window_mixer(hn, w_in, sink, w_out, rel_bias):
    b, s, _ = hn.shape
    grp = GQA_Q_HEADS // GQA_KV_HEADS
    W = GQA_WINDOW
    nqc = GQA_Q_HEADS * HEAD_DIM
    nkc = GQA_KV_HEADS * HEAD_DIM
    qkv = hn @ w_in
    q = qkv[..., :nqc].reshape(b, s, GQA_KV_HEADS, grp, HEAD_DIM)
    k = qkv[..., nqc:nqc + nkc].reshape(b, s, GQA_KV_HEADS, HEAD_DIM)
    v = qkv[..., nqc + nkc:].reshape(b, s, GQA_KV_HEADS, HEAD_DIM)
    nb = s // W
    kb = 3 * W
    idx = jnp.arange(nb)[:, None] * W + jnp.arange(kb)[None, :]
    pad = ((0, 0), (W, W), (0, 0), (0, 0))
    kw = jnp.pad(k, pad)[:, idx]
    vw = jnp.pad(v, pad)[:, idx]
    qr = q.reshape(b, nb, W, GQA_KV_HEADS, grp, HEAD_DIM)
    logits = jnp.einsum('bnqhgc,bnjhc->bnhgqj', qr, kw).astype(jnp.float32) * (HEAD_DIM ** -0.5)
    rel = jnp.arange(kb)[None, :] - W - jnp.arange(W)[:, None]
    kpos = idx - W
    valid = (jnp.abs(rel) <= W)[None] & ((kpos >= 0) & (kpos < s))[:, None, :]
    bias = rel_bias[_rel_bucket(rel)].astype(jnp.float32).transpose(2, 0, 1)
    bias = bias.reshape(GQA_KV_HEADS, grp, W, kb)
    logits = jnp.where(valid[:, None, None], logits + bias, -jnp.inf)
    sk = sink.astype(jnp.float32).reshape(GQA_KV_HEADS, grp)[:, :, None, None]
    m = jnp.maximum(jnp.max(logits, axis=-1, keepdims=True), sk)
    e = jnp.exp(logits - m)
    p = e / (jnp.sum(e, axis=-1, keepdims=True) + jnp.exp(sk - m))
    o = jnp.einsum('bnhgqj,bnjhc->bnqhgc', p.astype(v.dtype), vw)
    return o.reshape(b, s, -1) @ w_out


def _swiglu(h, w_gate_up, w_down):
    gu = h @ w_gate_up
    g, u = gu[..., :D_FF], gu[..., D_FF:]
    return (jax.nn.silu(g) * u) @ w_down


def _moe(h, router, w_gate_up, w_down):
    logits = (h @ router).astype(jnp.float32)
    top_v, top_i = lax.top_k(logits, TOP_K)
    gates = jax.nn.softmax(top_v, axis=-1)
    gate_full = jnp.sum(jax.nn.one_hot(top_i, N_EXPERTS, dtype=jnp.float32) * gates[..., None], axis=-2)
    gate_full = gate_full.astype(h.dtype)
    y = jnp.zeros_like(h)
    for e in range(N_EXPERTS):
        y = y + gate_full[..., e:e + 1] * _swiglu(h, w_gate_up[e], w_down[e])
    return y


def setup_inputs(seed: int = 0) -> dict:
    key = jax.random.key(seed)
    ks = jax.random.split(key, 24)
    f32 = jnp.float32

    def nrm(k, shape, scale):
        return jax.random.normal(k, shape, f32) * scale

    n_a = len(range(0, DEPTH, N_MIXERS))
    n_b = len(range(1, DEPTH, N_MIXERS))
    n_c = len(range(2, DEPTH, N_MIXERS))
    n_d = len(range(3, DEPTH, N_MIXERS))
    n_f = len(range(0, DEPTH, 2))
    n_m = len(range(1, DEPTH, 2))
    D = D_MODEL
    n_dil = len(DIL_PAIRS)
    gqa_cols = (GQA_Q_HEADS + 2 * GQA_KV_HEADS) * HEAD_DIM
    return {
        "x": nrm(ks[0], (BATCH, SEQ, D), 1.0),
        "rel_bias": nrm(ks[1], (N_BUCKETS, N_BIAS_HEADS), 0.5),
        "norm_mix": 1.0 + nrm(ks[2], (DEPTH, D), 0.1),
        "norm_ffn": 1.0 + nrm(ks[3], (DEPTH, D), 0.1),
        "norm_final": 1.0 + nrm(ks[4], (D,), 0.1),
        "a_w_in": nrm(ks[5], (n_a, D, D), D ** -0.5),
        "a_w_group": nrm(ks[6], (n_a, N_POOL_GROUPS, POOL_GROUP, POOL_GROUP), POOL_GROUP ** -0.5),
        "a_scale": 1.0 + nrm(ks[7], (n_a, D), 0.1),
        "a_w_out": nrm(ks[8], (n_a, D, D), D ** -0.5),
        "b_w_in": nrm(ks[9], (n_b, D, n_dil * 3 * DIL_HEADS * HEAD_DIM), D ** -0.5),
        "b_w_out": nrm(ks[10], (n_b, DIL_HEADS * HEAD_DIM, D), (DIL_HEADS * HEAD_DIM) ** -0.5),
        "c_w_in": nrm(ks[11], (n_c, D, 3 * D), D ** -0.5),
        "c_lambda": nrm(ks[12], (n_c, 4, HEAD_DIM), 0.1),
        "c_subln": 1.0 + nrm(ks[13], (n_c, 2 * HEAD_DIM), 0.1),
        "c_w_out": nrm(ks[14], (n_c, D, D), D ** -0.5),
        "d_w_in": nrm(ks[15], (n_d, D, gqa_cols), D ** -0.5),
        "d_sink": nrm(ks[16], (n_d, GQA_Q_HEADS), 1.0),
        "d_w_out": nrm(ks[17], (n_d, GQA_Q_HEADS * HEAD_DIM, D), (GQA_Q_HEADS * HEAD_DIM) ** -0.5),
        "f_w_gate_up": nrm(ks[18], (n_f, D, 2 * D_FF), D ** -0.5),
        "f_w_down": nrm(ks[19], (n_f, D_FF, D), D_FF ** -0.5),
        "m_router": nrm(ks[20], (n_m, D, N_EXPERTS), D ** -0.5),
        "m_w_gate_up": nrm(ks[21], (n_m, N_EXPERTS, D, 2 * D_FF), D ** -0.5),
        "m_w_down": nrm(ks[22], (n_m, N_EXPERTS, D_FF, D), D_FF ** -0.5),
    }


def reference(x, rel_bias, norm_mix, norm_ffn, norm_final,
              a_w_in, a_w_group, a_scale, a_w_out,
              b_w_in, b_w_out,
              c_w_in, c_lambda, c_subln, c_w_out,
              d_w_in, d_sink, d_w_out,
              f_w_gate_up, f_w_down,
              m_router, m_w_gate_up, m_w_down):
    for i in range(DEPTH):
        mixer = i % N_MIXERS
        slot = i // N_MIXERS
        hn = _rmsnorm(x, norm_mix[i])
        if mixer == 0:
            y = _pool_mixer(hn, a_w_in[slot], a_w_group[slot], a_scale[slot], a_w_out[slot])
        elif mixer == 1:
            y = _dilated_mixer(hn, b_w_in[slot], b_w_out[slot], rel_bias)
        elif mixer == 2:
            y = _diff_mixer(hn, c_w_in[slot], c_lambda[slot], c_subln[slot], c_w_out[slot], rel_bias, i)
        else:
            y = _window_mixer(hn, d_w_in[slot], d_sink[slot], d_w_out[slot], rel_bias)
        x = x + y
        hn = _rmsnorm(x, norm_ffn[i])
        if i % 2 == 0:
            y = _swiglu(hn, f_w_gate_up[i // 2], f_w_down[i // 2])
        else:
            y = _moe(hn, m_router[i // 2], m_w_gate_up[i // 2], m_w_down[i // 2])
        x = x + y
    return _rmsnorm(x, norm_final)
```

```cpp
#include <hip/hip_runtime.h>
#include <cstdio>
#include <cstdint>

#ifndef MK_MULTI
#define MK_MULTI 1
#endif

#define LAS __attribute__((address_space(3)))
#define GAS __attribute__((address_space(1)))
typedef unsigned short bf16_t;
typedef short bf16x8 __attribute__((ext_vector_type(8)));
typedef float f32x4 __attribute__((ext_vector_type(4)));
typedef float f32x16 __attribute__((ext_vector_type(16)));
typedef unsigned u32x4 __attribute__((ext_vector_type(4)));
typedef unsigned u32x2 __attribute__((ext_vector_type(2)));

constexpr int NB = 8, SEQ = 2048, DM = 1024, MTOK = NB * SEQ, DFF = 3584, NE = 8;
constexpr int MP_MAX = 2 * MTOK + NE * 256;
constexpr int NPANEL_MAX = MP_MAX / 256;
constexpr float RMS_EPS = 1e-6f;
constexpr float LOG2E = 1.4426950408889634f;
constexpr float QSCALE = 0.125f * LOG2E;
constexpr float NEG_BIG = -1e30f;
constexpr int NWAVES = 8;

constexpr size_t MiB = 1ull << 20;
constexpr size_t WS_CTL = 0, CTL_ZERO_BYTES = 1 * MiB;
constexpr size_t WS_TAB = 1 * MiB;
constexpr size_t WS_MISC = WS_TAB + 256 * 1024;
constexpr size_t WS_ROUTE = 2 * MiB;
constexpr size_t WS_CNT = WS_ROUTE + 384 * 1024;
constexpr size_t WS_PANEL = WS_ROUTE + 448 * 1024;
constexpr size_t WS_W = 4 * MiB;
constexpr size_t W_A_IN = 0, W_A_GRP = W_A_IN + 1048576, W_A_OUT = W_A_GRP + 262144, W_B_QK = W_A_OUT + 1048576, W_B_V = W_B_QK + 6144 * 1024,
                 W_B_OUT = W_B_V + 3072 * 1024, W_C_QK = W_B_OUT + 1048576, W_C_V = W_C_QK + 2048 * 1024, W_C_OUT = W_C_V + 1048576,
                 W_D_QK = W_C_OUT + 1048576, W_D_V = W_D_QK + 1280 * 1024, W_D_OUT = W_D_V + 256 * 1024, W_F_GU = W_D_OUT + 1048576,
                 W_F_D = W_F_GU + 2 * 7168 * 1024, W_M_GU = W_F_D + 2 * 3584 * 1024, W_M_D = W_M_GU + 16ull * 7168 * 1024, W_END = W_M_D + 16ull * 3584 * 1024;
constexpr size_t WS_XA = WS_W + ((W_END * 2 + MiB - 1) / MiB) * MiB;
constexpr size_t WS_XB = WS_XA + 64 * MiB;
constexpr size_t WS_HN = WS_XB + 64 * MiB;
constexpr size_t WS_BUFA = WS_HN + 32 * MiB;
constexpr size_t WS_BUFB = WS_BUFA + 32 * MiB;
constexpr size_t WS_BUFC = WS_BUFB + 32 * MiB;
constexpr size_t WS_BIG = WS_BUFC + 32 * MiB;
constexpr size_t WS_VT = WS_BIG + 240 * MiB;
constexpr size_t WS_OG = WS_VT + 96 * MiB;
constexpr size_t WS_LSE = WS_OG + 96 * MiB;
constexpr size_t WS_END = WS_LSE + 4 * MiB;
constexpr int CW_BAR = 4096;
constexpr int RING_BYTES = 131072, LDSCTL_OFF = RING_BYTES, MISC_OFF = LDSCTL_OFF + 320, LDS_BYTES = 147456;

__device__ __forceinline__ unsigned cvt_pk_bf16(float lo, float hi) { unsigned r; asm volatile("v_cvt_pk_bf16_f32 %0, %1, %2" : "=v"(r) : "v"(lo), "v"(hi)); return r; }
__device__ __forceinline__ float bf_lo(unsigned w) { return __uint_as_float(w << 16); }
__device__ __forceinline__ float bf_hi(unsigned w) { return __uint_as_float(w & 0xffff0000u); }
__device__ __forceinline__ float wave_sum(float v) {
#pragma unroll
    for (int o = 1; o < 64; o <<= 1) v += __shfl_xor(v, o);
    return v;
}
#define LDS_WAIT() asm volatile("s_waitcnt lgkmcnt(0)" ::: "memory")
#define VM_WAIT() asm volatile("s_waitcnt vmcnt(0)" ::: "memory")

namespace pg8 {
constexpr int BM = 256, BK = 64, HALF = 128, HTB = HALF * BK * 2, STAGE_BYTES = 8 * HTB, NXCD = 8, WGM = 8;
__host__ __device__ __forceinline__ int lds_byte(int r, int c) { const int st = (r >> 4) * 2 + (c >> 5), rr = r & 15, cc = c & 31, ob = rr * 64 + cc * 2; return st * 1024 + (ob ^ (((ob >> 9) & 1) << 5)); }
__host__ __device__ __forceinline__ void stage_rc(int b, int& R, int& C) { const int st = b / 1024, sb = b % 1024, swz = sb ^ (((sb >> 9) & 1) << 5); R = (st >> 1) * 16 + swz / 64; C = (st & 1) * 32 + (swz % 64) / 2; }
__host__ __device__ __forceinline__ int perm32(int rho) { const int n = rho >> 4, i = rho & 15; return 8 * (i >> 2) + 4 * n + (i & 3); }

struct Unit { const char* A; const char* B; unsigned ldb, hsb; size_t co; int tag; };

__device__ __forceinline__ void tile_order(int nM, int nN, int L, int& pm, int& pn) {
    const int nwg = nM * nN; int wgid = L;
    { const int q = nwg / NXCD, r = nwg % NXCD, xcd = wgid % NXCD, off = wgid / NXCD; wgid = (xcd < r ? xcd * (q + 1) : r * (q + 1) + (xcd - r) * q) + off; }
    const int nig = WGM * nN, gid = wgid / nig, fm = gid * WGM, gsz = (nM - fm) < WGM ? (nM - fm) : WGM;
    pm = fm + ((wgid % nig) % gsz); pn = (wgid % nig) / gsz;
}

__device__ __forceinline__ void zero_acc(f32x4 (&acc)[2][2][4][2]) {
#pragma unroll
    for (int a = 0; a < 2; ++a)
#pragma unroll
        for (int b = 0; b < 2; ++b)
#pragma unroll
            for (int m = 0; m < 4; ++m)
#pragma unroll
                for (int n = 0; n < 2; ++n) acc[a][b][m][n] = (f32x4){0.f, 0.f, 0.f, 0.f};
}
struct EpiBf16 {
    static constexpr bool PERM = true;
    bf16_t* out0; int ld0; bf16_t* out1; int ld1;
    __device__ __forceinline__ void init(f32x4 (&acc)[2][2][4][2], const Unit&, int, int, int, int) const { zero_acc(acc); }
    __device__ __forceinline__ void operator()(const f32x4 (&acc)[2][2][4][2], const Unit& u, int wr, int wc, int fr, int fq) const {
        bf16_t* base = (u.tag ? out1 : out0) + u.co; const int ldc = u.tag ? ld1 : ld0;
        int r0 = wr * 64 + fr; asm volatile("" : "+v"(r0));
#pragma unroll
        for (int ai = 0; ai < 2; ++ai)
#pragma unroll
            for (int m = 0; m < 4; ++m) { bf16_t* rowp = base + (unsigned)((ai * HALF + m * 16 + r0) * ldc + wc * 32 + 8 * fq);
#pragma unroll
                for (int bj = 0; bj < 2; ++bj) { const f32x4 v0 = acc[ai][bj][m][0], v1 = acc[ai][bj][m][1];
                    u32x4 w; w.x = cvt_pk_bf16(v0[0], v0[1]); w.y = cvt_pk_bf16(v0[2], v0[3]); w.z = cvt_pk_bf16(v1[0], v1[1]); w.w = cvt_pk_bf16(v1[2], v1[3]);
                    *(u32x4*)(rowp + bj * HALF) = w; } }
    }
};
struct EpiSwiglu {
    static constexpr bool PERM = true;
    bf16_t* out; int ldc;
    __device__ __forceinline__ void init(f32x4 (&acc)[2][2][4][2], const Unit&, int, int, int, int) const { zero_acc(acc); }
    __device__ __forceinline__ void operator()(const f32x4 (&acc)[2][2][4][2], const Unit& u, int wr, int wc, int fr, int fq) const {
        bf16_t* base = out + u.co;
        int r0 = wr * 64 + fr; asm volatile("" : "+v"(r0));
#pragma unroll
        for (int ai = 0; ai < 2; ++ai)
#pragma unroll
            for (int m = 0; m < 4; ++m) { bf16_t* rowp = base + (unsigned)((ai * HALF + m * 16 + r0) * ldc + wc * 32 + 8 * fq);
                float r[8];
#pragma unroll
                for (int n = 0; n < 2; ++n)
#pragma unroll
                    for (int j = 0; j < 4; ++j) { const float g = acc[ai][0][m][n][j], up = acc[ai][1][m][n][j];
                        r[n * 4 + j] = g * __builtin_amdgcn_rcpf(1.0f + __builtin_amdgcn_exp2f(-g * LOG2E)) * up; }
                u32x4 w; w.x = cvt_pk_bf16(r[0], r[1]); w.y = cvt_pk_bf16(r[2], r[3]); w.z = cvt_pk_bf16(r[4], r[5]); w.w = cvt_pk_bf16(r[6], r[7]);
                *(u32x4*)rowp = w; }
    }
};
struct EpiResid {
    static constexpr bool PERM = false;
    const float* __restrict__ resid; float* __restrict__ out;
    __device__ __forceinline__ void init(f32x4 (&acc)[2][2][4][2], const Unit& u, int wr, int wc, int fr, int fq) const {
        int r0 = wr * 64 + fr; asm volatile("" : "+v"(r0));
#pragma unroll
        for (int ai = 0; ai < 2; ++ai)
#pragma unroll
            for (int m = 0; m < 4; ++m) { const size_t off = u.co + (unsigned)((ai * HALF + m * 16 + r0) * DM + wc * 32 + 4 * fq);
#pragma unroll
                for (int bj = 0; bj < 2; ++bj)
#pragma unroll
                    for (int n = 0; n < 2; ++n) acc[ai][bj][m][n] = *(const f32x4*)(resid + off + bj * HALF + n * 16); }
    }
    __device__ __forceinline__ void operator()(const f32x4 (&acc)[2][2][4][2], const Unit& u, int wr, int wc, int fr, int fq) const {
        int r0 = wr * 64 + fr; asm volatile("" : "+v"(r0));
#pragma unroll
        for (int ai = 0; ai < 2; ++ai)
#pragma unroll
            for (int m = 0; m < 4; ++m) { const size_t off = u.co + (unsigned)((ai * HALF + m * 16 + r0) * DM + wc * 32 + 4 * fq);
#pragma unroll
                for (int bj = 0; bj < 2; ++bj)
#pragma unroll
                    for (int n = 0; n < 2; ++n) *(f32x4*)(out + off + bj * HALF + n * 16) = acc[ai][bj][m][n]; }
    }
};

template <class Epi, class Sched>
__device__ __forceinline__ void gemm_phase(LAS unsigned char* lds, const int K, const unsigned lda, const Sched& S, const Epi& E) {
    const int tid = threadIdx.x, wid = __builtin_amdgcn_readfirstlane(tid >> 6), lane = tid & 63, wr = wid >> 2, wc = wid & 3, fr = lane & 15, fq = lane >> 4;
    int nt = K / BK; asm volatile("" : "+s"(nt));
    unsigned voffA[2], voffB[2];
#pragma unroll
    for (int i = 0; i < 2; ++i) { int R, C; stage_rc(tid * 16 + i * 8192, R, C); const int Rb = Epi::PERM ? ((R & ~31) + perm32(R & 31)) : R;
        voffA[i] = (unsigned)R * lda + (unsigned)C * 2u; (void)Rb; }
    const size_t kstep = (size_t)(BK * 2);
    const size_t hstepA = (size_t)HALF * lda;
    const unsigned ldsw = (unsigned)wid * 1024u;
    const int aoff = lds_byte(wr * 64 + fr, fq * 8), boff = lds_byte(wc * 32 + fr, fq * 8);
#define PG8_SA(b, h) (((b) * 2 + (h)) * HTB)
#define PG8_SB(b, h) ((4 + (b) * 2 + (h)) * HTB)
#define PG8_STAGE(bufoff, gbase, voff) do { _Pragma("unroll") for (int _i = 0; _i < 2; ++_i) \
        __builtin_amdgcn_global_load_lds((const unsigned*)((const char*)(gbase) + (voff)[_i]), (LAS unsigned*)(lds + (bufoff) + ldsw + _i * 8192), 16, 0, 0); } while (0)
#define PG8_LDA(dst, b, h) do { _Pragma("unroll") for (int m = 0; m < 4; ++m) _Pragma("unroll") for (int k = 0; k < 2; ++k) dst[m][k] = *(const LAS bf16x8*)(lds + PG8_SA(b, h) + aoff + m * 2048 + k * 1024); } while (0)
#define PG8_LDB(dst, b, h) do { _Pragma("unroll") for (int n = 0; n < 2; ++n) _Pragma("unroll") for (int k = 0; k < 2; ++k) dst[n][k] = *(const LAS bf16x8*)(lds + PG8_SB(b, h) + boff + n * 2048 + k * 1024); } while (0)
#define PG8_MMA(ai, bj, At, Bt) do { __builtin_amdgcn_s_setprio(1); _Pragma("unroll") for (int m = 0; m < 4; ++m) _Pragma("unroll") for (int n = 0; n < 2; ++n) _Pragma("unroll") for (int k = 0; k < 2; ++k) \
        acc[ai][bj][m][n] = __builtin_amdgcn_mfma_f32_16x16x32_bf16(Bt[n][k], At[m][k], acc[ai][bj][m][n], 0, 0, 0); __builtin_amdgcn_s_setprio(0); } while (0)
#define PG8_WAIT_V(n) asm volatile("s_waitcnt vmcnt(" #n ")" ::: "memory")
#define PG8_WAIT_L(n) asm volatile("s_waitcnt lgkmcnt(" #n ")" ::: "memory")
#define PG8_BAR __builtin_amdgcn_s_barrier()
#define PG8_SCHED __builtin_amdgcn_sched_barrier(0)
#define PG8_SETB(u) do { _Pragma("unroll") for (int _i = 0; _i < 2; ++_i) { int R_, C_; stage_rc((int)(threadIdx.x) * 16 + _i * 8192, R_, C_); const int Rb_ = Epi::PERM ? ((R_ & ~31) + perm32(R_ & 31)) : R_; \
        voffB[_i] = (unsigned)Rb_ * (u).ldb + (unsigned)C_ * 2u; } hsB = (size_t)(u).hsb; } while (0)
    Unit cur, nxt; int ui = 0;
    if (!S.next(0, cur)) return;
    f32x4 acc[2][2][4][2];
    E.init(acc, cur, wr, wc, fr, fq);
    bf16x8 At[4][2], B0[2][2], B1[2][2];
    const char* cA = cur.A; const char* cB = cur.B; size_t hsB;
    PG8_SETB(cur);
    PG8_STAGE(PG8_SB(0, 0), cB, voffB); PG8_STAGE(PG8_SB(0, 1), cB + hsB, voffB); PG8_STAGE(PG8_SA(0, 0), cA, voffA); PG8_STAGE(PG8_SA(0, 1), cA + hstepA, voffA);
    if (wr == 1) PG8_BAR;
    PG8_WAIT_V(2); PG8_BAR;
    PG8_STAGE(PG8_SB(1, 0), cB + kstep, voffB); PG8_STAGE(PG8_SA(1, 0), cA + kstep, voffA); PG8_STAGE(PG8_SB(1, 1), cB + hsB + kstep, voffB);
    PG8_WAIT_V(6); PG8_BAR;
    for (;;) {
        const bool has_next = S.next(ui + 1, nxt);
        const char* nA = has_next ? nxt.A : cA; const char* nB = has_next ? nxt.B : cB;
        for (int t = 0; t < nt; t += 2) {
            const bool last = (t == nt - 2);
            const char* a1 = cA + (size_t)(t + 1) * kstep;
            const char* a2 = last ? nA : cA + (size_t)(t + 2) * kstep; const char* b2 = last ? nB : cB + (size_t)(t + 2) * kstep;
            const char* a3 = a2 + kstep; const char* b3 = b2 + kstep;
            if (last && has_next) PG8_SETB(nxt);
            PG8_LDB(B0, 0, 0); PG8_LDB(B1, 0, 1); PG8_SCHED; PG8_LDA(At, 0, 0); PG8_STAGE(PG8_SA(1, 1), a1 + hstepA, voffA);
            PG8_WAIT_V(8); PG8_WAIT_L(0); PG8_BAR; PG8_MMA(0, 0, At, B0); PG8_MMA(0, 1, At, B1); PG8_BAR; PG8_SCHED;
            PG8_LDA(At, 0, 1); PG8_STAGE(PG8_SB(0, 0), b2, voffB); PG8_STAGE(PG8_SB(0, 1), b2 + hsB, voffB); PG8_STAGE(PG8_SA(0, 0), a2, voffA);
            PG8_WAIT_V(8); PG8_WAIT_L(0); PG8_BAR; PG8_MMA(1, 0, At, B0); PG8_MMA(1, 1, At, B1); PG8_BAR; PG8_SCHED;
            PG8_LDB(B0, 1, 0); PG8_LDB(B1, 1, 1); PG8_SCHED; PG8_LDA(At, 1, 0); PG8_STAGE(PG8_SA(0, 1), a2 + hstepA, voffA);
            PG8_WAIT_V(8); PG8_WAIT_L(0); PG8_BAR; PG8_MMA(0, 0, At, B0); PG8_MMA(0, 1, At, B1); PG8_BAR; PG8_SCHED;
            PG8_LDA(At, 1, 1); PG8_STAGE(PG8_SB(1, 0), b3, voffB); PG8_STAGE(PG8_SB(1, 1), b3 + hsB, voffB); PG8_STAGE(PG8_SA(1, 0), a3, voffA);
            PG8_WAIT_V(8); PG8_WAIT_L(0); PG8_BAR; PG8_MMA(1, 0, At, B0); PG8_MMA(1, 1, At, B1); PG8_BAR; PG8_SCHED;
        }
        if (wr == 0) PG8_BAR;
        E(acc, cur, wr, wc, fr, fq);
        if (!has_next) break;
        E.init(acc, nxt, wr, wc, fr, fq);
        cur = nxt; cA = nA; cB = nB; ++ui;
        if (wr == 1) PG8_BAR;
    }
    PG8_WAIT_V(0);
    PG8_BAR;
#undef PG8_SA
#undef PG8_SB
#undef PG8_STAGE
#undef PG8_LDA
#undef PG8_LDB
#undef PG8_MMA
#undef PG8_WAIT_V
#undef PG8_WAIT_L
#undef PG8_BAR
#undef PG8_SCHED
#undef PG8_SETB
}
}

#define XB_TMO      128
#define XB_XCNT(j)  (256  + 64 * (j))
#define XB_XSUB(j)  (1280 + 64 * (j))
#define XB_XGEN(j)  (2304 + 64 * (j))
#define XB_TOP      3328
#define XB_TOPGEN   3392
#define XCD_BAR_WORDS 3456
#define XB_SPIN_CAP (1u << 18)
__device__ __forceinline__ unsigned xb_ld(unsigned* p)              { return __hip_atomic_load(p, __ATOMIC_RELAXED, __HIP_MEMORY_SCOPE_AGENT); }
__device__ __forceinline__ unsigned xb_add(unsigned* p, unsigned v) { return __hip_atomic_fetch_add(p, v, __ATOMIC_RELAXED, __HIP_MEMORY_SCOPE_AGENT); }
__device__ __forceinline__ unsigned xb_xcc_id() { return (unsigned)__builtin_amdgcn_s_getreg((3 << 11) | 20) & 0xFu; }
#define XB_SPIN(cond, bar) do { unsigned _sp = 0; while (cond) { __builtin_amdgcn_s_sleep(1); \
    if ((++_sp & 255u) == 0u) { if (xb_ld(&(bar)[XB_TMO])) break; if (_sp > XB_SPIN_CAP) { atomicAdd(&(bar)[XB_TMO], 1u); break; } } } } while (0)
struct XcdBarrier { unsigned* bar; unsigned x; volatile LAS unsigned* st; };
__device__ __forceinline__ XcdBarrier xcd_barrier_post(unsigned* bar, volatile LAS unsigned* st) {
    XcdBarrier b; b.bar = bar; b.x = xb_xcc_id(); b.st = st;
    if (threadIdx.x == 0) (void)xb_add(&bar[XB_XCNT(b.x)], 1u);
    return b;
}
__device__ __forceinline__ void xcd_barrier_complete(unsigned* bar, unsigned x, unsigned& nloc, unsigned& nx) {
    const unsigned G = gridDim.x * gridDim.y * gridDim.z;
    unsigned sum, cnt, mine, sp = 0u;
    for (;;) {
        sum = 0u; cnt = 0u; mine = 0u;
#pragma unroll
        for (unsigned j = 0; j < 16; ++j) { const unsigned c = xb_ld(&bar[XB_XCNT(j)]); sum += c; cnt += (c > 0u) ? 1u : 0u; mine = (j == x) ? c : mine; }
        if (sum == G) break;
        __builtin_amdgcn_s_sleep(1);
        if ((++sp & 255u) == 0u) { if (xb_ld(&bar[XB_TMO])) break; if (sp > XB_SPIN_CAP) { atomicAdd(&bar[XB_TMO], 1u); break; } }
    }
    nloc = mine > 0u ? mine : 1u; nx = cnt > 0u ? cnt : 1u;
}
__device__ __forceinline__ void xcd_barrier(const XcdBarrier& b) {
    asm volatile("s_waitcnt vmcnt(0)" ::: "memory");
    __syncthreads();
    if (threadIdx.x == 0) {
        unsigned* bar = b.bar;
        __builtin_amdgcn_s_waitcnt(0);
        unsigned nloc = b.st[0], nx = b.st[1];
        if (nloc == 0u) { xcd_barrier_complete(bar, b.x, nloc, nx); b.st[0] = nloc; b.st[1] = nx; }
        const unsigned old = xb_add(&bar[XB_XSUB(b.x)], 1u);
        const unsigned gen = old / nloc;
        if (old + 1u == (gen + 1u) * nloc) {
            __builtin_amdgcn_fence(__ATOMIC_RELEASE, "agent");
            asm volatile("s_waitcnt vmcnt(0)" ::: "memory");
            const unsigned og = xb_add(&bar[XB_TOP], 1u);
            const unsigned tg = og / nx;
            if (og + 1u == (tg + 1u) * nx) xb_add(&bar[XB_TOPGEN], 1u);
            else XB_SPIN(xb_ld(&bar[XB_TOPGEN]) == tg, bar);
            __builtin_amdgcn_fence(__ATOMIC_ACQUIRE, "agent");
            xb_add(&bar[XB_XGEN(b.x)], 1u);
            asm volatile("s_waitcnt vmcnt(0)" ::: "memory");
        } else {
            XB_SPIN(xb_ld(&bar[XB_XGEN(b.x)]) == gen, bar);
            __builtin_amdgcn_fence(__ATOMIC_ACQUIRE, "agent");
            asm volatile("s_waitcnt vmcnt(0)" ::: "memory");
        }
    }
    __syncthreads();
}

struct Job { int in, K, ld, col0, ncols, mode, sk, sidx; unsigned long long src, dst; unsigned item0; unsigned pad; };
constexpr int NJOBS = 60;
struct JobTab { Job j[NJOBS]; unsigned nitems; unsigned pad[3]; };
constexpr JobTab make_jobs() {
    JobTab t{}; int n = 0; unsigned it = 0;
    auto add = [&](int in, unsigned long long src, int K, int ld, int col0, int ncols, unsigned long long dst_elem, int mode, int sk, int sidx) {
        Job& q = t.j[n++]; q.in = in; q.K = K; q.ld = ld; q.col0 = col0; q.ncols = ncols; q.mode = mode; q.sk = sk; q.sidx = sidx; q.src = src; q.dst = dst_elem; q.item0 = it; q.pad = 0;
        it += (unsigned)((K / 64) * (ncols / 64)); };
    add(5, 0, 1024, 1024, 0, 1024, W_A_IN, 0, 0, 0);
    for (int g = 0; g < 4; ++g) add(6, (unsigned long long)g * 65536, 256, 256, 0, 256, W_A_GRP + (unsigned long long)g * 65536, 0, 2, g * 256);
    add(8, 0, 1024, 1024, 0, 1024, W_A_OUT, 0, 0, 0);
    for (int g = 0; g < 3; ++g) {
        add(9, 0, 1024, 9216, g * 3072, 1024, W_B_QK + (unsigned long long)g * 1048576, 0, 1, 0);
        add(9, 0, 1024, 9216, g * 3072 + 1024, 1024, W_B_QK + (unsigned long long)(3 + g) * 1048576, 0, 0, 0);
        add(9, 0, 1024, 9216, g * 3072 + 2048, 1024, W_B_V + (unsigned long long)g * 1048576, 0, 0, 0);
    }
    add(10, 0, 1024, 1024, 0, 1024, W_B_OUT, 0, 0, 0);
    add(11, 0, 1024, 3072, 0, 1024, W_C_QK, 0, 1, 0);
    add(11, 0, 1024, 3072, 1024, 1024, W_C_QK + 1048576, 0, 0, 0);
    add(11, 0, 1024, 3072, 2048, 1024, W_C_V, 0, 0, 0);
    add(14, 0, 1024, 1024, 0, 1024, W_C_OUT, 0, 0, 0);
    add(15, 0, 1024, 1536, 0, 1024, W_D_QK, 0, 1, 0);
    add(15, 0, 1024, 1536, 1024, 256, W_D_QK + 1048576, 0, 0, 0);
    add(15, 0, 1024, 1536, 1280, 256, W_D_V, 0, 0, 0);
    add(17, 0, 1024, 1024, 0, 1024, W_D_OUT, 0, 0, 0);
    for (int l = 0; l < 2; ++l) add(18, (unsigned long long)l * 1024 * 7168, 1024, 7168, 0, 7168, W_F_GU + (unsigned long long)l * 7168 * 1024, 1, 0, 0);
    for (int l = 0; l < 2; ++l) add(19, (unsigned long long)l * 3584 * 1024, 3584, 1024, 0, 1024, W_F_D + (unsigned long long)l * 3584 * 1024, 0, 0, 0);
    for (int l = 0; l < 16; ++l) add(21, (unsigned long long)l * 1024 * 7168, 1024, 7168, 0, 7168, W_M_GU + (unsigned long long)l * 7168 * 1024, 1, 0, 0);
    for (int l = 0; l < 16; ++l) add(22, (unsigned long long)l * 3584 * 1024, 3584, 1024, 0, 1024, W_M_D + (unsigned long long)l * 3584 * 1024, 0, 0, 0);
    t.nitems = it;
    return t;
}
__constant__ JobTab g_jobs = make_jobs();
static_assert(make_jobs().j[NJOBS - 1].K == 3584, "job count");

struct Args { const float* in[23]; float* out; unsigned char* ws; int ph_lo, ph_hi; };

struct Frame {
    LAS unsigned char* lds;
    int G, c, vcu;
    __device__ __forceinline__ int tid_() const { return (int)threadIdx.x; }
    __device__ __forceinline__ int lane_() const { return (int)threadIdx.x & 63; }
    __device__ __forceinline__ int wave_() const { return __builtin_amdgcn_readfirstlane((int)threadIdx.x >> 6); }
};

__device__ __forceinline__ void conv_item(const Job& jb, const float* __restrict__ src, bf16_t* __restrict__ dst, const float* __restrict__ cs, LAS unsigned* scr, unsigned item, int lane) {
    const int ntn = jb.ncols >> 6; const int kb = (int)item / ntn, nb = (int)item % ntn, k0 = kb * 64, n0 = nb * 64;
    int drow = n0;
    if (jb.mode == 1) { int n = n0; const bool up = n >= DFF; if (up) n -= DFF; drow = (n >> 7) * 256 + (n & 127) + (up ? 128 : 0); }
    const int a = lane & 15, b = lane >> 4;
    const float sc = (jb.sk == 1) ? QSCALE : 1.0f;
    f32x4 csv = (f32x4){sc, sc, sc, sc};
    if (jb.sk == 2) csv = *(const f32x4*)(cs + jb.sidx + n0 + 4 * a);
    const float* sp = src + (size_t)(k0 + 2 * b) * jb.ld + jb.col0 + n0 + 4 * a;
    f32x4 v0[8], v1[8];
#pragma unroll
    for (int i = 0; i < 8; ++i) { v0[i] = *(const f32x4*)(sp + (size_t)(8 * i) * jb.ld); v1[i] = *(const f32x4*)(sp + (size_t)(8 * i + 1) * jb.ld); }
#pragma unroll
    for (int i = 0; i < 8; ++i) { const f32x4 x0 = v0[i] * csv, x1 = v1[i] * csv; const int kp = 4 * i + b;
#pragma unroll
        for (int j = 0; j < 4; ++j) scr[(4 * a + j) * 33 + kp] = cvt_pk_bf16(x0[j], x1[j]); }
    LDS_WAIT();
    const int c = lane & 7;
#pragma unroll
    for (int jj = 0; jj < 8; ++jj) { const int n = (lane >> 3) + 8 * jj; const LAS unsigned* s = scr + n * 33 + 4 * c;
        u32x4 o; o.x = s[0]; o.y = s[1]; o.z = s[2]; o.w = s[3];
        *(u32x4*)(dst + (size_t)(drow + n) * jb.K + k0 + 8 * c) = o; }
    LDS_WAIT();
}

__device__ __forceinline__ int rel_bucket(int rel) {
    const int n = rel < 0 ? -rel : rel;
    int big = 8 + (int)(logf((float)(n < 1 ? 1 : n) / 8.0f) / 4.852030263919617f * 8.0f);
    big = big < 15 ? big : 15;
    return (rel > 0 ? 16 : 0) + (n < 8 ? n : big);
}

__device__ __forceinline__ void load_row(const float* xrow, int lane, f32x4 (&v)[4]) {
    const f32x4* xr = (const f32x4*)xrow + lane;
#pragma unroll
    for (int j = 0; j < 4; ++j) v[j] = xr[64 * j];
}
__device__ __forceinline__ float row_rstd(const f32x4 (&v)[4]) {
    float s = 0.f;
#pragma unroll
    for (int j = 0; j < 4; ++j) s += (v[j].x * v[j].x + v[j].y * v[j].y) + (v[j].z * v[j].z + v[j].w * v[j].w);
    return 1.0f / sqrtf(wave_sum(s) * (1.0f / DM) + RMS_EPS);
}
__device__ __forceinline__ void store_row_bf16(bf16_t* orow, int lane, const f32x4 (&v)[4]) {
    u32x2* o8 = (u32x2*)orow + lane;
#pragma unroll
    for (int j = 0; j < 4; ++j) { u32x2 w; w.x = cvt_pk_bf16(v[j].x, v[j].y); w.y = cvt_pk_bf16(v[j].z, v[j].w); o8[64 * j] = w; }
}
__device__ __forceinline__ void rms_phase(const Frame& F, const float* x, const float* gain, bf16_t* hn) {
    const int gw = F.c * NWAVES + F.wave_(), NGW = F.G * NWAVES;
    f32x4 g[4]; load_row(gain, F.lane_(), g);
    for (int m = gw; m < MTOK; m += NGW) {
        f32x4 v[4]; load_row(x + (size_t)m * DM, F.lane_(), v);
        const float rstd = row_rstd(v);
#pragma unroll
        for (int j = 0; j < 4; ++j) v[j] = v[j] * rstd * g[j];
        store_row_bf16(hn + (size_t)m * DM, F.lane_(), v);
    }
}

__device__ __forceinline__ int keyperm(int rho) { return (rho & 0x13) | ((rho & 4) << 1) | ((rho & 8) >> 1); }
template <int NVB> struct AttnAcc { f32x16 o[NVB]; float m, l; };
template <int NVB>
__device__ __forceinline__ void attn_tile(AttnAcc<NVB>& st, const bf16x8 (&qf)[4], const char* kptr, const char* vptr, const size_t vblk, const LAS float* bt) {
    bf16x8 kf[4], vf[NVB][2];
#pragma unroll
    for (int t = 0; t < 4; ++t) kf[t] = *(const bf16x8*)(kptr + t * 32);
#pragma unroll
    for (int b = 0; b < NVB; ++b)
#pragma unroll
        for (int t = 0; t < 2; ++t) vf[b][t] = *(const bf16x8*)(vptr + b * vblk + t * 32);
    f32x16 s;
#pragma unroll
    for (int r = 0; r < 16; ++r) s[r] = bt[(r >> 3) * 16 + (r & 7)];
#pragma unroll
    for (int t = 0; t < 4; ++t) s = __builtin_amdgcn_mfma_f32_32x32x16_bf16(kf[t], qf[t], s, 0, 0, 0);
    float mx = s[0];
#pragma unroll
    for (int r = 1; r < 16; ++r) mx = fmaxf(mx, s[r]);
    mx = fmaxf(mx, __shfl_xor(mx, 32));
    const float mn = fmaxf(st.m, mx), alpha = __builtin_amdgcn_exp2f(st.m - mn); st.m = mn;
    float ps = 0.f;
#pragma unroll
    for (int r = 0; r < 16; ++r) { s[r] = __builtin_amdgcn_exp2f(s[r] - mn); ps += s[r]; }
    st.l = st.l * alpha + ps;
#pragma unroll
    for (int b = 0; b < NVB; ++b) st.o[b] = st.o[b] * alpha;
    u32x4 p0, p1;
    p0.x = cvt_pk_bf16(s[0], s[1]); p0.y = cvt_pk_bf16(s[2], s[3]); p0.z = cvt_pk_bf16(s[4], s[5]); p0.w = cvt_pk_bf16(s[6], s[7]);
    p1.x = cvt_pk_bf16(s[8], s[9]); p1.y = cvt_pk_bf16(s[10], s[11]); p1.z = cvt_pk_bf16(s[12], s[13]); p1.w = cvt_pk_bf16(s[14], s[15]);
    const bf16x8 pf0 = __builtin_bit_cast(bf16x8, p0), pf1 = __builtin_bit_cast(bf16x8, p1);
#pragma unroll
    for (int b = 0; b < NVB; ++b) { st.o[b] = __builtin_amdgcn_mfma_f32_32x32x16_bf16(vf[b][0], pf0, st.o[b], 0, 0, 0); st.o[b] = __builtin_amdgcn_mfma_f32_32x32x16_bf16(vf[b][1], pf1, st.o[b], 0, 0, 0); }
}

template <int HALF>
__device__ __forceinline__ void band_item(const bf16_t* Qp, const bf16_t* Kp, const int ldqk, const size_t tok0, const int dil, const int L, const int q0,
                                          const bf16_t* Vt, const size_t vn0, const float* gtab_h, LAS float* tbl, const float m_init, const float l_init,
                                          bf16_t* out_row0  , const int ldo, float* lse_out  , const int lane) {
    const int ql = lane & 31, hf = lane >> 5;
    for (int i = lane; i < 2 * HALF + 63; i += 64) { const int j = i - HALF - 31; tbl[i] = (j >= -HALF && j <= HALF) ? gtab_h[j * dil + 2048] : NEG_BIG; }
    LDS_WAIT();
    const size_t qtok = tok0 + (size_t)(q0 + ql) * dil;
    bf16x8 qf[4];
#pragma unroll
    for (int t = 0; t < 4; ++t) qf[t] = *(const bf16x8*)(Qp + qtok * ldqk + 16 * t + 8 * hf);
    AttnAcc<2> st;
    st.o[0] = (f32x16){}; st.o[1] = (f32x16){}; st.m = m_init; st.l = (hf == 0) ? l_init : 0.f;
    const int kr = keyperm(ql);
    for (int kt = q0 - HALF; kt <= q0 + HALF; kt += 32) {
        if (kt < 0 || kt >= L) continue;
        const char* kptr = (const char*)(Kp + (tok0 + (size_t)(kt + kr) * dil) * ldqk + 8 * hf);
        const char* vptr = (const char*)(Vt + (size_t)ql * MTOK + vn0 + kt + 8 * hf);
        const LAS float* bt = tbl + (kt - q0 + HALF) + 8 * hf - ql + 31;
        attn_tile<2>(st, qf, kptr, vptr, (size_t)32 * MTOK * 2, bt);
    }
    const float lt = st.l + __shfl_xor(st.l, 32), inv = 1.0f / lt;
    bf16_t* orow = out_row0 + qtok * ldo;
#pragma unroll
    for (int b = 0; b < 2; ++b)
#pragma unroll
        for (int i = 0; i < 4; ++i) { u32x2 w; w.x = cvt_pk_bf16(st.o[b][4 * i] * inv, st.o[b][4 * i + 1] * inv); w.y = cvt_pk_bf16(st.o[b][4 * i + 2] * inv, st.o[b][4 * i + 3] * inv);
            *(u32x2*)(orow + 32 * b + 8 * i + 4 * hf) = w; }
    if (lse_out && hf == 0) lse_out[qtok * 16] = st.m + __builtin_amdgcn_logf(lt);
}

struct PlainSched {
    const char* A; const char* B; unsigned lda, ldb; int nM, nN, G, c; size_t co_m, co_n;
    __device__ __forceinline__ bool next(int i, pg8::Unit& u) const {
        const long L = (long)i * G + c; if (L >= (long)nM * nN) return false;
        int pm, pn; pg8::tile_order(nM, nN, (int)L, pm, pn);
        u.A = A + (size_t)pm * 256 * lda; u.B = B + (size_t)pn * 256 * ldb; u.ldb = ldb; u.hsb = 128u * ldb; u.co = (size_t)pm * co_m + (size_t)pn * co_n; u.tag = 0; return true;
    }
};
struct QkvSched {
    const char* hn; const char* Wqk; const char* Wv; int nNqk, nvp, nMv, dshift, G, c; int ldqk;
    __device__ __forceinline__ bool next(int i, pg8::Unit& u) const {
        long L = (long)i * G + c; const int n0 = 64 * nNqk, nv = nMv * 64;
        if (L < n0) { int pm, pn; pg8::tile_order(64, nNqk, (int)L, pm, pn);
            u.A = hn + (size_t)pm * 256 * 2048; u.B = Wqk + (size_t)pn * 256 * 2048; u.ldb = 2048u; u.hsb = 128u * 2048u; u.co = (size_t)pm * 256 * ldqk + (size_t)pn * 256; u.tag = 0; return true; }
        L -= n0; if (L >= (long)nvp * nv) return false;
        const int g = (int)(L / nv); int pm, pn; pg8::tile_order(nMv, 64, (int)(L % nv), pm, pn);
        const int d = 1 << (dshift * g), b = pn >> 3, nn = (pn & 7) * 256;
        size_t tok; unsigned ldb, hsb;
        if (d == 1) { tok = (size_t)b * SEQ + nn; ldb = 2048u; hsb = 128u * 2048u; }
        else if (d == 4) { tok = (size_t)b * SEQ + (size_t)(nn & 511) * 4 + (nn >> 9); ldb = 4u * 2048u; hsb = 128u * 4u * 2048u; }
        else { tok = (size_t)b * SEQ + (nn >> 7); ldb = 16u * 2048u; hsb = 2048u; }
        u.A = Wv + (size_t)(g * nMv + pm) * 256 * 2048; u.B = hn + tok * 2048; u.ldb = ldb; u.hsb = hsb;
        u.co = (size_t)(g * nMv + pm) * 256 * MTOK + (size_t)pn * 256; u.tag = 1; return true;
    }
};
struct MoeSched {
    const char* A; const char* B; unsigned lda, ldb; const int* panel; size_t estride; int nN, G, c; size_t co_m, co_n;
    __device__ __forceinline__ bool next(int i, pg8::Unit& u) const {
        const int nM = panel[0]; const long L = (long)i * G + c; if (L >= (long)nM * nN) return false;
        int pm, pn; pg8::tile_order(nM, nN, (int)L, pm, pn); const int e = panel[4 + pm];
        u.A = A + (size_t)pm * 256 * lda; u.B = B + (size_t)e * estride + (size_t)pn * 256 * ldb; u.ldb = ldb; u.hsb = 128u * ldb; u.co = (size_t)pm * co_m + (size_t)pn * co_n; u.tag = 0; return true;
    }
};

__device__ __forceinline__ void moe_route(const Frame& F, const float* x, const float* gain, const float* router, bf16_t* hn, int* e12, float* g1o, float* g2o, int* cnt_wg) {
    LAS float* Rt = (LAS float*)F.lds;
    LAS int* cnt = (LAS int*)(F.lds + 32768);
    for (int i = F.tid_(); i < DM * NE; i += NWAVES * 64) { const int k = i >> 3, e = i & 7; Rt[e * DM + k] = router[i]; }
    f32x4 g[4]; load_row(gain, F.lane_(), g);
    for (int ch = F.c; ch < MTOK / 64; ch += F.G) {
        if (F.tid_() < 8) cnt[F.tid_()] = 0;
        __syncthreads();
        for (int i = 0; i < 8; ++i) {
            const int m = ch * 64 + F.wave_() * 8 + i;
            f32x4 v[4]; load_row(x + (size_t)m * DM, F.lane_(), v);
            const float rstd = row_rstd(v);
#pragma unroll
            for (int j = 0; j < 4; ++j) v[j] = v[j] * rstd * g[j];
            store_row_bf16(hn + (size_t)m * DM, F.lane_(), v);
            float lg[8];
#pragma unroll
            for (int e = 0; e < 8; ++e) { float s = 0.f;
#pragma unroll
                for (int j = 0; j < 4; ++j) { const f32x4 r = *(const LAS f32x4*)(Rt + e * DM + 4 * F.lane_() + 256 * j); s += (v[j].x * r.x + v[j].y * r.y) + (v[j].z * r.z + v[j].w * r.w); }
                lg[e] = wave_sum(s); }
            int e1 = 0; float v1 = lg[0];
#pragma unroll
            for (int e = 1; e < 8; ++e) if (lg[e] > v1) { v1 = lg[e]; e1 = e; }
            int e2 = -1; float v2 = -3.4e38f;
#pragma unroll
            for (int e = 0; e < 8; ++e) if (e != e1 && lg[e] > v2) { v2 = lg[e]; e2 = e; }
            const float ex = __expf(v2 - v1), ga = 1.0f / (1.0f + ex), gb = ex * ga;
            if (F.lane_() == 0) { e12[m] = e1 | (e2 << 8); g1o[m] = ga; g2o[m] = gb; atomicAdd((int*)&cnt[e1], 1); atomicAdd((int*)&cnt[e2], 1); }
        }
        __syncthreads();
        if (F.tid_() < 8) cnt_wg[ch * 8 + F.tid_()] = cnt[F.tid_()];
        __syncthreads();
    }
}
__device__ __forceinline__ void moe_assign(const Frame& F, const bf16_t* hn, const int* e12, const int* cnt_wg, int* p1o, int* p2o, int* panel, bf16_t* hs) {
    LAS int* psum = (LAS int*)F.lds;
    LAS int* tot = psum + 512; LAS int* base = tot + 8; LAS int* off = base + 8;
    LAS int* plist = off + 16;
    for (int ch = F.c; ch < MTOK / 64; ch += F.G) {
        { const int e = F.tid_() & 7, part = F.tid_() >> 3; int s = 0;
#pragma unroll
          for (int q = 0; q < 4; ++q) s += cnt_wg[(4 * part + q) * 8 + e];
          psum[part * 8 + e] = s; }
        __syncthreads();
        if (F.tid_() < 8) { const int e = F.tid_(); int t = 0, b = 0; for (int p = 0; p < 64; ++p) { const int s = psum[p * 8 + e]; if (p < (ch >> 2)) b += s; t += s; }
            for (int q = 0; q < (ch & 3); ++q) b += cnt_wg[(4 * (ch >> 2) + q) * 8 + e];
            tot[e] = t; base[e] = b; }
        __syncthreads();
        if (F.tid_() == 0) { int o = 0; for (int e = 0; e < 8; ++e) { off[e] = o; o += (tot[e] + 255) & ~255; } off[8] = o; }
        __syncthreads();
        if (F.wave_() == 0) {
            const int m = ch * 64 + F.lane_(); const int ee = e12[m]; const int e1 = ee & 255, e2 = ee >> 8; int p1 = 0, p2 = 0;
#pragma unroll
            for (int e = 0; e < 8; ++e) { const unsigned long long mk = __ballot(e1 == e || e2 == e); const int rk = __popcll(mk & ((1ull << F.lane_()) - 1ull));
                if (e1 == e) p1 = off[e] + base[e] + rk; if (e2 == e) p2 = off[e] + base[e] + rk; }
            p1o[m] = p1; p2o[m] = p2; plist[2 * F.lane_()] = p1; plist[2 * F.lane_() + 1] = p2;
        }
        __syncthreads();
        for (int i = 0; i < 16; ++i) { const int pr = F.wave_() * 16 + i; const int m = ch * 64 + (pr >> 1); const int pos = plist[pr];
            const u32x4* s = (const u32x4*)(hn + (size_t)m * DM); u32x4* d = (u32x4*)(hs + (size_t)pos * DM);
            const u32x4 a = s[F.lane_()], b = s[64 + F.lane_()]; d[F.lane_()] = a; d[64 + F.lane_()] = b; }
        if (ch < 8) { const int e = ch; for (int r = off[e] + tot[e] + F.wave_(); r < off[e + 1]; r += NWAVES) { u32x4* d = (u32x4*)(hs + (size_t)r * DM); d[F.lane_()] = (u32x4){0, 0, 0, 0}; d[64 + F.lane_()] = (u32x4){0, 0, 0, 0}; } }
        if (ch == 0) { if (F.tid_() == 0) panel[0] = off[8] >> 8;
            if (F.tid_() < NPANEL_MAX) { const int r = F.tid_() * 256; int e = 0;
#pragma unroll
                for (int q = 1; q < 8; ++q) if (r >= off[q]) e = q;
                panel[4 + F.tid_()] = e; } }
        __syncthreads();
    }
}
__device__ __forceinline__ void moe_combine(const Frame& F, const float* x, const bf16_t* ys, const int* p1, const int* p2, const float* g1, const float* g2, const float* gain, float* xo, bf16_t* hn, float* outf) {
    const int gw = F.c * NWAVES + F.wave_(), NGW = F.G * NWAVES;
    f32x4 g[4]; load_row(gain, F.lane_(), g);
    for (int m = gw; m < MTOK; m += NGW) {
        f32x4 v[4]; load_row(x + (size_t)m * DM, F.lane_(), v);
        const float ga = g1[m], gb = g2[m];
        const u32x2* ya = (const u32x2*)(ys + (size_t)p1[m] * DM) + F.lane_(); const u32x2* yb = (const u32x2*)(ys + (size_t)p2[m] * DM) + F.lane_();
#pragma unroll
        for (int j = 0; j < 4; ++j) { const u32x2 a = ya[64 * j], b = yb[64 * j];
            v[j].x += ga * bf_lo(a.x) + gb * bf_lo(b.x); v[j].y += ga * bf_hi(a.x) + gb * bf_hi(b.x); v[j].z += ga * bf_lo(a.y) + gb * bf_lo(b.y); v[j].w += ga * bf_hi(a.y) + gb * bf_hi(b.y); }
        if (xo) { f32x4* o = (f32x4*)(xo + (size_t)m * DM) + F.lane_();
#pragma unroll
            for (int j = 0; j < 4; ++j) o[64 * j] = v[j]; }
        const float rstd = row_rstd(v);
#pragma unroll
        for (int j = 0; j < 4; ++j) v[j] = v[j] * rstd * g[j];
        if (outf) { f32x4* o = (f32x4*)(outf + (size_t)m * DM) + F.lane_();
#pragma unroll
            for (int j = 0; j < 4; ++j) o[64 * j] = v[j]; }
        else store_row_bf16(hn + (size_t)m * DM, F.lane_(), v);
    }
}


__global__ void __launch_bounds__(NWAVES * 64, 2) enc_fwd(Args args) {
    extern __shared__ __attribute__((aligned(16))) unsigned char lds_raw[];
    Frame F;
    F.lds = (LAS unsigned char*)lds_raw;
    F.G = gridDim.x; F.c = blockIdx.x; F.vcu = (F.G % 8 == 0) ? (F.c % 8) * (F.G / 8) + F.c / 8 : F.c;
    unsigned char* ws = args.ws;
    volatile LAS unsigned* MISC = (volatile LAS unsigned*)(F.lds + MISC_OFF);
    for (int u = F.tid_(); u < (LDS_BYTES - LDSCTL_OFF) / 4; u += NWAVES * 64) ((LAS unsigned*)(F.lds + LDSCTL_OFF))[u] = 0u;
    __syncthreads();
#if MK_MULTI
    #define GRID_BAR() do { } while (0)
#else
    XcdBarrier bar = xcd_barrier_post((unsigned*)(ws + WS_CTL) + CW_BAR, MISC + 8);
    #define GRID_BAR() xcd_barrier(bar)
#endif
    const int lo = args.ph_lo, hi = args.ph_hi;
#define IN(k) (lo <= (k) && (k) < hi)
#define SEAM(k) do { if (IN((k) + 1)) GRID_BAR(); } while (0)

    const float* x_in = args.in[0]; const float* rel_bias = args.in[1]; const float* norm_mix = args.in[2]; const float* norm_ffn = args.in[3]; const float* norm_final = args.in[4];
    bf16_t* Wb = (bf16_t*)(ws + WS_W);
    float* gtab = (float*)(ws + WS_TAB); float* misc = (float*)(ws + WS_MISC);
    int* r_e12 = (int*)(ws + WS_ROUTE); float* r_g1 = (float*)(ws + WS_ROUTE + 65536); float* r_g2 = (float*)(ws + WS_ROUTE + 2 * 65536);
    int* r_p1 = (int*)(ws + WS_ROUTE + 3 * 65536); int* r_p2 = (int*)(ws + WS_ROUTE + 4 * 65536);
    int* cnt_wg = (int*)(ws + WS_CNT); int* panel = (int*)(ws + WS_PANEL);
    float* XA = (float*)(ws + WS_XA); float* XB = (float*)(ws + WS_XB);
    bf16_t* HN = (bf16_t*)(ws + WS_HN); bf16_t* BUFA = (bf16_t*)(ws + WS_BUFA); bf16_t* BUFB = (bf16_t*)(ws + WS_BUFB); bf16_t* BUFC = (bf16_t*)(ws + WS_BUFC);
    bf16_t* BIG = (bf16_t*)(ws + WS_BIG); bf16_t* VT = (bf16_t*)(ws + WS_VT); bf16_t* OG = (bf16_t*)(ws + WS_OG); float* LSE = (float*)(ws + WS_LSE);
    bf16_t* HS = VT; bf16_t* YS = OG;
    LAS unsigned char* ring = F.lds;

#define PLAIN_GEMM(EPI, Aptr, Bptr, K_, lda_, ldb_, nM_, nN_, com_, con_) do { \
        PlainSched S_{(const char*)(Aptr), (const char*)(Bptr), (unsigned)(lda_), (unsigned)(ldb_), (nM_), (nN_), F.G, F.c, (size_t)(com_), (size_t)(con_)}; \
        pg8::gemm_phase(ring, (K_), (unsigned)(lda_), S_, EPI); } while (0)

#define DENSE_FFN(p, l, xr, xo) \
    if (IN(p)) { pg8::EpiSwiglu E_{BIG, DFF}; PLAIN_GEMM(E_, HN, Wb + W_F_GU + (size_t)(l) * 7168 * 1024, 1024, 2048, 2048, 64, 28, 256 * DFF, 128); SEAM(p); } \
    if (IN((p) + 1)) { pg8::EpiResid E_{(xr), (xo)}; PLAIN_GEMM(E_, BIG, Wb + W_F_D + (size_t)(l) * 3584 * 1024, 3584, 7168, 7168, 64, 4, 256 * DM, 256); SEAM((p) + 1); }

#define MOE_FFN(p, l, xr, gain) \
    if (IN(p)) { moe_route(F, (xr), (gain), args.in[20] + (size_t)(l) * DM * NE, HN, r_e12, r_g1, r_g2, cnt_wg); SEAM(p); } \
    if (IN((p) + 1)) { moe_assign(F, HN, r_e12, cnt_wg, r_p1, r_p2, panel, HS); SEAM((p) + 1); } \
    if (IN((p) + 2)) { pg8::EpiSwiglu E_{BIG, DFF}; MoeSched S_{(const char*)HS, (const char*)(Wb + W_M_GU + (size_t)(l) * 8 * 7168 * 1024), 2048u, 2048u, panel, (size_t)7168 * 1024 * 2, 28, F.G, F.c, (size_t)256 * DFF, (size_t)128}; \
        pg8::gemm_phase(ring, 1024, 2048u, S_, E_); SEAM((p) + 2); } \
    if (IN((p) + 3)) { pg8::EpiBf16 E_{YS, DM, YS, DM}; MoeSched S_{(const char*)BIG, (const char*)(Wb + W_M_D + (size_t)(l) * 8 * 3584 * 1024), 7168u, 7168u, panel, (size_t)3584 * 1024 * 2, 4, F.G, F.c, (size_t)256 * DM, (size_t)256}; \
        pg8::gemm_phase(ring, 3584, 7168u, S_, E_); SEAM((p) + 3); }

    if (IN(0)) {
        LAS unsigned* scr = (LAS unsigned*)(F.lds + F.wave_() * 8448);
        const unsigned gw = (unsigned)(F.c * NWAVES + F.wave_()), NGW = (unsigned)(F.G * NWAVES);
        int jn = 0;
        for (unsigned it = gw; it < g_jobs.nitems; it += NGW) {
            while (jn + 1 < NJOBS && g_jobs.j[jn + 1].item0 <= it) ++jn;
            const Job& jb = g_jobs.j[jn];
            conv_item(jb, args.in[jb.in] + jb.src, Wb + jb.dst, args.in[7], scr, it - jb.item0, F.lane_());
        }
        for (int i = F.c * NWAVES * 64 + F.tid_(); i < 16 * 4096; i += F.G * NWAVES * 64) { const int h = i >> 12, idx = i & 4095; gtab[i] = rel_bias[rel_bucket(idx - 2048) * 16 + h] * LOG2E; }
        if (F.c == 0 && F.tid_() == 0) { const float* lv = args.in[12]; float s0 = 0.f, s1 = 0.f; for (int i = 0; i < 64; ++i) { s0 += lv[i] * lv[64 + i]; s1 += lv[128 + i] * lv[192 + i]; }
            const float lam_init = 0.8f - 0.6f * expf(-0.3f * 2.0f); misc[0] = expf(s0) - expf(s1) + lam_init; misc[1] = lam_init; }
        rms_phase(F, x_in, norm_mix, HN);
        SEAM(0);
    }
    if (IN(1)) { pg8::EpiBf16 E_{BUFA, DM, BUFA, DM}; PLAIN_GEMM(E_, HN, Wb + W_A_IN, 1024, 2048, 2048, 64, 4, 256 * DM, 256); SEAM(1); }
    if (IN(2)) {
        for (int it = F.c * NWAVES * 64 + F.tid_(); it < MTOK * 128; it += F.G * NWAVES * 64) {
            const int t = it >> 7, cc = it & 127, g = cc >> 5, hw = 1 << g, s = t & (SEQ - 1);
            const int lo_ = (s - hw) < 0 ? 0 : s - hw, hi_ = (s + hw) > SEQ ? SEQ : s + hw;
            const bf16_t* base = BUFA + (size_t)(t - s) * DM + cc * 8;
            float a[8] = {0, 0, 0, 0, 0, 0, 0, 0};
            for (int r = lo_; r < hi_; ++r) { const u32x4 w = *(const u32x4*)(base + (size_t)r * DM);
                a[0] += bf_lo(w.x); a[1] += bf_hi(w.x); a[2] += bf_lo(w.y); a[3] += bf_hi(w.y); a[4] += bf_lo(w.z); a[5] += bf_hi(w.z); a[6] += bf_lo(w.w); a[7] += bf_hi(w.w); }
            const float ic = 1.0f / (float)(hi_ - lo_); const u32x4 w = *(const u32x4*)(base + (size_t)s * DM);
            u32x4 o; o.x = cvt_pk_bf16(a[0] * ic - bf_lo(w.x), a[1] * ic - bf_hi(w.x)); o.y = cvt_pk_bf16(a[2] * ic - bf_lo(w.y), a[3] * ic - bf_hi(w.y));
            o.z = cvt_pk_bf16(a[4] * ic - bf_lo(w.z), a[5] * ic - bf_hi(w.z)); o.w = cvt_pk_bf16(a[6] * ic - bf_lo(w.w), a[7] * ic - bf_hi(w.w));
            *(u32x4*)(BUFB + (size_t)t * DM + cc * 8) = o;
        }
        SEAM(2);
    }
    if (IN(3)) {
        struct GrpSched { const char* A; const char* B; int G, c;
            __device__ __forceinline__ bool next(int i, pg8::Unit& u) const { const int L = i * G + c; if (L >= 256) return false; int pm, pn; pg8::tile_order(64, 4, L, pm, pn);
                u.A = A + (size_t)pm * 256 * 2048 + pn * 512; u.B = B + (size_t)pn * 65536 * 2; u.ldb = 512u; u.hsb = 128u * 512u; u.co = (size_t)pm * 256 * DM + pn * 256; u.tag = 0; return true; } };
        GrpSched S_{(const char*)BUFB, (const char*)(Wb + W_A_GRP), F.G, F.c}; pg8::EpiBf16 E_{BUFC, DM, BUFC, DM};
        pg8::gemm_phase(ring, 256, 2048u, S_, E_); SEAM(3);
    }
    if (IN(4)) { pg8::EpiResid E_{x_in, XA}; PLAIN_GEMM(E_, BUFC, Wb + W_A_OUT, 1024, 2048, 2048, 64, 4, 256 * DM, 256); SEAM(4); }
    if (IN(5)) { rms_phase(F, XA, norm_ffn, HN); SEAM(5); }
    DENSE_FFN(6, 0, XA, XB)
    if (IN(8)) { rms_phase(F, XB, norm_mix + DM, HN); SEAM(8); }
    if (IN(9)) {
        QkvSched S_{(const char*)HN, (const char*)(Wb + W_B_QK), (const char*)(Wb + W_B_V), 24, 3, 4, 2, F.G, F.c, 6144};
        pg8::EpiBf16 E_{BIG, 6144, VT, MTOK}; pg8::gemm_phase(ring, 1024, 2048u, S_, E_); SEAM(9);
    }
    if (IN(10)) {
        LAS float* tbl = (LAS float*)(F.lds + F.wave_() * 2048);
        for (int i = 0; i < 12; ++i) {
            const int w = (i * F.G + F.vcu) * NWAVES + F.wave_(); if (w >= 3 * 8192) break;
            const int g = w >> 13, rest = w & 8191, b = rest >> 10, h = (rest >> 6) & 15, blk = rest & 63;
            const int dil = (g == 0) ? 1 : (g == 1 ? 4 : 16), L = SEQ / dil, nqb = L >> 5, r = blk / nqb, qb = blk % nqb;
            band_item<64>(BIG + g * 1024 + h * 64, BIG + 3072 + g * 1024 + h * 64, 6144, (size_t)b * SEQ + r, dil, L, qb * 32,
                          VT + (size_t)(g * 1024 + h * 64) * MTOK, (size_t)b * SEQ + (size_t)r * L, gtab + h * 4096, tbl, NEG_BIG, 0.f,
                          OG + (size_t)g * MTOK * DM + h * 64, DM, LSE + (size_t)g * MTOK * 16 + h, F.lane_());
        }
        SEAM(10);
    }
    if (IN(11)) {
        for (int it = F.c * NWAVES * 64 + F.tid_(); it < MTOK * 128; it += F.G * NWAVES * 64) {
            const int t = it >> 7, cc = it & 127, h = cc >> 3;
            const float l0 = LSE[(size_t)t * 16 + h], l1 = LSE[(size_t)(MTOK + t) * 16 + h], l2 = LSE[(size_t)(2 * MTOK + t) * 16 + h];
            const float mx = fmaxf(l0, fmaxf(l1, l2)); float w0 = __builtin_amdgcn_exp2f(l0 - mx), w1 = __builtin_amdgcn_exp2f(l1 - mx), w2 = __builtin_amdgcn_exp2f(l2 - mx);
            const float inv = 1.0f / (w0 + w1 + w2); w0 *= inv; w1 *= inv; w2 *= inv;
            const size_t o = (size_t)t * DM + cc * 8;
            const u32x4 a = *(const u32x4*)(OG + o), b = *(const u32x4*)(OG + (size_t)MTOK * DM + o), c = *(const u32x4*)(OG + 2 * (size_t)MTOK * DM + o);
            u32x4 r;
            r.x = cvt_pk_bf16(w0 * bf_lo(a.x) + w1 * bf_lo(b.x) + w2 * bf_lo(c.x), w0 * bf_hi(a.x) + w1 * bf_hi(b.x) + w2 * bf_hi(c.x));
            r.y = cvt_pk_bf16(w0 * bf_lo(a.y) + w1 * bf_lo(b.y) + w2 * bf_lo(c.y), w0 * bf_hi(a.y) + w1 * bf_hi(b.y) + w2 * bf_hi(c.y));
            r.z = cvt_pk_bf16(w0 * bf_lo(a.z) + w1 * bf_lo(b.z) + w2 * bf_lo(c.z), w0 * bf_hi(a.z) + w1 * bf_hi(b.z) + w2 * bf_hi(c.z));
            r.w = cvt_pk_bf16(w0 * bf_lo(a.w) + w1 * bf_lo(b.w) + w2 * bf_lo(c.w), w0 * bf_hi(a.w) + w1 * bf_hi(b.w) + w2 * bf_hi(c.w));
            *(u32x4*)(BUFA + o) = r;
        }
        SEAM(11);
    }
    if (IN(12)) { pg8::EpiResid E_{XB, XA}; PLAIN_GEMM(E_, BUFA, Wb + W_B_OUT, 1024, 2048, 2048, 64, 4, 256 * DM, 256); SEAM(12); }
    MOE_FFN(13, 0, XA, norm_ffn + DM)
    if (IN(17)) { moe_combine(F, XA, YS, r_p1, r_p2, r_g1, r_g2, norm_mix + 2 * DM, XB, HN, nullptr); SEAM(17); }
    if (IN(18)) {
        QkvSched S_{(const char*)HN, (const char*)(Wb + W_C_QK), (const char*)(Wb + W_C_V), 8, 1, 4, 0, F.G, F.c, 2048};
        pg8::EpiBf16 E_{BIG, 2048, VT, MTOK}; pg8::gemm_phase(ring, 1024, 2048u, S_, E_); SEAM(18);
    }
    if (IN(19)) {
        LAS float* tabL = (LAS float*)F.lds;
        LAS float* xch = (LAS float*)(F.lds + 32768);
        const float lam = misc[0], post = 1.0f - misc[1];
        const int j = F.wave_() & 1, sub = F.wave_() >> 1, ql = F.lane_() & 31, hf = F.lane_() >> 5, kr = keyperm(ql);
        for (int i = 0; i < 4; ++i) {
            const int u = i * F.G + F.vcu; if (u >= 1024) break;
            const int b = u >> 7, h = (u >> 4) & 7, qblk = u & 15;
            __syncthreads();
            for (int q = F.tid_(); q < 2 * 4096; q += NWAVES * 64) tabL[q] = gtab[(2 * h) * 4096 + q];
            __syncthreads();
            const int q0 = qblk * 128 + sub * 32; const size_t tok0 = (size_t)b * SEQ;
            const bf16_t* Qp = BIG + (2 * h + j) * 64; const bf16_t* Kp = BIG + 1024 + (2 * h + j) * 64;
            const size_t qtok = tok0 + q0 + ql;
            bf16x8 qf[4];
#pragma unroll
            for (int t = 0; t < 4; ++t) qf[t] = *(const bf16x8*)(Qp + qtok * 2048 + 16 * t + 8 * hf);
            AttnAcc<4> st;
#pragma unroll
            for (int bb = 0; bb < 4; ++bb) st.o[bb] = (f32x16){};
            st.m = NEG_BIG; st.l = 0.f;
            const bf16_t* Vh = VT + (size_t)(h * 128 + ql) * MTOK + tok0 + 8 * hf;
            for (int kt = 0; kt < SEQ; kt += 32) {
                const char* kptr = (const char*)(Kp + (tok0 + kt + kr) * 2048 + 8 * hf);
                const char* vptr = (const char*)(Vh + kt);
                const LAS float* bt = tabL + j * 4096 + kt + 8 * hf - (q0 + ql) + 2048;
                attn_tile<4>(st, qf, kptr, vptr, (size_t)32 * MTOK * 2, bt);
            }
            const float lt = st.l + __shfl_xor(st.l, 32), inv = 1.0f / lt;
            if (j == 1) {
#pragma unroll
                for (int bb = 0; bb < 4; ++bb)
#pragma unroll
                    for (int r = 0; r < 16; ++r) xch[(sub * 64 + bb * 16 + r) * 64 + F.lane_()] = st.o[bb][r] * inv;
            }
            __syncthreads();
            if (j == 0) {
                float ss = 0.f;
#pragma unroll
                for (int bb = 0; bb < 4; ++bb)
#pragma unroll
                    for (int r = 0; r < 16; ++r) { const float v = st.o[bb][r] * inv - lam * xch[(sub * 64 + bb * 16 + r) * 64 + F.lane_()]; st.o[bb][r] = v; ss += v * v; }
                ss += __shfl_xor(ss, 32);
                const float rstd = post / sqrtf(ss * (1.0f / 128.0f) + RMS_EPS);
                const float* sg = args.in[13];
                bf16_t* orow = BUFA + qtok * DM + h * 128;
#pragma unroll
                for (int bb = 0; bb < 4; ++bb)
#pragma unroll
                    for (int i4 = 0; i4 < 4; ++i4) { const int d = 32 * bb + 8 * i4 + 4 * hf; const f32x4 gg = *(const f32x4*)(sg + d);
                        u32x2 w; w.x = cvt_pk_bf16(st.o[bb][4 * i4] * rstd * gg.x, st.o[bb][4 * i4 + 1] * rstd * gg.y); w.y = cvt_pk_bf16(st.o[bb][4 * i4 + 2] * rstd * gg.z, st.o[bb][4 * i4 + 3] * rstd * gg.w);
                        *(u32x2*)(orow + d) = w; }
            }
        }
        SEAM(19);
    }
    if (IN(20)) { pg8::EpiResid E_{XB, XA}; PLAIN_GEMM(E_, BUFA, Wb + W_C_OUT, 1024, 2048, 2048, 64, 4, 256 * DM, 256); SEAM(20); }
    if (IN(21)) { rms_phase(F, XA, norm_ffn + 2 * DM, HN); SEAM(21); }
    DENSE_FFN(22, 1, XA, XB)
    if (IN(24)) { rms_phase(F, XB, norm_mix + 3 * DM, HN); SEAM(24); }
    if (IN(25)) {
        QkvSched S_{(const char*)HN, (const char*)(Wb + W_D_QK), (const char*)(Wb + W_D_V), 5, 1, 1, 0, F.G, F.c, 1280};
        pg8::EpiBf16 E_{BIG, 1280, VT, MTOK}; pg8::gemm_phase(ring, 1024, 2048u, S_, E_); SEAM(25);
    }
    if (IN(26)) {
        LAS float* tbl = (LAS float*)(F.lds + F.wave_() * 2048);
        const float* sink = args.in[16];
        for (int i = 0; i < 4; ++i) {
            const int w = (i * F.G + F.vcu) * NWAVES + F.wave_(); if (w >= 8192) break;
            const int b = w >> 10, kvh = (w >> 8) & 3, qb = (w >> 2) & 63, qh = kvh * 4 + (w & 3);
            band_item<128>(BIG + qh * 64, BIG + 1024 + kvh * 64, 1280, (size_t)b * SEQ, 1, SEQ, qb * 32,
                           VT + (size_t)(kvh * 64) * MTOK, (size_t)b * SEQ, gtab + qh * 4096, tbl, sink[qh] * LOG2E, 1.0f,
                           BUFA + qh * 64, DM, nullptr, F.lane_());
        }
        SEAM(26);
    }
    if (IN(27)) { pg8::EpiResid E_{XB, XA}; PLAIN_GEMM(E_, BUFA, Wb + W_D_OUT, 1024, 2048, 2048, 64, 4, 256 * DM, 256); SEAM(27); }
    MOE_FFN(28, 1, XA, norm_ffn + 3 * DM)
    if (IN(32)) { moe_combine(F, XA, YS, r_p1, r_p2, r_g1, r_g2, norm_final, nullptr, nullptr, args.out); }
#undef IN
#undef SEAM
}
constexpr int N_PHASES = 33;

extern "C" void kernel_launch(void* const* d_in, const int* in_sizes, int n_in, void* d_out, int out_size, void* d_ws, size_t ws_size, hipStream_t stream) {
    static int grid = 0;
    if (grid == 0) {
        if (n_in != 23 || out_size != MTOK * DM || ws_size < WS_END) { fprintf(stderr, "kernel_launch: unexpected problem (n_in %d, out %d, ws %zu, need %zu)\n", n_in, out_size, ws_size, (size_t)WS_END); grid = -1; return; }
        int dev = 0, cus = 0, per_cu = 0;
        if (hipGetDevice(&dev) != hipSuccess || hipDeviceGetAttribute(&cus, hipDeviceAttributeMultiprocessorCount, dev) != hipSuccess) { grid = -1; return; }
        if (hipFuncSetAttribute((const void*)enc_fwd, hipFuncAttributeMaxDynamicSharedMemorySize, LDS_BYTES) != hipSuccess) { fprintf(stderr, "kernel_launch: hipFuncSetAttribute failed\n"); grid = -1; return; }
        if (hipOccupancyMaxActiveBlocksPerMultiprocessor(&per_cu, (const void*)enc_fwd, NWAVES * 64, LDS_BYTES) != hipSuccess || per_cu < 1)
            fprintf(stderr, "kernel_launch: occupancy query reports %d workgroups per CU\n", per_cu);
        (void)hipGetLastError();
        grid = cus;
    }
    if (grid < 0) return;
    if (hipMemsetAsync((char*)d_ws + WS_CTL, 0, CTL_ZERO_BYTES, stream) != hipSuccess) return;
    Args a{};
    for (int i = 0; i < 23; ++i) a.in[i] = (const float*)d_in[i];
    a.out = (float*)d_out; a.ws = (unsigned char*)d_ws;
#if MK_MULTI
    for (int p = 0; p < N_PHASES; ++p) { a.ph_lo = p; a.ph_hi = p + 1; hipLaunchKernelGGL(enc_fwd, dim3(grid), dim3(NWAVES * 64), LDS_BYTES, stream, a); }
#else
    a.ph_lo = 0; a.ph_hi = N_PHASES;
    hipLaunchKernelGGL(enc_fwd, dim3(grid), dim3(NWAVES * 64), LDS_BYTES, stream, a);
#endif
}
```

```cpp
#include <hip/hip_runtime.h>
#include <cstdio>
#include <cstdint>

#ifndef MK_MULTI
#define MK_MULTI 0
#endif

#define LAS __attribute__((address_space(3)))
#define GAS __attribute__((address_space(1)))
typedef unsigned short bf16_t;
typedef short bf16x8 __attribute__((ext_vector_type(8)));
typedef float f32x4 __attribute__((ext_vector_type(4)));
typedef float f32x16 __attribute__((ext_vector_type(16)));
typedef unsigned u32x4 __attribute__((ext_vector_type(4)));
typedef unsigned u32x2 __attribute__((ext_vector_type(2)));

constexpr int NB = 8, SEQ = 2048, DM = 1024, MTOK = NB * SEQ, DFF = 3584, NE = 8;
constexpr int MP_MAX = 2 * MTOK + NE * 256;
constexpr int NPANEL_MAX = MP_MAX / 256;
constexpr float RMS_EPS = 1e-6f;
constexpr float LOG2E = 1.4426950408889634f;
constexpr float QSCALE = 0.125f * LOG2E;
constexpr float NEG_BIG = -1e30f;
constexpr int NWAVES = 8;

constexpr size_t MiB = 1ull << 20;
constexpr size_t WS_CTL = 0, CTL_ZERO_BYTES = 1 * MiB;
constexpr size_t WS_TAB = 1 * MiB;
constexpr size_t WS_MISC = WS_TAB + 256 * 1024;
constexpr size_t WS_ROUTE = 2 * MiB;
constexpr size_t WS_CNT = WS_ROUTE + 384 * 1024;
constexpr size_t WS_PANEL = WS_ROUTE + 448 * 1024;
constexpr size_t WS_W = 4 * MiB;
constexpr size_t W_A_IN = 0, W_A_GRP = W_A_IN + 1048576, W_A_OUT = W_A_GRP + 262144, W_B_QK = W_A_OUT + 1048576, W_B_V = W_B_QK + 6144 * 1024,
                 W_B_OUT = W_B_V + 3072 * 1024, W_C_QK = W_B_OUT + 1048576, W_C_V = W_C_QK + 2048 * 1024, W_C_OUT = W_C_V + 1048576,
                 W_D_QK = W_C_OUT + 1048576, W_D_V = W_D_QK + 1280 * 1024, W_D_OUT = W_D_V + 256 * 1024, W_F_GU = W_D_OUT + 1048576,
                 W_F_D = W_F_GU + 2 * 7168 * 1024, W_M_GU = W_F_D + 2 * 3584 * 1024, W_M_D = W_M_GU + 16ull * 7168 * 1024, W_END = W_M_D + 16ull * 3584 * 1024;
constexpr size_t WS_XA = WS_W + ((W_END * 2 + MiB - 1) / MiB) * MiB;
constexpr size_t WS_XB = WS_XA + 64 * MiB;
constexpr size_t WS_HN = WS_XB + 64 * MiB;
constexpr size_t WS_BUFA = WS_HN + 32 * MiB;
constexpr size_t WS_BUFB = WS_BUFA + 32 * MiB;
constexpr size_t WS_BUFC = WS_BUFB + 32 * MiB;
constexpr size_t WS_BIG = WS_BUFC + 32 * MiB;
constexpr size_t WS_VT = WS_BIG + 240 * MiB;
constexpr size_t WS_OG = WS_VT + 96 * MiB;
constexpr size_t WS_LSE = WS_OG + 96 * MiB;
constexpr size_t WS_END = WS_LSE + 4 * MiB;
constexpr int CW_BAR = 4096;
constexpr int RING_BYTES = 131072, LDSCTL_OFF = RING_BYTES, MISC_OFF = LDSCTL_OFF + 320, LDS_BYTES = 147456;

__device__ __forceinline__ unsigned cvt_pk_bf16(float lo, float hi) { unsigned r; asm volatile("v_cvt_pk_bf16_f32 %0, %1, %2" : "=v"(r) : "v"(lo), "v"(hi)); return r; }
__device__ __forceinline__ float bf_lo(unsigned w) { return __uint_as_float(w << 16); }
__device__ __forceinline__ float bf_hi(unsigned w) { return __uint_as_float(w & 0xffff0000u); }
__device__ __forceinline__ float wave_sum(float v) {
#pragma unroll
    for (int o = 1; o < 64; o <<= 1) v += __shfl_xor(v, o);
    return v;
}
#define LDS_WAIT() asm volatile("s_waitcnt lgkmcnt(0)" ::: "memory")
#define VM_WAIT() asm volatile("s_waitcnt vmcnt(0)" ::: "memory")

namespace pg8 {
constexpr int BM = 256, BK = 64, HALF = 128, HTB = HALF * BK * 2, STAGE_BYTES = 8 * HTB, NXCD = 8, WGM = 8;
__host__ __device__ __forceinline__ int lds_byte(int r, int c) { const int st = (r >> 4) * 2 + (c >> 5), rr = r & 15, cc = c & 31, ob = rr * 64 + cc * 2; return st * 1024 + (ob ^ (((ob >> 9) & 1) << 5)); }
__host__ __device__ __forceinline__ void stage_rc(int b, int& R, int& C) { const int st = b / 1024, sb = b % 1024, swz = sb ^ (((sb >> 9) & 1) << 5); R = (st >> 1) * 16 + swz / 64; C = (st & 1) * 32 + (swz % 64) / 2; }
__host__ __device__ __forceinline__ int perm32(int rho) { const int n = rho >> 4, i = rho & 15; return 8 * (i >> 2) + 4 * n + (i & 3); }

struct Unit { const char* A; const char* B; unsigned ldb, hsb; size_t co; int tag; };

__device__ __forceinline__ void tile_order(int nM, int nN, int L, int& pm, int& pn) {
    const int nwg = nM * nN; int wgid = L;
    { const int q = nwg / NXCD, r = nwg % NXCD, xcd = wgid % NXCD, off = wgid / NXCD; wgid = (xcd < r ? xcd * (q + 1) : r * (q + 1) + (xcd - r) * q) + off; }
    const int nig = WGM * nN, gid = wgid / nig, fm = gid * WGM, gsz = (nM - fm) < WGM ? (nM - fm) : WGM;
    pm = fm + ((wgid % nig) % gsz); pn = (wgid % nig) / gsz;
}

__device__ __forceinline__ void zero_acc(f32x4 (&acc)[2][2][4][2]) {
#pragma unroll
    for (int a = 0; a < 2; ++a)
#pragma unroll
        for (int b = 0; b < 2; ++b)
#pragma unroll
            for (int m = 0; m < 4; ++m)
#pragma unroll
                for (int n = 0; n < 2; ++n) acc[a][b][m][n] = (f32x4){0.f, 0.f, 0.f, 0.f};
}
struct EpiBf16 {
    static constexpr bool PERM = true;
    bf16_t* out0; int ld0; bf16_t* out1; int ld1;
    __device__ __forceinline__ void init(f32x4 (&acc)[2][2][4][2], const Unit&, int, int, int, int) const { zero_acc(acc); }
    __device__ __forceinline__ void operator()(const f32x4 (&acc)[2][2][4][2], const Unit& u, int wr, int wc, int fr, int fq) const {
        bf16_t* base = (u.tag ? out1 : out0) + u.co; const int ldc = u.tag ? ld1 : ld0;
        int r0 = wr * 64 + fr; asm volatile("" : "+v"(r0));
#pragma unroll
        for (int ai = 0; ai < 2; ++ai)
#pragma unroll
            for (int m = 0; m < 4; ++m) { bf16_t* rowp = base + (unsigned)((ai * HALF + m * 16 + r0) * ldc + wc * 32 + 8 * fq);
#pragma unroll
                for (int bj = 0; bj < 2; ++bj) { const f32x4 v0 = acc[ai][bj][m][0], v1 = acc[ai][bj][m][1];
                    u32x4 w; w.x = cvt_pk_bf16(v0[0], v0[1]); w.y = cvt_pk_bf16(v0[2], v0[3]); w.z = cvt_pk_bf16(v1[0], v1[1]); w.w = cvt_pk_bf16(v1[2], v1[3]);
                    *(u32x4*)(rowp + bj * HALF) = w; } }
    }
};
struct EpiSwiglu {
    static constexpr bool PERM = true;
    bf16_t* out; int ldc;
    __device__ __forceinline__ void init(f32x4 (&acc)[2][2][4][2], const Unit&, int, int, int, int) const { zero_acc(acc); }
    __device__ __forceinline__ void operator()(const f32x4 (&acc)[2][2][4][2], const Unit& u, int wr, int wc, int fr, int fq) const {
        bf16_t* base = out + u.co;
        int r0 = wr * 64 + fr; asm volatile("" : "+v"(r0));
#pragma unroll
        for (int ai = 0; ai < 2; ++ai)
#pragma unroll
            for (int m = 0; m < 4; ++m) { bf16_t* rowp = base + (unsigned)((ai * HALF + m * 16 + r0) * ldc + wc * 32 + 8 * fq);
                float r[8];
#pragma unroll
                for (int n = 0; n < 2; ++n)
#pragma unroll
                    for (int j = 0; j < 4; ++j) { const float g = acc[ai][0][m][n][j], up = acc[ai][1][m][n][j];
                        r[n * 4 + j] = g * __builtin_amdgcn_rcpf(1.0f + __builtin_amdgcn_exp2f(-g * LOG2E)) * up; }
                u32x4 w; w.x = cvt_pk_bf16(r[0], r[1]); w.y = cvt_pk_bf16(r[2], r[3]); w.z = cvt_pk_bf16(r[4], r[5]); w.w = cvt_pk_bf16(r[6], r[7]);
                *(u32x4*)rowp = w; }
    }
};
struct EpiResid {
    static constexpr bool PERM = false;
    const float* __restrict__ resid; float* __restrict__ out;
    __device__ __forceinline__ void init(f32x4 (&acc)[2][2][4][2], const Unit& u, int wr, int wc, int fr, int fq) const {
        int r0 = wr * 64 + fr; asm volatile("" : "+v"(r0));
#pragma unroll
        for (int ai = 0; ai < 2; ++ai)
#pragma unroll
            for (int m = 0; m < 4; ++m) { const size_t off = u.co + (unsigned)((ai * HALF + m * 16 + r0) * DM + wc * 32 + 4 * fq);
#pragma unroll
                for (int bj = 0; bj < 2; ++bj)
#pragma unroll
                    for (int n = 0; n < 2; ++n) acc[ai][bj][m][n] = *(const f32x4*)(resid + off + bj * HALF + n * 16); }
    }
    __device__ __forceinline__ void operator()(const f32x4 (&acc)[2][2][4][2], const Unit& u, int wr, int wc, int fr, int fq) const {
        int r0 = wr * 64 + fr; asm volatile("" : "+v"(r0));
#pragma unroll
        for (int ai = 0; ai < 2; ++ai)
#pragma unroll
            for (int m = 0; m < 4; ++m) { const size_t off = u.co + (unsigned)((ai * HALF + m * 16 + r0) * DM + wc * 32 + 4 * fq);
#pragma unroll
                for (int bj = 0; bj < 2; ++bj)
#pragma unroll
                    for (int n = 0; n < 2; ++n) *(f32x4*)(out + off + bj * HALF + n * 16) = acc[ai][bj][m][n]; }
    }
};

template <class Epi, class Sched>
__device__ __forceinline__ void gemm_phase(LAS unsigned char* lds, const int K, const unsigned lda, const Sched& S, const Epi& E) {
    const int tid = threadIdx.x, wid = __builtin_amdgcn_readfirstlane(tid >> 6), lane = tid & 63, wr = wid >> 2, wc = wid & 3, fr = lane & 15, fq = lane >> 4;
    int nt = K / BK; asm volatile("" : "+s"(nt));
    unsigned voffA[2], voffB[2];
#pragma unroll
    for (int i = 0; i < 2; ++i) { int R, C; stage_rc(tid * 16 + i * 8192, R, C); const int Rb = Epi::PERM ? ((R & ~31) + perm32(R & 31)) : R;
        voffA[i] = (unsigned)R * lda + (unsigned)C * 2u; (void)Rb; }
    const size_t kstep = (size_t)(BK * 2);
    const size_t hstepA = (size_t)HALF * lda;
    const unsigned ldsw = (unsigned)wid * 1024u;
    const int aoff = lds_byte(wr * 64 + fr, fq * 8), boff = lds_byte(wc * 32 + fr, fq * 8);
#define PG8_SA(b, h) (((b) * 2 + (h)) * HTB)
#define PG8_SB(b, h) ((4 + (b) * 2 + (h)) * HTB)
#define PG8_STAGE(bufoff, gbase, voff) do { _Pragma("unroll") for (int _i = 0; _i < 2; ++_i) \
        __builtin_amdgcn_global_load_lds((const unsigned*)((const char*)(gbase) + (voff)[_i]), (LAS unsigned*)(lds + (bufoff) + ldsw + _i * 8192), 16, 0, 0); } while (0)
#define PG8_LDA(dst, b, h) do { _Pragma("unroll") for (int m = 0; m < 4; ++m) _Pragma("unroll") for (int k = 0; k < 2; ++k) dst[m][k] = *(const LAS bf16x8*)(lds + PG8_SA(b, h) + aoff + m * 2048 + k * 1024); } while (0)
#define PG8_LDB(dst, b, h) do { _Pragma("unroll") for (int n = 0; n < 2; ++n) _Pragma("unroll") for (int k = 0; k < 2; ++k) dst[n][k] = *(const LAS bf16x8*)(lds + PG8_SB(b, h) + boff + n * 2048 + k * 1024); } while (0)
#define PG8_MMA(ai, bj, At, Bt) do { __builtin_amdgcn_s_setprio(1); _Pragma("unroll") for (int m = 0; m < 4; ++m) _Pragma("unroll") for (int n = 0; n < 2; ++n) _Pragma("unroll") for (int k = 0; k < 2; ++k) \
        acc[ai][bj][m][n] = __builtin_amdgcn_mfma_f32_16x16x32_bf16(Bt[n][k], At[m][k], acc[ai][bj][m][n], 0, 0, 0); __builtin_amdgcn_s_setprio(0); } while (0)
#define PG8_WAIT_V(n) asm volatile("s_waitcnt vmcnt(" #n ")" ::: "memory")
#define PG8_WAIT_L(n) asm volatile("s_waitcnt lgkmcnt(" #n ")" ::: "memory")
#define PG8_BAR __builtin_amdgcn_s_barrier()
#define PG8_SCHED __builtin_amdgcn_sched_barrier(0)
#define PG8_SETB(u) do { _Pragma("unroll") for (int _i = 0; _i < 2; ++_i) { int R_, C_; stage_rc((int)(threadIdx.x) * 16 + _i * 8192, R_, C_); const int Rb_ = Epi::PERM ? ((R_ & ~31) + perm32(R_ & 31)) : R_; \
        voffB[_i] = (unsigned)Rb_ * (u).ldb + (unsigned)C_ * 2u; } hsB = (size_t)(u).hsb; } while (0)
    Unit cur, nxt; int ui = 0;
    if (!S.next(0, cur)) return;
    f32x4 acc[2][2][4][2];
    E.init(acc, cur, wr, wc, fr, fq);
    bf16x8 At[4][2], B0[2][2], B1[2][2];
    const char* cA = cur.A; const char* cB = cur.B; size_t hsB;
    PG8_SETB(cur);
    PG8_STAGE(PG8_SB(0, 0), cB, voffB); PG8_STAGE(PG8_SB(0, 1), cB + hsB, voffB); PG8_STAGE(PG8_SA(0, 0), cA, voffA); PG8_STAGE(PG8_SA(0, 1), cA + hstepA, voffA);
    if (wr == 1) PG8_BAR;
    PG8_WAIT_V(2); PG8_BAR;
    PG8_STAGE(PG8_SB(1, 0), cB + kstep, voffB); PG8_STAGE(PG8_SA(1, 0), cA + kstep, voffA); PG8_STAGE(PG8_SB(1, 1), cB + hsB + kstep, voffB);
    PG8_WAIT_V(6); PG8_BAR;
    for (;;) {
        const bool has_next = S.next(ui + 1, nxt);
        const char* nA = has_next ? nxt.A : cA; const char* nB = has_next ? nxt.B : cB;
        for (int t = 0; t < nt; t += 2) {
            const bool last = (t == nt - 2);
            const char* a1 = cA + (size_t)(t + 1) * kstep;
            const char* a2 = last ? nA : cA + (size_t)(t + 2) * kstep; const char* b2 = last ? nB : cB + (size_t)(t + 2) * kstep;
            const char* a3 = a2 + kstep; const char* b3 = b2 + kstep;
            if (last && has_next) PG8_SETB(nxt);
            PG8_LDB(B0, 0, 0); PG8_LDB(B1, 0, 1); PG8_SCHED; PG8_LDA(At, 0, 0); PG8_STAGE(PG8_SA(1, 1), a1 + hstepA, voffA);
            PG8_WAIT_V(8); PG8_WAIT_L(0); PG8_BAR; PG8_MMA(0, 0, At, B0); PG8_MMA(0, 1, At, B1); PG8_BAR; PG8_SCHED;
            PG8_LDA(At, 0, 1); PG8_STAGE(PG8_SB(0, 0), b2, voffB); PG8_STAGE(PG8_SB(0, 1), b2 + hsB, voffB); PG8_STAGE(PG8_SA(0, 0), a2, voffA);
            PG8_WAIT_V(8); PG8_WAIT_L(0); PG8_BAR; PG8_MMA(1, 0, At, B0); PG8_MMA(1, 1, At, B1); PG8_BAR; PG8_SCHED;
            PG8_LDB(B0, 1, 0); PG8_LDB(B1, 1, 1); PG8_SCHED; PG8_LDA(At, 1, 0); PG8_STAGE(PG8_SA(0, 1), a2 + hstepA, voffA);
            PG8_WAIT_V(8); PG8_WAIT_L(0); PG8_BAR; PG8_MMA(0, 0, At, B0); PG8_MMA(0, 1, At, B1); PG8_BAR; PG8_SCHED;
            PG8_LDA(At, 1, 1); PG8_STAGE(PG8_SB(1, 0), b3, voffB); PG8_STAGE(PG8_SB(1, 1), b3 + hsB, voffB); PG8_STAGE(PG8_SA(1, 0), a3, voffA);
            PG8_WAIT_V(8); PG8_WAIT_L(0); PG8_BAR; PG8_MMA(1, 0, At, B0); PG8_MMA(1, 1, At, B1); PG8_BAR; PG8_SCHED;
        }
        if (wr == 0) PG8_BAR;
        E(acc, cur, wr, wc, fr, fq);
        if (!has_next) break;
        E.init(acc, nxt, wr, wc, fr, fq);
        cur = nxt; cA = nA; cB = nB; ++ui;
        if (wr == 1) PG8_BAR;
    }
    PG8_WAIT_V(0);
    PG8_BAR;
#undef PG8_SA
#undef PG8_SB
#undef PG8_STAGE
#undef PG8_LDA
#undef PG8_LDB
#undef PG8_MMA
#undef PG8_WAIT_V
#undef PG8_WAIT_L
#undef PG8_BAR
#undef PG8_SCHED
#undef PG8_SETB
}
}

#define XB_TMO      128
#define XB_XCNT(j)  (256  + 64 * (j))
#define XB_XSUB(j)  (1280 + 64 * (j))
#define XB_XGEN(j)  (2304 + 64 * (j))
#define XB_TOP      3328
#define XB_TOPGEN   3392
#define XCD_BAR_WORDS 3456
#define XB_SPIN_CAP (1u << 18)
__device__ __forceinline__ unsigned xb_ld(unsigned* p)              { return __hip_atomic_load(p, __ATOMIC_RELAXED, __HIP_MEMORY_SCOPE_AGENT); }
__device__ __forceinline__ unsigned xb_add(unsigned* p, unsigned v) { return __hip_atomic_fetch_add(p, v, __ATOMIC_RELAXED, __HIP_MEMORY_SCOPE_AGENT); }
__device__ __forceinline__ unsigned xb_xcc_id() { return (unsigned)__builtin_amdgcn_s_getreg((3 << 11) | 20) & 0xFu; }
#define XB_SPIN(cond, bar) do { unsigned _sp = 0; while (cond) { __builtin_amdgcn_s_sleep(1); \
    if ((++_sp & 255u) == 0u) { if (xb_ld(&(bar)[XB_TMO])) break; if (_sp > XB_SPIN_CAP) { atomicAdd(&(bar)[XB_TMO], 1u); break; } } } } while (0)
struct XcdBarrier { unsigned* bar; unsigned x; volatile LAS unsigned* st; };
__device__ __forceinline__ XcdBarrier xcd_barrier_post(unsigned* bar, volatile LAS unsigned* st) {
    XcdBarrier b; b.bar = bar; b.x = xb_xcc_id(); b.st = st;
    if (threadIdx.x == 0) (void)xb_add(&bar[XB_XCNT(b.x)], 1u);
    return b;
}
__device__ __forceinline__ void xcd_barrier_complete(unsigned* bar, unsigned x, unsigned& nloc, unsigned& nx) {
    const unsigned G = gridDim.x * gridDim.y * gridDim.z;
    unsigned sum, cnt, mine, sp = 0u;
    for (;;) {
        sum = 0u; cnt = 0u; mine = 0u;
#pragma unroll
        for (unsigned j = 0; j < 16; ++j) { const unsigned c = xb_ld(&bar[XB_XCNT(j)]); sum += c; cnt += (c > 0u) ? 1u : 0u; mine = (j == x) ? c : mine; }
        if (sum == G) break;
        __builtin_amdgcn_s_sleep(1);
        if ((++sp & 255u) == 0u) { if (xb_ld(&bar[XB_TMO])) break; if (sp > XB_SPIN_CAP) { atomicAdd(&bar[XB_TMO], 1u); break; } }
    }
    nloc = mine > 0u ? mine : 1u; nx = cnt > 0u ? cnt : 1u;
}
__device__ __forceinline__ void xcd_barrier(const XcdBarrier& b) {
    asm volatile("s_waitcnt vmcnt(0)" ::: "memory");
    __syncthreads();
    if (threadIdx.x == 0) {
        unsigned* bar = b.bar;
        __builtin_amdgcn_s_waitcnt(0);
        unsigned nloc = b.st[0], nx = b.st[1];
        if (nloc == 0u) { xcd_barrier_complete(bar, b.x, nloc, nx); b.st[0] = nloc; b.st[1] = nx; }
        const unsigned old = xb_add(&bar[XB_XSUB(b.x)], 1u);
        const unsigned gen = old / nloc;
        if (old + 1u == (gen + 1u) * nloc) {
            __builtin_amdgcn_fence(__ATOMIC_RELEASE, "agent");
            asm volatile("s_waitcnt vmcnt(0)" ::: "memory");
            const unsigned og = xb_add(&bar[XB_TOP], 1u);
            const unsigned tg = og / nx;
            if (og + 1u == (tg + 1u) * nx) xb_add(&bar[XB_TOPGEN], 1u);
            else XB_SPIN(xb_ld(&bar[XB_TOPGEN]) == tg, bar);
            __builtin_amdgcn_fence(__ATOMIC_ACQUIRE, "agent");
            xb_add(&bar[XB_XGEN(b.x)], 1u);
            asm volatile("s_waitcnt vmcnt(0)" ::: "memory");
        } else {
            XB_SPIN(xb_ld(&bar[XB_XGEN(b.x)]) == gen, bar);
            __builtin_amdgcn_fence(__ATOMIC_ACQUIRE, "agent");
            asm volatile("s_waitcnt vmcnt(0)" ::: "memory");
        }
    }
    __syncthreads();
}

struct Job { int in, K, ld, col0, ncols, mode, sk, sidx; unsigned long long src, dst; unsigned item0; unsigned pad; };
constexpr int NJOBS = 60;
struct JobTab { Job j[NJOBS]; unsigned nitems; unsigned pad[3]; };
constexpr JobTab make_jobs() {
    JobTab t{}; int n = 0; unsigned it = 0;
    auto add = [&](int in, unsigned long long src, int K, int ld, int col0, int ncols, unsigned long long dst_elem, int mode, int sk, int sidx) {
        Job& q = t.j[n++]; q.in = in; q.K = K; q.ld = ld; q.col0 = col0; q.ncols = ncols; q.mode = mode; q.sk = sk; q.sidx = sidx; q.src = src; q.dst = dst_elem; q.item0 = it; q.pad = 0;
        it += (unsigned)((K / 64) * (ncols / 64)); };
    add(5, 0, 1024, 1024, 0, 1024, W_A_IN, 0, 0, 0);
    for (int g = 0; g < 4; ++g) add(6, (unsigned long long)g * 65536, 256, 256, 0, 256, W_A_GRP + (unsigned long long)g * 65536, 0, 2, g * 256);
    add(8, 0, 1024, 1024, 0, 1024, W_A_OUT, 0, 0, 0);
    for (int g = 0; g < 3; ++g) {
        add(9, 0, 1024, 9216, g * 3072, 1024, W_B_QK + (unsigned long long)g * 1048576, 0, 1, 0);
        add(9, 0, 1024, 9216, g * 3072 + 1024, 1024, W_B_QK + (unsigned long long)(3 + g) * 1048576, 0, 0, 0);
        add(9, 0, 1024, 9216, g * 3072 + 2048, 1024, W_B_V + (unsigned long long)g * 1048576, 0, 0, 0);
    }
    add(10, 0, 1024, 1024, 0, 1024, W_B_OUT, 0, 0, 0);
    add(11, 0, 1024, 3072, 0, 1024, W_C_QK, 0, 1, 0);
    add(11, 0, 1024, 3072, 1024, 1024, W_C_QK + 1048576, 0, 0, 0);
    add(11, 0, 1024, 3072, 2048, 1024, W_C_V, 0, 0, 0);
    add(14, 0, 1024, 1024, 0, 1024, W_C_OUT, 0, 0, 0);
    add(15, 0, 1024, 1536, 0, 1024, W_D_QK, 0, 1, 0);
    add(15, 0, 1024, 1536, 1024, 256, W_D_QK + 1048576, 0, 0, 0);
    add(15, 0, 1024, 1536, 1280, 256, W_D_V, 0, 0, 0);
    add(17, 0, 1024, 1024, 0, 1024, W_D_OUT, 0, 0, 0);
    for (int l = 0; l < 2; ++l) add(18, (unsigned long long)l * 1024 * 7168, 1024, 7168, 0, 7168, W_F_GU + (unsigned long long)l * 7168 * 1024, 1, 0, 0);
    for (int l = 0; l < 2; ++l) add(19, (unsigned long long)l * 3584 * 1024, 3584, 1024, 0, 1024, W_F_D + (unsigned long long)l * 3584 * 1024, 0, 0, 0);
    for (int l = 0; l < 16; ++l) add(21, (unsigned long long)l * 1024 * 7168, 1024, 7168, 0, 7168, W_M_GU + (unsigned long long)l * 7168 * 1024, 1, 0, 0);
    for (int l = 0; l < 16; ++l) add(22, (unsigned long long)l * 3584 * 1024, 3584, 1024, 0, 1024, W_M_D + (unsigned long long)l * 3584 * 1024, 0, 0, 0);
    t.nitems = it;
    return t;
}
__constant__ JobTab g_jobs = make_jobs();
static_assert(make_jobs().j[NJOBS - 1].K == 3584, "job count");

struct Args { const float* in[23]; float* out; unsigned char* ws; int ph_lo, ph_hi; };

struct Frame {
    LAS unsigned char* lds;
    int G, c, vcu;
    __device__ __forceinline__ int tid_() const { return (int)threadIdx.x; }
    __device__ __forceinline__ int lane_() const { return (int)threadIdx.x & 63; }
    __device__ __forceinline__ int wave_() const { return __builtin_amdgcn_readfirstlane((int)threadIdx.x >> 6); }
};

__device__ __forceinline__ void conv_item(const Job& jb, const float* __restrict__ src, bf16_t* __restrict__ dst, const float* __restrict__ cs, LAS unsigned* scr, unsigned item, int lane) {
    const int ntn = jb.ncols >> 6; const int kb = (int)item / ntn, nb = (int)item % ntn, k0 = kb * 64, n0 = nb * 64;
    int drow = n0;
    if (jb.mode == 1) { int n = n0; const bool up = n >= DFF; if (up) n -= DFF; drow = (n >> 7) * 256 + (n & 127) + (up ? 128 : 0); }
    const int a = lane & 15, b = lane >> 4;
    const float sc = (jb.sk == 1) ? QSCALE : 1.0f;
    f32x4 csv = (f32x4){sc, sc, sc, sc};
    if (jb.sk == 2) csv = *(const f32x4*)(cs + jb.sidx + n0 + 4 * a);
    const float* sp = src + (size_t)(k0 + 2 * b) * jb.ld + jb.col0 + n0 + 4 * a;
    f32x4 v0[8], v1[8];
#pragma unroll
    for (int i = 0; i < 8; ++i) { v0[i] = *(const f32x4*)(sp + (size_t)(8 * i) * jb.ld); v1[i] = *(const f32x4*)(sp + (size_t)(8 * i + 1) * jb.ld); }
#pragma unroll
    for (int i = 0; i < 8; ++i) { const f32x4 x0 = v0[i] * csv, x1 = v1[i] * csv; const int kp = 4 * i + b;
#pragma unroll
        for (int j = 0; j < 4; ++j) scr[(4 * a + j) * 33 + kp] = cvt_pk_bf16(x0[j], x1[j]); }
    LDS_WAIT();
    const int c = lane & 7;
#pragma unroll
    for (int jj = 0; jj < 8; ++jj) { const int n = (lane >> 3) + 8 * jj; const LAS unsigned* s = scr + n * 33 + 4 * c;
        u32x4 o; o.x = s[0]; o.y = s[1]; o.z = s[2]; o.w = s[3];
        *(u32x4*)(dst + (size_t)(drow + n) * jb.K + k0 + 8 * c) = o; }
    LDS_WAIT();
}

__device__ __forceinline__ int rel_bucket(int rel) {
    const int n = rel < 0 ? -rel : rel;
    int big = 8 + (int)(logf((float)(n < 1 ? 1 : n) / 8.0f) / 4.852030263919617f * 8.0f);
    big = big < 15 ? big : 15;
    return (rel > 0 ? 16 : 0) + (n < 8 ? n : big);
}

__device__ __forceinline__ void load_row(const float* xrow, int lane, f32x4 (&v)[4]) {
    const f32x4* xr = (const f32x4*)xrow + lane;
#pragma unroll
    for (int j = 0; j < 4; ++j) v[j] = xr[64 * j];
}
__device__ __forceinline__ float row_rstd(const f32x4 (&v)[4]) {
    float s = 0.f;
#pragma unroll
    for (int j = 0; j < 4; ++j) s += (v[j].x * v[j].x + v[j].y * v[j].y) + (v[j].z * v[j].z + v[j].w * v[j].w);
    return 1.0f / sqrtf(wave_sum(s) * (1.0f / DM) + RMS_EPS);
}
__device__ __forceinline__ void store_row_bf16(bf16_t* orow, int lane, const f32x4 (&v)[4]) {
    u32x2* o8 = (u32x2*)orow + lane;
#pragma unroll
    for (int j = 0; j < 4; ++j) { u32x2 w; w.x = cvt_pk_bf16(v[j].x, v[j].y); w.y = cvt_pk_bf16(v[j].z, v[j].w); o8[64 * j] = w; }
}
__device__ __forceinline__ void rms_phase(const Frame& F, const float* x, const float* gain, bf16_t* hn) {
    const int gw = F.c * NWAVES + F.wave_(), NGW = F.G * NWAVES;
    f32x4 g[4]; load_row(gain, F.lane_(), g);
    for (int m = gw; m < MTOK; m += NGW) {
        f32x4 v[4]; load_row(x + (size_t)m * DM, F.lane_(), v);
        const float rstd = row_rstd(v);
#pragma unroll
        for (int j = 0; j < 4; ++j) v[j] = v[j] * rstd * g[j];
        store_row_bf16(hn + (size_t)m * DM, F.lane_(), v);
    }
}

__device__ __forceinline__ int keyperm(int rho) { return (rho & 0x13) | ((rho & 4) << 1) | ((rho & 8) >> 1); }
template <int NVB> struct AttnAcc { f32x16 o[NVB]; float m, l; };
template <int NVB>
__device__ __forceinline__ void attn_tile(AttnAcc<NVB>& st, const bf16x8 (&qf)[4], const char* kptr, const char* vptr, const size_t vblk, const LAS float* bt) {
    bf16x8 kf[4], vf[NVB][2];
#pragma unroll
    for (int t = 0; t < 4; ++t) kf[t] = *(const bf16x8*)(kptr + t * 32);
#pragma unroll
    for (int b = 0; b < NVB; ++b)
#pragma unroll
        for (int t = 0; t < 2; ++t) vf[b][t] = *(const bf16x8*)(vptr + b * vblk + t * 32);
    f32x16 s;
#pragma unroll
    for (int r = 0; r < 16; ++r) s[r] = bt[(r >> 3) * 16 + (r & 7)];
#pragma unroll
    for (int t = 0; t < 4; ++t) s = __builtin_amdgcn_mfma_f32_32x32x16_bf16(kf[t], qf[t], s, 0, 0, 0);
    float mx = s[0];
#pragma unroll
    for (int r = 1; r < 16; ++r) mx = fmaxf(mx, s[r]);
    mx = fmaxf(mx, __shfl_xor(mx, 32));
    const float mn = fmaxf(st.m, mx), alpha = __builtin_amdgcn_exp2f(st.m - mn); st.m = mn;
    float ps = 0.f;
#pragma unroll
    for (int r = 0; r < 16; ++r) { s[r] = __builtin_amdgcn_exp2f(s[r] - mn); ps += s[r]; }
    st.l = st.l * alpha + ps;
#pragma unroll
    for (int b = 0; b < NVB; ++b) st.o[b] = st.o[b] * alpha;
    u32x4 p0, p1;
    p0.x = cvt_pk_bf16(s[0], s[1]); p0.y = cvt_pk_bf16(s[2], s[3]); p0.z = cvt_pk_bf16(s[4], s[5]); p0.w = cvt_pk_bf16(s[6], s[7]);
    p1.x = cvt_pk_bf16(s[8], s[9]); p1.y = cvt_pk_bf16(s[10], s[11]); p1.z = cvt_pk_bf16(s[12], s[13]); p1.w = cvt_pk_bf16(s[14], s[15]);
    const bf16x8 pf0 = __builtin_bit_cast(bf16x8, p0), pf1 = __builtin_bit_cast(bf16x8, p1);
#pragma unroll
    for (int b = 0; b < NVB; ++b) { st.o[b] = __builtin_amdgcn_mfma_f32_32x32x16_bf16(vf[b][0], pf0, st.o[b], 0, 0, 0); st.o[b] = __builtin_amdgcn_mfma_f32_32x32x16_bf16(vf[b][1], pf1, st.o[b], 0, 0, 0); }
}

template <int HALF>
__device__ __forceinline__ void band_item(const bf16_t* Qp, const bf16_t* Kp, const int ldqk, const size_t tok0, const int dil, const int L, const int q0,
                                          const bf16_t* Vt, const size_t vn0, const float* gtab_h, LAS float* tbl, const float m_init, const float l_init,
                                          bf16_t* out_row0  , const int ldo, float* lse_out  , const int lane) {
    const int ql = lane & 31, hf = lane >> 5;
    for (int i = lane; i < 2 * HALF + 63; i += 64) { const int j = i - HALF - 31; tbl[i] = (j >= -HALF && j <= HALF) ? gtab_h[j * dil + 2048] : NEG_BIG; }
    LDS_WAIT();
    const size_t qtok = tok0 + (size_t)(q0 + ql) * dil;
    bf16x8 qf[4];
#pragma unroll
    for (int t = 0; t < 4; ++t) qf[t] = *(const bf16x8*)(Qp + qtok * ldqk + 16 * t + 8 * hf);
    AttnAcc<2> st;
    st.o[0] = (f32x16){}; st.o[1] = (f32x16){}; st.m = m_init; st.l = (hf == 0) ? l_init : 0.f;
    const int kr = keyperm(ql);
    for (int kt = q0 - HALF; kt <= q0 + HALF; kt += 32) {
        if (kt < 0 || kt >= L) continue;
        const char* kptr = (const char*)(Kp + (tok0 + (size_t)(kt + kr) * dil) * ldqk + 8 * hf);
        const char* vptr = (const char*)(Vt + (size_t)ql * MTOK + vn0 + kt + 8 * hf);
        const LAS float* bt = tbl + (kt - q0 + HALF) + 8 * hf - ql + 31;
        attn_tile<2>(st, qf, kptr, vptr, (size_t)32 * MTOK * 2, bt);
    }
    const float lt = st.l + __shfl_xor(st.l, 32), inv = 1.0f / lt;
    bf16_t* orow = out_row0 + qtok * ldo;
#pragma unroll
    for (int b = 0; b < 2; ++b)
#pragma unroll
        for (int i = 0; i < 4; ++i) { u32x2 w; w.x = cvt_pk_bf16(st.o[b][4 * i] * inv, st.o[b][4 * i + 1] * inv); w.y = cvt_pk_bf16(st.o[b][4 * i + 2] * inv, st.o[b][4 * i + 3] * inv);
            *(u32x2*)(orow + 32 * b + 8 * i + 4 * hf) = w; }
    if (lse_out && hf == 0) lse_out[qtok * 16] = st.m + __builtin_amdgcn_logf(lt);
}

struct PlainSched {
    const char* A; const char* B; unsigned lda, ldb; int nM, nN, G, c; size_t co_m, co_n;
    __device__ __forceinline__ bool next(int i, pg8::Unit& u) const {
        const long L = (long)i * G + c; if (L >= (long)nM * nN) return false;
        int pm, pn; pg8::tile_order(nM, nN, (int)L, pm, pn);
        u.A = A + (size_t)pm * 256 * lda; u.B = B + (size_t)pn * 256 * ldb; u.ldb = ldb; u.hsb = 128u * ldb; u.co = (size_t)pm * co_m + (size_t)pn * co_n; u.tag = 0; return true;
    }
};
struct QkvSched {
    const char* hn; const char* Wqk; const char* Wv; int nNqk, nvp, nMv, dshift, G, c; int ldqk;
    __device__ __forceinline__ bool next(int i, pg8::Unit& u) const {
        long L = (long)i * G + c; const int n0 = 64 * nNqk, nv = nMv * 64;
        if (L < n0) { int pm, pn; pg8::tile_order(64, nNqk, (int)L, pm, pn);
            u.A = hn + (size_t)pm * 256 * 2048; u.B = Wqk + (size_t)pn * 256 * 2048; u.ldb = 2048u; u.hsb = 128u * 2048u; u.co = (size_t)pm * 256 * ldqk + (size_t)pn * 256; u.tag = 0; return true; }
        L -= n0; if (L >= (long)nvp * nv) return false;
        const int g = (int)(L / nv); int pm, pn; pg8::tile_order(nMv, 64, (int)(L % nv), pm, pn);
        const int d = 1 << (dshift * g), b = pn >> 3, nn = (pn & 7) * 256;
        size_t tok; unsigned ldb, hsb;
        if (d == 1) { tok = (size_t)b * SEQ + nn; ldb = 2048u; hsb = 128u * 2048u; }
        else if (d == 4) { tok = (size_t)b * SEQ + (size_t)(nn & 511) * 4 + (nn >> 9); ldb = 4u * 2048u; hsb = 128u * 4u * 2048u; }
        else { tok = (size_t)b * SEQ + (nn >> 7); ldb = 16u * 2048u; hsb = 2048u; }
        u.A = Wv + (size_t)(g * nMv + pm) * 256 * 2048; u.B = hn + tok * 2048; u.ldb = ldb; u.hsb = hsb;
        u.co = (size_t)(g * nMv + pm) * 256 * MTOK + (size_t)pn * 256; u.tag = 1; return true;
    }
};
struct MoeSched {
    const char* A; const char* B; unsigned lda, ldb; const int* panel; size_t estride; int nN, G, c; size_t co_m, co_n;
    __device__ __forceinline__ bool next(int i, pg8::Unit& u) const {
        const int nM = panel[0]; const long L = (long)i * G + c; if (L >= (long)nM * nN) return false;
        int pm, pn; pg8::tile_order(nM, nN, (int)L, pm, pn); const int e = panel[4 + pm];
        u.A = A + (size_t)pm * 256 * lda; u.B = B + (size_t)e * estride + (size_t)pn * 256 * ldb; u.ldb = ldb; u.hsb = 128u * ldb; u.co = (size_t)pm * co_m + (size_t)pn * co_n; u.tag = 0; return true;
    }
};

__device__ __forceinline__ void moe_route(const Frame& F, const float* x, const float* gain, const float* router, bf16_t* hn, int* e12, float* g1o, float* g2o, int* cnt_wg) {
    LAS float* Rt = (LAS float*)F.lds;
    LAS int* cnt = (LAS int*)(F.lds + 32768);
    for (int i = F.tid_(); i < DM * NE; i += NWAVES * 64) { const int k = i >> 3, e = i & 7; Rt[e * DM + k] = router[i]; }
    f32x4 g[4]; load_row(gain, F.lane_(), g);
    for (int ch = F.c; ch < MTOK / 64; ch += F.G) {
        if (F.tid_() < 8) cnt[F.tid_()] = 0;
        __syncthreads();
        for (int i = 0; i < 8; ++i) {
            const int m = ch * 64 + F.wave_() * 8 + i;
            f32x4 v[4]; load_row(x + (size_t)m * DM, F.lane_(), v);
            const float rstd = row_rstd(v);
#pragma unroll
            for (int j = 0; j < 4; ++j) v[j] = v[j] * rstd * g[j];
            store_row_bf16(hn + (size_t)m * DM, F.lane_(), v);
            float lg[8];
#pragma unroll
            for (int e = 0; e < 8; ++e) { float s = 0.f;
#pragma unroll
                for (int j = 0; j < 4; ++j) { const f32x4 r = *(const LAS f32x4*)(Rt + e * DM + 4 * F.lane_() + 256 * j); s += (v[j].x * r.x + v[j].y * r.y) + (v[j].z * r.z + v[j].w * r.w); }
                lg[e] = wave_sum(s); }
            int e1 = 0; float v1 = lg[0];
#pragma unroll
            for (int e = 1; e < 8; ++e) if (lg[e] > v1) { v1 = lg[e]; e1 = e; }
            int e2 = -1; float v2 = -3.4e38f;
#pragma unroll
            for (int e = 0; e < 8; ++e) if (e != e1 && lg[e] > v2) { v2 = lg[e]; e2 = e; }
            const float ex = __expf(v2 - v1), ga = 1.0f / (1.0f + ex), gb = ex * ga;
            if (F.lane_() == 0) { e12[m] = e1 | (e2 << 8); g1o[m] = ga; g2o[m] = gb; atomicAdd((int*)&cnt[e1], 1); atomicAdd((int*)&cnt[e2], 1); }
        }
        __syncthreads();
        if (F.tid_() < 8) cnt_wg[ch * 8 + F.tid_()] = cnt[F.tid_()];
        __syncthreads();
    }
}
__device__ __forceinline__ void moe_assign(const Frame& F, const bf16_t* hn, const int* e12, const int* cnt_wg, int* p1o, int* p2o, int* panel, bf16_t* hs) {
    LAS int* psum = (LAS int*)F.lds;
    LAS int* tot = psum + 512; LAS int* base = tot + 8; LAS int* off = base + 8;
    LAS int* plist = off + 16;
    for (int ch = F.c; ch < MTOK / 64; ch += F.G) {
        { const int e = F.tid_() & 7, part = F.tid_() >> 3; int s = 0;
#pragma unroll
          for (int q = 0; q < 4; ++q) s += cnt_wg[(4 * part + q) * 8 + e];
          psum[part * 8 + e] = s; }
        __syncthreads();
        if (F.tid_() < 8) { const int e = F.tid_(); int t = 0, b = 0; for (int p = 0; p < 64; ++p) { const int s = psum[p * 8 + e]; if (p < (ch >> 2)) b += s; t += s; }
            for (int q = 0; q < (ch & 3); ++q) b += cnt_wg[(4 * (ch >> 2) + q) * 8 + e];
            tot[e] = t; base[e] = b; }
        __syncthreads();
        if (F.tid_() == 0) { int o = 0; for (int e = 0; e < 8; ++e) { off[e] = o; o += (tot[e] + 255) & ~255; } off[8] = o; }
        __syncthreads();
        if (F.wave_() == 0) {
            const int m = ch * 64 + F.lane_(); const int ee = e12[m]; const int e1 = ee & 255, e2 = ee >> 8; int p1 = 0, p2 = 0;
#pragma unroll
            for (int e = 0; e < 8; ++e) { const unsigned long long mk = __ballot(e1 == e || e2 == e); const int rk = __popcll(mk & ((1ull << F.lane_()) - 1ull));
                if (e1 == e) p1 = off[e] + base[e] + rk; if (e2 == e) p2 = off[e] + base[e] + rk; }
            p1o[m] = p1; p2o[m] = p2; plist[2 * F.lane_()] = p1; plist[2 * F.lane_() + 1] = p2;
        }
        __syncthreads();
        for (int i = 0; i < 16; ++i) { const int pr = F.wave_() * 16 + i; const int m = ch * 64 + (pr >> 1); const int pos = plist[pr];
            const u32x4* s = (const u32x4*)(hn + (size_t)m * DM); u32x4* d = (u32x4*)(hs + (size_t)pos * DM);
            const u32x4 a = s[F.lane_()], b = s[64 + F.lane_()]; d[F.lane_()] = a; d[64 + F.lane_()] = b; }
        if (ch < 8) { const int e = ch; for (int r = off[e] + tot[e] + F.wave_(); r < off[e + 1]; r += NWAVES) { u32x4* d = (u32x4*)(hs + (size_t)r * DM); d[F.lane_()] = (u32x4){0, 0, 0, 0}; d[64 + F.lane_()] = (u32x4){0, 0, 0, 0}; } }
        if (ch == 0) { if (F.tid_() == 0) panel[0] = off[8] >> 8;
            if (F.tid_() < NPANEL_MAX) { const int r = F.tid_() * 256; int e = 0;
#pragma unroll
                for (int q = 1; q < 8; ++q) if (r >= off[q]) e = q;
                panel[4 + F.tid_()] = e; } }
        __syncthreads();
    }
}
__device__ __forceinline__ void moe_combine(const Frame& F, const float* x, const bf16_t* ys, const int* p1, const int* p2, const float* g1, const float* g2, const float* gain, float* xo, bf16_t* hn, float* outf) {
    const int gw = F.c * NWAVES + F.wave_(), NGW = F.G * NWAVES;
    f32x4 g[4]; load_row(gain, F.lane_(), g);
    for (int m = gw; m < MTOK; m += NGW) {
        f32x4 v[4]; load_row(x + (size_t)m * DM, F.lane_(), v);
        const float ga = g1[m], gb = g2[m];
        const u32x2* ya = (const u32x2*)(ys + (size_t)p1[m] * DM) + F.lane_(); const u32x2* yb = (const u32x2*)(ys + (size_t)p2[m] * DM) + F.lane_();
#pragma unroll
        for (int j = 0; j < 4; ++j) { const u32x2 a = ya[64 * j], b = yb[64 * j];
            v[j].x += ga * bf_lo(a.x) + gb * bf_lo(b.x); v[j].y += ga * bf_hi(a.x) + gb * bf_hi(b.x); v[j].z += ga * bf_lo(a.y) + gb * bf_lo(b.y); v[j].w += ga * bf_hi(a.y) + gb * bf_hi(b.y); }
        if (xo) { f32x4* o = (f32x4*)(xo + (size_t)m * DM) + F.lane_();
#pragma unroll
            for (int j = 0; j < 4; ++j) o[64 * j] = v[j]; }
        const float rstd = row_rstd(v);
#pragma unroll
        for (int j = 0; j < 4; ++j) v[j] = v[j] * rstd * g[j];
        if (outf) { f32x4* o = (f32x4*)(outf + (size_t)m * DM) + F.lane_();
#pragma unroll
            for (int j = 0; j < 4; ++j) o[64 * j] = v[j]; }
        else store_row_bf16(hn + (size_t)m * DM, F.lane_(), v);
    }
}


__global__ void __launch_bounds__(NWAVES * 64, 2) enc_fwd(Args args) {
    extern __shared__ __attribute__((aligned(16))) unsigned char lds_raw[];
    Frame F;
    F.lds = (LAS unsigned char*)lds_raw;
    F.G = gridDim.x; F.c = blockIdx.x; F.vcu = (F.G % 8 == 0) ? (F.c % 8) * (F.G / 8) + F.c / 8 : F.c;
    unsigned char* ws = args.ws;
    volatile LAS unsigned* MISC = (volatile LAS unsigned*)(F.lds + MISC_OFF);
    for (int u = F.tid_(); u < (LDS_BYTES - LDSCTL_OFF) / 4; u += NWAVES * 64) ((LAS unsigned*)(F.lds + LDSCTL_OFF))[u] = 0u;
    __syncthreads();
#if MK_MULTI
    #define GRID_BAR() do { } while (0)
#else
    XcdBarrier bar = xcd_barrier_post((unsigned*)(ws + WS_CTL) + CW_BAR, MISC + 8);
    #define GRID_BAR() xcd_barrier(bar)
#endif
    const int lo = args.ph_lo, hi = args.ph_hi;
#define IN(k) (lo <= (k) && (k) < hi)
#define SEAM(k) do { if (IN((k) + 1)) GRID_BAR(); } while (0)

    const float* x_in = args.in[0]; const float* rel_bias = args.in[1]; const float* norm_mix = args.in[2]; const float* norm_ffn = args.in[3]; const float* norm_final = args.in[4];
    bf16_t* Wb = (bf16_t*)(ws + WS_W);
    float* gtab = (float*)(ws + WS_TAB); float* misc = (float*)(ws + WS_MISC);
    int* r_e12 = (int*)(ws + WS_ROUTE); float* r_g1 = (float*)(ws + WS_ROUTE + 65536); float* r_g2 = (float*)(ws + WS_ROUTE + 2 * 65536);
    int* r_p1 = (int*)(ws + WS_ROUTE + 3 * 65536); int* r_p2 = (int*)(ws + WS_ROUTE + 4 * 65536);
    int* cnt_wg = (int*)(ws + WS_CNT); int* panel = (int*)(ws + WS_PANEL);
    float* XA = (float*)(ws + WS_XA); float* XB = (float*)(ws + WS_XB);
    bf16_t* HN = (bf16_t*)(ws + WS_HN); bf16_t* BUFA = (bf16_t*)(ws + WS_BUFA); bf16_t* BUFB = (bf16_t*)(ws + WS_BUFB); bf16_t* BUFC = (bf16_t*)(ws + WS_BUFC);
    bf16_t* BIG = (bf16_t*)(ws + WS_BIG); bf16_t* VT = (bf16_t*)(ws + WS_VT); bf16_t* OG = (bf16_t*)(ws + WS_OG); float* LSE = (float*)(ws + WS_LSE);
    bf16_t* HS = VT; bf16_t* YS = OG;
    LAS unsigned char* ring = F.lds;

#define PLAIN_GEMM(EPI, Aptr, Bptr, K_, lda_, ldb_, nM_, nN_, com_, con_) do { \
        PlainSched S_{(const char*)(Aptr), (const char*)(Bptr), (unsigned)(lda_), (unsigned)(ldb_), (nM_), (nN_), F.G, F.c, (size_t)(com_), (size_t)(con_)}; \
        pg8::gemm_phase(ring, (K_), (unsigned)(lda_), S_, EPI); } while (0)

#define DENSE_FFN(p, l, xr, xo) \
    if (IN(p)) { pg8::EpiSwiglu E_{BIG, DFF}; PLAIN_GEMM(E_, HN, Wb + W_F_GU + (size_t)(l) * 7168 * 1024, 1024, 2048, 2048, 64, 28, 256 * DFF, 128); SEAM(p); } \
    if (IN((p) + 1)) { pg8::EpiResid E_{(xr), (xo)}; PLAIN_GEMM(E_, BIG, Wb + W_F_D + (size_t)(l) * 3584 * 1024, 3584, 7168, 7168, 64, 4, 256 * DM, 256); SEAM((p) + 1); }

#define MOE_FFN(p, l, xr, gain) \
    if (IN(p)) { moe_route(F, (xr), (gain), args.in[20] + (size_t)(l) * DM * NE, HN, r_e12, r_g1, r_g2, cnt_wg); SEAM(p); } \
    if (IN((p) + 1)) { moe_assign(F, HN, r_e12, cnt_wg, r_p1, r_p2, panel, HS); SEAM((p) + 1); } \
    if (IN((p) + 2)) { pg8::EpiSwiglu E_{BIG, DFF}; MoeSched S_{(const char*)HS, (const char*)(Wb + W_M_GU + (size_t)(l) * 8 * 7168 * 1024), 2048u, 2048u, panel, (size_t)7168 * 1024 * 2, 28, F.G, F.c, (size_t)256 * DFF, (size_t)128}; \
        pg8::gemm_phase(ring, 1024, 2048u, S_, E_); SEAM((p) + 2); } \
    if (IN((p) + 3)) { pg8::EpiBf16 E_{YS, DM, YS, DM}; MoeSched S_{(const char*)BIG, (const char*)(Wb + W_M_D + (size_t)(l) * 8 * 3584 * 1024), 7168u, 7168u, panel, (size_t)3584 * 1024 * 2, 4, F.G, F.c, (size_t)256 * DM, (size_t)256}; \
        pg8::gemm_phase(ring, 3584, 7168u, S_, E_); SEAM((p) + 3); }

    if (IN(0)) {
        LAS unsigned* scr = (LAS unsigned*)(F.lds + F.wave_() * 8448);
        const unsigned gw = (unsigned)(F.c * NWAVES + F.wave_()), NGW = (unsigned)(F.G * NWAVES);
        int jn = 0;
        for (unsigned it = gw; it < g_jobs.nitems; it += NGW) {
            while (jn + 1 < NJOBS && g_jobs.j[jn + 1].item0 <= it) ++jn;
            const Job& jb = g_jobs.j[jn];
            conv_item(jb, args.in[jb.in] + jb.src, Wb + jb.dst, args.in[7], scr, it - jb.item0, F.lane_());
        }
        for (int i = F.c * NWAVES * 64 + F.tid_(); i < 16 * 4096; i += F.G * NWAVES * 64) { const int h = i >> 12, idx = i & 4095; gtab[i] = rel_bias[rel_bucket(idx - 2048) * 16 + h] * LOG2E; }
        if (F.c == 0 && F.tid_() == 0) { const float* lv = args.in[12]; float s0 = 0.f, s1 = 0.f; for (int i = 0; i < 64; ++i) { s0 += lv[i] * lv[64 + i]; s1 += lv[128 + i] * lv[192 + i]; }
            const float lam_init = 0.8f - 0.6f * expf(-0.3f * 2.0f); misc[0] = expf(s0) - expf(s1) + lam_init; misc[1] = lam_init; }
        rms_phase(F, x_in, norm_mix, HN);
        SEAM(0);
    }
    if (IN(1)) { pg8::EpiBf16 E_{BUFA, DM, BUFA, DM}; PLAIN_GEMM(E_, HN, Wb + W_A_IN, 1024, 2048, 2048, 64, 4, 256 * DM, 256); SEAM(1); }
    if (IN(2)) {
        for (int it = F.c * NWAVES * 64 + F.tid_(); it < MTOK * 128; it += F.G * NWAVES * 64) {
            const int t = it >> 7, cc = it & 127, g = cc >> 5, hw = 1 << g, s = t & (SEQ - 1);
            const int lo_ = (s - hw) < 0 ? 0 : s - hw, hi_ = (s + hw) > SEQ ? SEQ : s + hw;
            const bf16_t* base = BUFA + (size_t)(t - s) * DM + cc * 8;
            float a[8] = {0, 0, 0, 0, 0, 0, 0, 0};
            for (int r = lo_; r < hi_; ++r) { const u32x4 w = *(const u32x4*)(base + (size_t)r * DM);
                a[0] += bf_lo(w.x); a[1] += bf_hi(w.x); a[2] += bf_lo(w.y); a[3] += bf_hi(w.y); a[4] += bf_lo(w.z); a[5] += bf_hi(w.z); a[6] += bf_lo(w.w); a[7] += bf_hi(w.w); }
            const float ic = 1.0f / (float)(hi_ - lo_); const u32x4 w = *(const u32x4*)(base + (size_t)s * DM);
            u32x4 o; o.x = cvt_pk_bf16(a[0] * ic - bf_lo(w.x), a[1] * ic - bf_hi(w.x)); o.y = cvt_pk_bf16(a[2] * ic - bf_lo(w.y), a[3] * ic - bf_hi(w.y));
            o.z = cvt_pk_bf16(a[4] * ic - bf_lo(w.z), a[5] * ic - bf_hi(w.z)); o.w = cvt_pk_bf16(a[6] * ic - bf_lo(w.w), a[7] * ic - bf_hi(w.w));
            *(u32x4*)(BUFB + (size_t)t * DM + cc * 8) = o;
        }
        SEAM(2);
    }
    if (IN(3)) {
        struct GrpSched { const char* A; const char* B; int G, c;
            __device__ __forceinline__ bool next(int i, pg8::Unit& u) const { const int L = i * G + c; if (L >= 256) return false; int pm, pn; pg8::tile_order(64, 4, L, pm, pn);
                u.A = A + (size_t)pm * 256 * 2048 + pn * 512; u.B = B + (size_t)pn * 65536 * 2; u.ldb = 512u; u.hsb = 128u * 512u; u.co = (size_t)pm * 256 * DM + pn * 256; u.tag = 0; return true; } };
        GrpSched S_{(const char*)BUFB, (const char*)(Wb + W_A_GRP), F.G, F.c}; pg8::EpiBf16 E_{BUFC, DM, BUFC, DM};
        pg8::gemm_phase(ring, 256, 2048u, S_, E_); SEAM(3);
    }
    if (IN(4)) { pg8::EpiResid E_{x_in, XA}; PLAIN_GEMM(E_, BUFC, Wb + W_A_OUT, 1024, 2048, 2048, 64, 4, 256 * DM, 256); SEAM(4); }
    if (IN(5)) { rms_phase(F, XA, norm_ffn, HN); SEAM(5); }
    DENSE_FFN(6, 0, XA, XB)
    if (IN(8)) { rms_phase(F, XB, norm_mix + DM, HN); SEAM(8); }
    if (IN(9)) {
        QkvSched S_{(const char*)HN, (const char*)(Wb + W_B_QK), (const char*)(Wb + W_B_V), 24, 3, 4, 2, F.G, F.c, 6144};
        pg8::EpiBf16 E_{BIG, 6144, VT, MTOK}; pg8::gemm_phase(ring, 1024, 2048u, S_, E_); SEAM(9);
    }
    if (IN(10)) {
        LAS float* tbl = (LAS float*)(F.lds + F.wave_() * 2048);
        for (int i = 0; i < 12; ++i) {
            const int w = (i * F.G + F.vcu) * NWAVES + F.wave_(); if (w >= 3 * 8192) break;
            const int g = w >> 13, rest = w & 8191, b = rest >> 10, h = (rest >> 6) & 15, blk = rest & 63;
            const int dil = (g == 0) ? 1 : (g == 1 ? 4 : 16), L = SEQ / dil, nqb = L >> 5, r = blk / nqb, qb = blk % nqb;
            band_item<64>(BIG + g * 1024 + h * 64, BIG + 3072 + g * 1024 + h * 64, 6144, (size_t)b * SEQ + r, dil, L, qb * 32,
                          VT + (size_t)(g * 1024 + h * 64) * MTOK, (size_t)b * SEQ + (size_t)r * L, gtab + h * 4096, tbl, NEG_BIG, 0.f,
                          OG + (size_t)g * MTOK * DM + h * 64, DM, LSE + (size_t)g * MTOK * 16 + h, F.lane_());
        }
        SEAM(10);
    }
    if (IN(11)) {
        for (int it = F.c * NWAVES * 64 + F.tid_(); it < MTOK * 128; it += F.G * NWAVES * 64) {
            const int t = it >> 7, cc = it & 127, h = cc >> 3;
            const float l0 = LSE[(size_t)t * 16 + h], l1 = LSE[(size_t)(MTOK + t) * 16 + h], l2 = LSE[(size_t)(2 * MTOK + t) * 16 + h];
            const float mx = fmaxf(l0, fmaxf(l1, l2)); float w0 = __builtin_amdgcn_exp2f(l0 - mx), w1 = __builtin_amdgcn_exp2f(l1 - mx), w2 = __builtin_amdgcn_exp2f(l2 - mx);
            const float inv = 1.0f / (w0 + w1 + w2); w0 *= inv; w1 *= inv; w2 *= inv;
            const size_t o = (size_t)t * DM + cc * 8;
            const u32x4 a = *(const u32x4*)(OG + o), b = *(const u32x4*)(OG + (size_t)MTOK * DM + o), c = *(const u32x4*)(OG + 2 * (size_t)MTOK * DM + o);
            u32x4 r;
            r.x = cvt_pk_bf16(w0 * bf_lo(a.x) + w1 * bf_lo(b.x) + w2 * bf_lo(c.x), w0 * bf_hi(a.x) + w1 * bf_hi(b.x) + w2 * bf_hi(c.x));
            r.y = cvt_pk_bf16(w0 * bf_lo(a.y) + w1 * bf_lo(b.y) + w2 * bf_lo(c.y), w0 * bf_hi(a.y) + w1 * bf_hi(b.y) + w2 * bf_hi(c.y));
            r.z = cvt_pk_bf16(w0 * bf_lo(a.z) + w1 * bf_lo(b.z) + w2 * bf_lo(c.z), w0 * bf_hi(a.z) + w1 * bf_hi(b.z) + w2 * bf_hi(c.z));
            r.w = cvt_pk_bf16(w0 * bf_lo(a.w) + w1 * bf_lo(b.w) + w2 * bf_lo(c.w), w0 * bf_hi(a.w) + w1 * bf_hi(b.w) + w2 * bf_hi(c.w));
            *(u32x4*)(BUFA + o) = r;
        }
        SEAM(11);
    }
    if (IN(12)) { pg8::EpiResid E_{XB, XA}; PLAIN_GEMM(E_, BUFA, Wb + W_B_OUT, 1024, 2048, 2048, 64, 4, 256 * DM, 256); SEAM(12); }
    MOE_FFN(13, 0, XA, norm_ffn + DM)
    if (IN(17)) { moe_combine(F, XA, YS, r_p1, r_p2, r_g1, r_g2, norm_mix + 2 * DM, XB, HN, nullptr); SEAM(17); }
    if (IN(18)) {
        QkvSched S_{(const char*)HN, (const char*)(Wb + W_C_QK), (const char*)(Wb + W_C_V), 8, 1, 4, 0, F.G, F.c, 2048};
        pg8::EpiBf16 E_{BIG, 2048, VT, MTOK}; pg8::gemm_phase(ring, 1024, 2048u, S_, E_); SEAM(18);
    }
    if (IN(19)) {
        LAS float* tabL = (LAS float*)F.lds;
        LAS float* xch = (LAS float*)(F.lds + 32768);
        const float lam = misc[0], post = 1.0f - misc[1];
        const int j = F.wave_() & 1, sub = F.wave_() >> 1, ql = F.lane_() & 31, hf = F.lane_() >> 5, kr = keyperm(ql);
        for (int i = 0; i < 4; ++i) {
            const int u = i * F.G + F.vcu; if (u >= 1024) break;
            const int b = u >> 7, h = (u >> 4) & 7, qblk = u & 15;
            __syncthreads();
            for (int q = F.tid_(); q < 2 * 4096; q += NWAVES * 64) tabL[q] = gtab[(2 * h) * 4096 + q];
            __syncthreads();
            const int q0 = qblk * 128 + sub * 32; const size_t tok0 = (size_t)b * SEQ;
            const bf16_t* Qp = BIG + (2 * h + j) * 64; const bf16_t* Kp = BIG + 1024 + (2 * h + j) * 64;
            const size_t qtok = tok0 + q0 + ql;
            bf16x8 qf[4];
#pragma unroll
            for (int t = 0; t < 4; ++t) qf[t] = *(const bf16x8*)(Qp + qtok * 2048 + 16 * t + 8 * hf);
            AttnAcc<4> st;
#pragma unroll
            for (int bb = 0; bb < 4; ++bb) st.o[bb] = (f32x16){};
            st.m = NEG_BIG; st.l = 0.f;
            const bf16_t* Vh = VT + (size_t)(h * 128 + ql) * MTOK + tok0 + 8 * hf;
            for (int kt = 0; kt < SEQ; kt += 32) {
                const char* kptr = (const char*)(Kp + (tok0 + kt + kr) * 2048 + 8 * hf);
                const char* vptr = (const char*)(Vh + kt);
                const LAS float* bt = tabL + j * 4096 + kt + 8 * hf - (q0 + ql) + 2048;
                attn_tile<4>(st, qf, kptr, vptr, (size_t)32 * MTOK * 2, bt);
            }
            const float lt = st.l + __shfl_xor(st.l, 32), inv = 1.0f / lt;
            if (j == 1) {
#pragma unroll
                for (int bb = 0; bb < 4; ++bb)
#pragma unroll
                    for (int r = 0; r < 16; ++r) xch[(sub * 64 + bb * 16 + r) * 64 + F.lane_()] = st.o[bb][r] * inv;
            }
            __syncthreads();
            if (j == 0) {
                float ss = 0.f;
#pragma unroll
                for (int bb = 0; bb < 4; ++bb)
#pragma unroll
                    for (int r = 0; r < 16; ++r) { const float v = st.o[bb][r] * inv - lam * xch[(sub * 64 + bb * 16 + r) * 64 + F.lane_()]; st.o[bb][r] = v; ss += v * v; }
                ss += __shfl_xor(ss, 32);
                const float rstd = post / sqrtf(ss * (1.0f / 128.0f) + RMS_EPS);
                const float* sg = args.in[13];
                bf16_t* orow = BUFA + qtok * DM + h * 128;
#pragma unroll
                for (int bb = 0; bb < 4; ++bb)
#pragma unroll
                    for (int i4 = 0; i4 < 4; ++i4) { const int d = 32 * bb + 8 * i4 + 4 * hf; const f32x4 gg = *(const f32x4*)(sg + d);
                        u32x2 w; w.x = cvt_pk_bf16(st.o[bb][4 * i4] * rstd * gg.x, st.o[bb][4 * i4 + 1] * rstd * gg.y); w.y = cvt_pk_bf16(st.o[bb][4 * i4 + 2] * rstd * gg.z, st.o[bb][4 * i4 + 3] * rstd * gg.w);
                        *(u32x2*)(orow + d) = w; }
            }
        }
        SEAM(19);
    }
    if (IN(20)) { pg8::EpiResid E_{XB, XA}; PLAIN_GEMM(E_, BUFA, Wb + W_C_OUT, 1024, 2048, 2048, 64, 4, 256 * DM, 256); SEAM(20); }
    if (IN(21)) { rms_phase(F, XA, norm_ffn + 2 * DM, HN); SEAM(21); }
    DENSE_FFN(22, 1, XA, XB)
    if (IN(24)) { rms_phase(F, XB, norm_mix + 3 * DM, HN); SEAM(24); }
    if (IN(25)) {
        QkvSched S_{(const char*)HN, (const char*)(Wb + W_D_QK), (const char*)(Wb + W_D_V), 5, 1, 1, 0, F.G, F.c, 1280};
        pg8::EpiBf16 E_{BIG, 1280, VT, MTOK}; pg8::gemm_phase(ring, 1024, 2048u, S_, E_); SEAM(25);
    }
    if (IN(26)) {
        LAS float* tbl = (LAS float*)(F.lds + F.wave_() * 2048);
        const float* sink = args.in[16];
        for (int i = 0; i < 4; ++i) {
            const int w = (i * F.G + F.vcu) * NWAVES + F.wave_(); if (w >= 8192) break;
            const int b = w >> 10, kvh = (w >> 8) & 3, qb = (w >> 2) & 63, qh = kvh * 4 + (w & 3);
            band_item<128>(BIG + qh * 64, BIG + 1024 + kvh * 64, 1280, (size_t)b * SEQ, 1, SEQ, qb * 32,
                           VT + (size_t)(kvh * 64) * MTOK, (size_t)b * SEQ, gtab + qh * 4096, tbl, sink[qh] * LOG2E, 1.0f,
                           BUFA + qh * 64, DM, nullptr, F.lane_());
        }
        SEAM(26);
    }
    if (IN(27)) { pg8::EpiResid E_{XB, XA}; PLAIN_GEMM(E_, BUFA, Wb + W_D_OUT, 1024, 2048, 2048, 64, 4, 256 * DM, 256); SEAM(27); }
    MOE_FFN(28, 1, XA, norm_ffn + 3 * DM)
    if (IN(32)) { moe_combine(F, XA, YS, r_p1, r_p2, r_g1, r_g2, norm_final, nullptr, nullptr, args.out); }
#undef IN
#undef SEAM
}
constexpr int N_PHASES = 33;

extern "C" void kernel_launch(void* const* d_in, const int* in_sizes, int n_in, void* d_out, int out_size, void* d_ws, size_t ws_size, hipStream_t stream) {
    static int grid = 0;
    if (grid == 0) {
        if (n_in != 23 || out_size != MTOK * DM || ws_size < WS_END) { fprintf(stderr, "kernel_launch: unexpected problem (n_in %d, out %d, ws %zu, need %zu)\n", n_in, out_size, ws_size, (size_t)WS_END); grid = -1; return; }
        int dev = 0, cus = 0, per_cu = 0;
        if (hipGetDevice(&dev) != hipSuccess || hipDeviceGetAttribute(&cus, hipDeviceAttributeMultiprocessorCount, dev) != hipSuccess) { grid = -1; return; }
        if (hipFuncSetAttribute((const void*)enc_fwd, hipFuncAttributeMaxDynamicSharedMemorySize, LDS_BYTES) != hipSuccess) { fprintf(stderr, "kernel_launch: hipFuncSetAttribute failed\n"); grid = -1; return; }
        if (hipOccupancyMaxActiveBlocksPerMultiprocessor(&per_cu, (const void*)enc_fwd, NWAVES * 64, LDS_BYTES) != hipSuccess || per_cu < 1)
            fprintf(stderr, "kernel_launch: occupancy query reports %d workgroups per CU\n", per_cu);
        (void)hipGetLastError();
        grid = cus;
    }
    if (grid < 0) return;
    if (hipMemsetAsync((char*)d_ws + WS_CTL, 0, CTL_ZERO_BYTES, stream) != hipSuccess) return;
    Args a{};
    for (int i = 0; i < 23; ++i) a.in[i] = (const float*)d_in[i];
    a.out = (float*)d_out; a.ws = (unsigned char*)d_ws;
#if MK_MULTI
    for (int p = 0; p < N_PHASES; ++p) { a.ph_lo = p; a.ph_hi = p + 1; hipLaunchKernelGGL(enc_fwd, dim3(grid), dim3(NWAVES * 64), LDS_BYTES, stream, a); }
#else
    a.ph_lo = 0; a.ph_hi = N_PHASES;
    hipLaunchKernelGGL(enc_fwd, dim3(grid), dim3(NWAVES * 64), LDS_BYTES, stream, a);
#endif
}
```

```cpp
#include <hip/hip_runtime.h>
#include <cstdio>
#include <cstdint>

#ifndef PROBE_MASK
#define PROBE_MASK 0ull
#endif
#ifndef PROBE_N
#define PROBE_N 2
#endif
#ifndef MK_MULTI
#define MK_MULTI 0
#endif

#define LAS __attribute__((address_space(3)))
#define GAS __attribute__((address_space(1)))
typedef unsigned short bf16_t;
typedef short bf16x8 __attribute__((ext_vector_type(8)));
typedef float f32x4 __attribute__((ext_vector_type(4)));
typedef float f32x16 __attribute__((ext_vector_type(16)));
typedef unsigned u32x4 __attribute__((ext_vector_type(4)));
typedef unsigned u32x2 __attribute__((ext_vector_type(2)));

constexpr int NB = 8, SEQ = 2048, DM = 1024, MTOK = NB * SEQ, DFF = 3584, NE = 8;
constexpr int MP_MAX = 2 * MTOK + NE * 256;
constexpr int NPANEL_MAX = MP_MAX / 256;
constexpr float RMS_EPS = 1e-6f;
constexpr float LOG2E = 1.4426950408889634f;
constexpr float QSCALE = 0.125f * LOG2E;
constexpr float NEG_BIG = -1e30f;
constexpr int NWAVES = 8;

constexpr size_t MiB = 1ull << 20;
constexpr size_t WS_CTL = 0, CTL_ZERO_BYTES = 1 * MiB;
constexpr size_t WS_TAB = 1 * MiB;
constexpr size_t WS_MISC = WS_TAB + 256 * 1024;
constexpr size_t WS_BID = WS_MISC + 4096;
constexpr size_t WS_ROUTE = 2 * MiB;
constexpr size_t WS_CNT = WS_ROUTE + 384 * 1024;
constexpr size_t WS_PANEL = WS_ROUTE + 448 * 1024;
constexpr size_t WS_W = 4 * MiB;
constexpr size_t W_A_IN = 0, W_A_GRP = W_A_IN + 1048576, W_A_OUT = W_A_GRP + 262144, W_B_QK = W_A_OUT + 1048576, W_B_V = W_B_QK + 6144 * 1024,
                 W_B_OUT = W_B_V + 3072 * 1024, W_C_QK = W_B_OUT + 1048576, W_C_V = W_C_QK + 2048 * 1024, W_C_OUT = W_C_V + 1048576,
                 W_D_QK = W_C_OUT + 1048576, W_D_V = W_D_QK + 1280 * 1024, W_D_OUT = W_D_V + 256 * 1024, W_F_GU = W_D_OUT + 1048576,
                 W_F_D = W_F_GU + 2 * 7168 * 1024, W_M_GU = W_F_D + 2 * 3584 * 1024, W_M_D = W_M_GU + 16ull * 7168 * 1024, W_END = W_M_D + 16ull * 3584 * 1024;
constexpr size_t WS_XA = WS_W + ((W_END * 2 + MiB - 1) / MiB) * MiB;
constexpr size_t WS_XB = WS_XA + 64 * MiB;
constexpr size_t WS_HN = WS_XB + 64 * MiB;
constexpr size_t WS_BUFA = WS_HN + 32 * MiB;
constexpr size_t WS_BUFB = WS_BUFA + 32 * MiB;
constexpr size_t WS_BUFC = WS_BUFB + 32 * MiB;
constexpr size_t WS_BIG = WS_BUFC + 32 * MiB;
constexpr size_t WS_VT = WS_BIG + 240 * MiB;
constexpr size_t WS_OG = WS_VT + 96 * MiB;
constexpr size_t WS_LSE = WS_OG + 96 * MiB;
constexpr size_t WS_END = WS_LSE + 4 * MiB;
constexpr int CW_BAR = 4096;
constexpr int RING_BYTES = 131072, LDSCTL_OFF = RING_BYTES, MISC_OFF = LDSCTL_OFF + 320, LDS_BYTES = 147456;
constexpr int DA_TAB = 0, DA_STG = 32768, DA_XCH = 32768, DA_BID = RING_BYTES + 1024;

__device__ __forceinline__ unsigned cvt_pk_bf16(float lo, float hi) { unsigned r; asm volatile("v_cvt_pk_bf16_f32 %0, %1, %2" : "=v"(r) : "v"(lo), "v"(hi)); return r; }
__device__ __forceinline__ float bf_lo(unsigned w) { return __uint_as_float(w << 16); }
__device__ __forceinline__ float bf_hi(unsigned w) { return __uint_as_float(w & 0xffff0000u); }
__device__ __forceinline__ float wave_sum(float v) {
#pragma unroll
    for (int o = 1; o < 64; o <<= 1) v += __shfl_xor(v, o);
    return v;
}
#define LDS_WAIT() asm volatile("s_waitcnt lgkmcnt(0)" ::: "memory")
#define VM_WAIT() asm volatile("s_waitcnt vmcnt(0)" ::: "memory")

namespace pg8 {
constexpr int BM = 256, BK = 64, HALF = 128, HTB = HALF * BK * 2, STAGE_BYTES = 8 * HTB, NXCD = 8, WGM = 8;
__host__ __device__ __forceinline__ int lds_byte(int r, int c) { const int st = (r >> 4) * 2 + (c >> 5), rr = r & 15, cc = c & 31, ob = rr * 64 + cc * 2; return st * 1024 + (ob ^ (((ob >> 9) & 1) << 5)); }
__host__ __device__ __forceinline__ void stage_rc(int b, int& R, int& C) { const int st = b / 1024, sb = b % 1024, swz = sb ^ (((sb >> 9) & 1) << 5); R = (st >> 1) * 16 + swz / 64; C = (st & 1) * 32 + (swz % 64) / 2; }
__host__ __device__ __forceinline__ int perm32(int rho) { const int n = rho >> 4, i = rho & 15; return 8 * (i >> 2) + 4 * n + (i & 3); }

struct Unit { const char* A; const char* B; unsigned ldb, hsb; size_t co; int tag; };

__device__ __forceinline__ void tile_order(int nM, int nN, int L, int& pm, int& pn) {
    const int nwg = nM * nN; int wgid = L;
    { const int q = nwg / NXCD, r = nwg % NXCD, xcd = wgid % NXCD, off = wgid / NXCD; wgid = (xcd < r ? xcd * (q + 1) : r * (q + 1) + (xcd - r) * q) + off; }
    const int nig = WGM * nN, gid = wgid / nig, fm = gid * WGM, gsz = (nM - fm) < WGM ? (nM - fm) : WGM;
    pm = fm + ((wgid % nig) % gsz); pn = (wgid % nig) / gsz;
}

__device__ __forceinline__ void zero_acc(f32x4 (&acc)[2][2][4][2]) {
#pragma unroll
    for (int a = 0; a < 2; ++a)
#pragma unroll
        for (int b = 0; b < 2; ++b)
#pragma unroll
            for (int m = 0; m < 4; ++m)
#pragma unroll
                for (int n = 0; n < 2; ++n) acc[a][b][m][n] = (f32x4){0.f, 0.f, 0.f, 0.f};
}
struct EpiBf16 {
    static constexpr bool PERM = true;
    bf16_t* out0; int ld0; bf16_t* out1; int ld1;
    __device__ __forceinline__ void init(f32x4 (&acc)[2][2][4][2], const Unit&, int, int, int, int) const { zero_acc(acc); }
    __device__ __forceinline__ void operator()(const f32x4 (&acc)[2][2][4][2], const Unit& u, int wr, int wc, int fr, int fq) const {
        bf16_t* base = (u.tag ? out1 : out0) + u.co; const int ldc = u.tag ? ld1 : ld0;
        int r0 = wr * 64 + fr; asm volatile("" : "+v"(r0));
#pragma unroll
        for (int ai = 0; ai < 2; ++ai)
#pragma unroll
            for (int m = 0; m < 4; ++m) { bf16_t* rowp = base + (unsigned)((ai * HALF + m * 16 + r0) * ldc + wc * 32 + 8 * fq);
#pragma unroll
                for (int bj = 0; bj < 2; ++bj) { const f32x4 v0 = acc[ai][bj][m][0], v1 = acc[ai][bj][m][1];
                    u32x4 w; w.x = cvt_pk_bf16(v0[0], v0[1]); w.y = cvt_pk_bf16(v0[2], v0[3]); w.z = cvt_pk_bf16(v1[0], v1[1]); w.w = cvt_pk_bf16(v1[2], v1[3]);
                    *(u32x4*)(rowp + bj * HALF) = w; } }
    }
};
struct EpiSwiglu {
    static constexpr bool PERM = true;
    bf16_t* out; int ldc;
    __device__ __forceinline__ void init(f32x4 (&acc)[2][2][4][2], const Unit&, int, int, int, int) const { zero_acc(acc); }
    __device__ __forceinline__ void operator()(const f32x4 (&acc)[2][2][4][2], const Unit& u, int wr, int wc, int fr, int fq) const {
        bf16_t* base = out + u.co;
        int r0 = wr * 64 + fr; asm volatile("" : "+v"(r0));
#pragma unroll
        for (int ai = 0; ai < 2; ++ai)
#pragma unroll
            for (int m = 0; m < 4; ++m) { bf16_t* rowp = base + (unsigned)((ai * HALF + m * 16 + r0) * ldc + wc * 32 + 8 * fq);
                float r[8];
#pragma unroll
                for (int n = 0; n < 2; ++n)
#pragma unroll
                    for (int j = 0; j < 4; ++j) { const float g = acc[ai][0][m][n][j], up = acc[ai][1][m][n][j];
                        r[n * 4 + j] = g * __builtin_amdgcn_rcpf(1.0f + __builtin_amdgcn_exp2f(-g * LOG2E)) * up; }
                u32x4 w; w.x = cvt_pk_bf16(r[0], r[1]); w.y = cvt_pk_bf16(r[2], r[3]); w.z = cvt_pk_bf16(r[4], r[5]); w.w = cvt_pk_bf16(r[6], r[7]);
                *(u32x4*)rowp = w; }
    }
};
struct EpiResid {
    static constexpr bool PERM = false;
    const float* __restrict__ resid; float* __restrict__ out;
    __device__ __forceinline__ void init(f32x4 (&acc)[2][2][4][2], const Unit& u, int wr, int wc, int fr, int fq) const {
        int r0 = wr * 64 + fr; asm volatile("" : "+v"(r0));
#pragma unroll
        for (int ai = 0; ai < 2; ++ai)
#pragma unroll
            for (int m = 0; m < 4; ++m) { const size_t off = u.co + (unsigned)((ai * HALF + m * 16 + r0) * DM + wc * 32 + 4 * fq);
#pragma unroll
                for (int bj = 0; bj < 2; ++bj)
#pragma unroll
                    for (int n = 0; n < 2; ++n) acc[ai][bj][m][n] = *(const f32x4*)(resid + off + bj * HALF + n * 16); }
    }
    __device__ __forceinline__ void operator()(const f32x4 (&acc)[2][2][4][2], const Unit& u, int wr, int wc, int fr, int fq) const {
        int r0 = wr * 64 + fr; asm volatile("" : "+v"(r0));
#pragma unroll
        for (int ai = 0; ai < 2; ++ai)
#pragma unroll
            for (int m = 0; m < 4; ++m) { const size_t off = u.co + (unsigned)((ai * HALF + m * 16 + r0) * DM + wc * 32 + 4 * fq);
#pragma unroll
                for (int bj = 0; bj < 2; ++bj)
#pragma unroll
                    for (int n = 0; n < 2; ++n) *(f32x4*)(out + off + bj * HALF + n * 16) = acc[ai][bj][m][n]; }
    }
};

template <class Epi, class Sched>
__device__ __forceinline__ void gemm_phase(LAS unsigned char* lds, const int K, const unsigned lda, const Sched& S, const Epi& E) {
    const int tid = threadIdx.x, wid = __builtin_amdgcn_readfirstlane(tid >> 6), lane = tid & 63, wr = wid >> 2, wc = wid & 3, fr = lane & 15, fq = lane >> 4;
    int nt = K / BK; asm volatile("" : "+s"(nt));
    unsigned voffA[2], voffB[2];
#pragma unroll
    for (int i = 0; i < 2; ++i) { int R, C; stage_rc(tid * 16 + i * 8192, R, C); const int Rb = Epi::PERM ? ((R & ~31) + perm32(R & 31)) : R;
        voffA[i] = (unsigned)R * lda + (unsigned)C * 2u; (void)Rb; }
    const size_t kstep = (size_t)(BK * 2);
    const size_t hstepA = (size_t)HALF * lda;
    const unsigned ldsw = (unsigned)wid * 1024u;
    const int aoff = lds_byte(wr * 64 + fr, fq * 8), boff = lds_byte(wc * 32 + fr, fq * 8);
#define PG8_SA(b, h) (((b) * 2 + (h)) * HTB)
#define PG8_SB(b, h) ((4 + (b) * 2 + (h)) * HTB)
#define PG8_STAGE(bufoff, gbase, voff) do { _Pragma("unroll") for (int _i = 0; _i < 2; ++_i) \
        __builtin_amdgcn_global_load_lds((const unsigned*)((const char*)(gbase) + (voff)[_i]), (LAS unsigned*)(lds + (bufoff) + ldsw + _i * 8192), 16, 0, 0); } while (0)
#define PG8_LDA(dst, b, h) do { _Pragma("unroll") for (int m = 0; m < 4; ++m) _Pragma("unroll") for (int k = 0; k < 2; ++k) dst[m][k] = *(const LAS bf16x8*)(lds + PG8_SA(b, h) + aoff + m * 2048 + k * 1024); } while (0)
#define PG8_LDB(dst, b, h) do { _Pragma("unroll") for (int n = 0; n < 2; ++n) _Pragma("unroll") for (int k = 0; k < 2; ++k) dst[n][k] = *(const LAS bf16x8*)(lds + PG8_SB(b, h) + boff + n * 2048 + k * 1024); } while (0)
#define PG8_MMA(ai, bj, At, Bt) do { __builtin_amdgcn_s_setprio(1); _Pragma("unroll") for (int m = 0; m < 4; ++m) _Pragma("unroll") for (int n = 0; n < 2; ++n) _Pragma("unroll") for (int k = 0; k < 2; ++k) \
        acc[ai][bj][m][n] = __builtin_amdgcn_mfma_f32_16x16x32_bf16(Bt[n][k], At[m][k], acc[ai][bj][m][n], 0, 0, 0); __builtin_amdgcn_s_setprio(0); } while (0)
#define PG8_WAIT_V(n) asm volatile("s_waitcnt vmcnt(" #n ")" ::: "memory")
#define PG8_WAIT_L(n) asm volatile("s_waitcnt lgkmcnt(" #n ")" ::: "memory")
#define PG8_BAR __builtin_amdgcn_s_barrier()
#define PG8_SCHED __builtin_amdgcn_sched_barrier(0)
#define PG8_SETB(u) do { _Pragma("unroll") for (int _i = 0; _i < 2; ++_i) { int R_, C_; stage_rc((int)(threadIdx.x) * 16 + _i * 8192, R_, C_); const int Rb_ = Epi::PERM ? ((R_ & ~31) + perm32(R_ & 31)) : R_; \
        voffB[_i] = (unsigned)Rb_ * (u).ldb + (unsigned)C_ * 2u; } hsB = (size_t)(u).hsb; } while (0)
    Unit cur, nxt; int ui = 0;
    if (!S.next(0, cur)) return;
    f32x4 acc[2][2][4][2];
    E.init(acc, cur, wr, wc, fr, fq);
    bf16x8 At[4][2], B0[2][2], B1[2][2];
    const char* cA = cur.A; const char* cB = cur.B; size_t hsB;
    PG8_SETB(cur);
    PG8_STAGE(PG8_SB(0, 0), cB, voffB); PG8_STAGE(PG8_SB(0, 1), cB + hsB, voffB); PG8_STAGE(PG8_SA(0, 0), cA, voffA); PG8_STAGE(PG8_SA(0, 1), cA + hstepA, voffA);
    if (wr == 1) PG8_BAR;
    PG8_WAIT_V(2); PG8_BAR;
    PG8_STAGE(PG8_SB(1, 0), cB + kstep, voffB); PG8_STAGE(PG8_SA(1, 0), cA + kstep, voffA); PG8_STAGE(PG8_SB(1, 1), cB + hsB + kstep, voffB);
    PG8_WAIT_V(6); PG8_BAR;
    for (;;) {
        const bool has_next = S.next(ui + 1, nxt);
        const char* nA = has_next ? nxt.A : cA; const char* nB = has_next ? nxt.B : cB;
        for (int t = 0; t < nt; t += 2) {
            const bool last = (t == nt - 2);
            const char* a1 = cA + (size_t)(t + 1) * kstep;
            const char* a2 = last ? nA : cA + (size_t)(t + 2) * kstep; const char* b2 = last ? nB : cB + (size_t)(t + 2) * kstep;
            const char* a3 = a2 + kstep; const char* b3 = b2 + kstep;
            if (last && has_next) PG8_SETB(nxt);
            PG8_LDB(B0, 0, 0); PG8_LDB(B1, 0, 1); PG8_SCHED; PG8_LDA(At, 0, 0); PG8_STAGE(PG8_SA(1, 1), a1 + hstepA, voffA);
            PG8_WAIT_V(8); PG8_WAIT_L(0); PG8_BAR; PG8_MMA(0, 0, At, B0); PG8_MMA(0, 1, At, B1); PG8_BAR; PG8_SCHED;
            PG8_LDA(At, 0, 1); PG8_STAGE(PG8_SB(0, 0), b2, voffB); PG8_STAGE(PG8_SB(0, 1), b2 + hsB, voffB); PG8_STAGE(PG8_SA(0, 0), a2, voffA);
            PG8_WAIT_V(8); PG8_WAIT_L(0); PG8_BAR; PG8_MMA(1, 0, At, B0); PG8_MMA(1, 1, At, B1); PG8_BAR; PG8_SCHED;
            PG8_LDB(B0, 1, 0); PG8_LDB(B1, 1, 1); PG8_SCHED; PG8_LDA(At, 1, 0); PG8_STAGE(PG8_SA(0, 1), a2 + hstepA, voffA);
            PG8_WAIT_V(8); PG8_WAIT_L(0); PG8_BAR; PG8_MMA(0, 0, At, B0); PG8_MMA(0, 1, At, B1); PG8_BAR; PG8_SCHED;
            PG8_LDA(At, 1, 1); PG8_STAGE(PG8_SB(1, 0), b3, voffB); PG8_STAGE(PG8_SB(1, 1), b3 + hsB, voffB); PG8_STAGE(PG8_SA(1, 0), a3, voffA);
            PG8_WAIT_V(8); PG8_WAIT_L(0); PG8_BAR; PG8_MMA(1, 0, At, B0); PG8_MMA(1, 1, At, B1); PG8_BAR; PG8_SCHED;
        }
        if (wr == 0) PG8_BAR;
        E(acc, cur, wr, wc, fr, fq);
        if (!has_next) break;
        E.init(acc, nxt, wr, wc, fr, fq);
        cur = nxt; cA = nA; cB = nB; ++ui;
        if (wr == 1) PG8_BAR;
    }
    PG8_WAIT_V(0);
    PG8_BAR;
#undef PG8_SA
#undef PG8_SB
#undef PG8_STAGE
#undef PG8_LDA
#undef PG8_LDB
#undef PG8_MMA
#undef PG8_WAIT_V
#undef PG8_WAIT_L
#undef PG8_BAR
#undef PG8_SCHED
#undef PG8_SETB
}
}

#define XB_TMO      128
#define XB_XCNT(j)  (256  + 64 * (j))
#define XB_XSUB(j)  (1280 + 64 * (j))
#define XB_XGEN(j)  (2304 + 64 * (j))
#define XB_TOP      3328
#define XB_TOPGEN   3392
#define XCD_BAR_WORDS 3456
#define XB_SPIN_CAP (1u << 18)
__device__ __forceinline__ unsigned xb_ld(unsigned* p)              { return __hip_atomic_load(p, __ATOMIC_RELAXED, __HIP_MEMORY_SCOPE_AGENT); }
__device__ __forceinline__ unsigned xb_add(unsigned* p, unsigned v) { return __hip_atomic_fetch_add(p, v, __ATOMIC_RELAXED, __HIP_MEMORY_SCOPE_AGENT); }
__device__ __forceinline__ unsigned xb_xcc_id() { return (unsigned)__builtin_amdgcn_s_getreg((3 << 11) | 20) & 0xFu; }
#define XB_SPIN(cond, bar) do { unsigned _sp = 0; while (cond) { __builtin_amdgcn_s_sleep(1); \
    if ((++_sp & 255u) == 0u) { if (xb_ld(&(bar)[XB_TMO])) break; if (_sp > XB_SPIN_CAP) { atomicAdd(&(bar)[XB_TMO], 1u); break; } } } } while (0)
struct XcdBarrier { unsigned* bar; unsigned x; volatile LAS unsigned* st; };
__device__ __forceinline__ XcdBarrier xcd_barrier_post(unsigned* bar, volatile LAS unsigned* st) {
    XcdBarrier b; b.bar = bar; b.x = xb_xcc_id(); b.st = st;
    if (threadIdx.x == 0) (void)xb_add(&bar[XB_XCNT(b.x)], 1u);
    return b;
}
__device__ __forceinline__ void xcd_barrier_complete(unsigned* bar, unsigned x, unsigned& nloc, unsigned& nx) {
    const unsigned G = gridDim.x * gridDim.y * gridDim.z;
    unsigned sum, cnt, mine, sp = 0u;
    for (;;) {
        sum = 0u; cnt = 0u; mine = 0u;
#pragma unroll
        for (unsigned j = 0; j < 16; ++j) { const unsigned c = xb_ld(&bar[XB_XCNT(j)]); sum += c; cnt += (c > 0u) ? 1u : 0u; mine = (j == x) ? c : mine; }
        if (sum == G) break;
        __builtin_amdgcn_s_sleep(1);
        if ((++sp & 255u) == 0u) { if (xb_ld(&bar[XB_TMO])) break; if (sp > XB_SPIN_CAP) { atomicAdd(&bar[XB_TMO], 1u); break; } }
    }
    nloc = mine > 0u ? mine : 1u; nx = cnt > 0u ? cnt : 1u;
}
__device__ __forceinline__ void xcd_barrier(const XcdBarrier& b) {
    asm volatile("s_waitcnt vmcnt(0)" ::: "memory");
    __syncthreads();
    if (threadIdx.x == 0) {
        unsigned* bar = b.bar;
        __builtin_amdgcn_s_waitcnt(0);
        unsigned nloc = b.st[0], nx = b.st[1];
        if (nloc == 0u) { xcd_barrier_complete(bar, b.x, nloc, nx); b.st[0] = nloc; b.st[1] = nx; }
        const unsigned old = xb_add(&bar[XB_XSUB(b.x)], 1u);
        const unsigned gen = old / nloc;
        if (old + 1u == (gen + 1u) * nloc) {
            __builtin_amdgcn_fence(__ATOMIC_RELEASE, "agent");
            asm volatile("s_waitcnt vmcnt(0)" ::: "memory");
            const unsigned og = xb_add(&bar[XB_TOP], 1u);
            const unsigned tg = og / nx;
            if (og + 1u == (tg + 1u) * nx) xb_add(&bar[XB_TOPGEN], 1u);
            else XB_SPIN(xb_ld(&bar[XB_TOPGEN]) == tg, bar);
            __builtin_amdgcn_fence(__ATOMIC_ACQUIRE, "agent");
            xb_add(&bar[XB_XGEN(b.x)], 1u);
            asm volatile("s_waitcnt vmcnt(0)" ::: "memory");
        } else {
            XB_SPIN(xb_ld(&bar[XB_XGEN(b.x)]) == gen, bar);
            __builtin_amdgcn_fence(__ATOMIC_ACQUIRE, "agent");
            asm volatile("s_waitcnt vmcnt(0)" ::: "memory");
        }
    }
    __syncthreads();
}

struct Job { int in, K, ld, col0, ncols, mode, sk, sidx; unsigned long long src, dst; unsigned item0; unsigned pad; };
constexpr int NJOBS = 60;
struct JobTab { Job j[NJOBS]; unsigned nitems; unsigned pad[3]; };
constexpr JobTab make_jobs() {
    JobTab t{}; int n = 0; unsigned it = 0;
    auto add = [&](int in, unsigned long long src, int K, int ld, int col0, int ncols, unsigned long long dst_elem, int mode, int sk, int sidx) {
        Job& q = t.j[n++]; q.in = in; q.K = K; q.ld = ld; q.col0 = col0; q.ncols = ncols; q.mode = mode; q.sk = sk; q.sidx = sidx; q.src = src; q.dst = dst_elem; q.item0 = it; q.pad = 0;
        it += (unsigned)((K / 64) * (ncols / 64)); };
    add(5, 0, 1024, 1024, 0, 1024, W_A_IN, 0, 0, 0);
    for (int g = 0; g < 4; ++g) add(6, (unsigned long long)g * 65536, 256, 256, 0, 256, W_A_GRP + (unsigned long long)g * 65536, 0, 2, g * 256);
    add(8, 0, 1024, 1024, 0, 1024, W_A_OUT, 0, 0, 0);
    for (int g = 0; g < 3; ++g) {
        add(9, 0, 1024, 9216, g * 3072, 1024, W_B_QK + (unsigned long long)g * 1048576, 0, 1, 0);
        add(9, 0, 1024, 9216, g * 3072 + 1024, 1024, W_B_QK + (unsigned long long)(3 + g) * 1048576, 0, 0, 0);
        add(9, 0, 1024, 9216, g * 3072 + 2048, 1024, W_B_V + (unsigned long long)g * 1048576, 0, 0, 0);
    }
    add(10, 0, 1024, 1024, 0, 1024, W_B_OUT, 0, 0, 0);
    add(11, 0, 1024, 3072, 0, 1024, W_C_QK, 0, 1, 0);
    add(11, 0, 1024, 3072, 1024, 1024, W_C_QK + 1048576, 0, 0, 0);
    add(11, 0, 1024, 3072, 2048, 1024, W_C_V, 0, 0, 0);
    add(14, 0, 1024, 1024, 0, 1024, W_C_OUT, 0, 0, 0);
    add(15, 0, 1024, 1536, 0, 1024, W_D_QK, 0, 1, 0);
    add(15, 0, 1024, 1536, 1024, 256, W_D_QK + 1048576, 0, 0, 0);
    add(15, 0, 1024, 1536, 1280, 256, W_D_V, 0, 0, 0);
    add(17, 0, 1024, 1024, 0, 1024, W_D_OUT, 0, 0, 0);
    for (int l = 0; l < 2; ++l) add(18, (unsigned long long)l * 1024 * 7168, 1024, 7168, 0, 7168, W_F_GU + (unsigned long long)l * 7168 * 1024, 1, 0, 0);
    for (int l = 0; l < 2; ++l) add(19, (unsigned long long)l * 3584 * 1024, 3584, 1024, 0, 1024, W_F_D + (unsigned long long)l * 3584 * 1024, 0, 0, 0);
    for (int l = 0; l < 16; ++l) add(21, (unsigned long long)l * 1024 * 7168, 1024, 7168, 0, 7168, W_M_GU + (unsigned long long)l * 7168 * 1024, 1, 0, 0);
    for (int l = 0; l < 16; ++l) add(22, (unsigned long long)l * 3584 * 1024, 3584, 1024, 0, 1024, W_M_D + (unsigned long long)l * 3584 * 1024, 0, 0, 0);
    t.nitems = it;
    return t;
}
__constant__ JobTab g_jobs = make_jobs();
static_assert(make_jobs().j[NJOBS - 1].K == 3584, "job count");

struct Args { const float* in[23]; float* out; unsigned char* ws; int ph_lo, ph_hi; };

struct Frame {
    LAS unsigned char* lds;
    int G, c, vcu;
    __device__ __forceinline__ int tid_() const { return (int)threadIdx.x; }
    __device__ __forceinline__ int lane_() const { return (int)threadIdx.x & 63; }
    __device__ __forceinline__ int wave_() const { return __builtin_amdgcn_readfirstlane((int)threadIdx.x >> 6); }
};

__device__ __forceinline__ void conv_item(const Job& jb, const float* __restrict__ src, bf16_t* __restrict__ dst, const float* __restrict__ cs, LAS unsigned* scr, unsigned item, int lane) {
    const int ntn = jb.ncols >> 6; const int kb = (int)item / ntn, nb = (int)item % ntn, k0 = kb * 64, n0 = nb * 64;
    int drow = n0;
    if (jb.mode == 1) { int n = n0; const bool up = n >= DFF; if (up) n -= DFF; drow = (n >> 7) * 256 + (n & 127) + (up ? 128 : 0); }
    const int a = lane & 15, b = lane >> 4;
    const float sc = (jb.sk == 1) ? QSCALE : 1.0f;
    f32x4 csv = (f32x4){sc, sc, sc, sc};
    if (jb.sk == 2) csv = *(const f32x4*)(cs + jb.sidx + n0 + 4 * a);
    const float* sp = src + (size_t)(k0 + 2 * b) * jb.ld + jb.col0 + n0 + 4 * a;
    f32x4 v0[8], v1[8];
#pragma unroll
    for (int i = 0; i < 8; ++i) { v0[i] = *(const f32x4*)(sp + (size_t)(8 * i) * jb.ld); v1[i] = *(const f32x4*)(sp + (size_t)(8 * i + 1) * jb.ld); }
#pragma unroll
    for (int i = 0; i < 8; ++i) { const f32x4 x0 = v0[i] * csv, x1 = v1[i] * csv; const int kp = 4 * i + b;
#pragma unroll
        for (int j = 0; j < 4; ++j) scr[(4 * a + j) * 33 + kp] = cvt_pk_bf16(x0[j], x1[j]); }
    LDS_WAIT();
    const int c = lane & 7;
#pragma unroll
    for (int jj = 0; jj < 8; ++jj) { const int n = (lane >> 3) + 8 * jj; const LAS unsigned* s = scr + n * 33 + 4 * c;
        u32x4 o; o.x = s[0]; o.y = s[1]; o.z = s[2]; o.w = s[3];
        *(u32x4*)(dst + (size_t)(drow + n) * jb.K + k0 + 8 * c) = o; }
    LDS_WAIT();
}

__device__ __forceinline__ int rel_bucket(int rel) {
    const int n = rel < 0 ? -rel : rel;
    int big = 8 + (int)(logf((float)(n < 1 ? 1 : n) / 8.0f) / 4.852030263919617f * 8.0f);
    big = big < 15 ? big : 15;
    return (rel > 0 ? 16 : 0) + (n < 8 ? n : big);
}

__device__ __forceinline__ void load_row(const float* xrow, int lane, f32x4 (&v)[4]) {
    const f32x4* xr = (const f32x4*)xrow + lane;
#pragma unroll
    for (int j = 0; j < 4; ++j) v[j] = xr[64 * j];
}
__device__ __forceinline__ float row_rstd(const f32x4 (&v)[4]) {
    float s = 0.f;
#pragma unroll
    for (int j = 0; j < 4; ++j) s += (v[j].x * v[j].x + v[j].y * v[j].y) + (v[j].z * v[j].z + v[j].w * v[j].w);
    return 1.0f / sqrtf(wave_sum(s) * (1.0f / DM) + RMS_EPS);
}
__device__ __forceinline__ void store_row_bf16(bf16_t* orow, int lane, const f32x4 (&v)[4]) {
    u32x2* o8 = (u32x2*)orow + lane;
#pragma unroll
    for (int j = 0; j < 4; ++j) { u32x2 w; w.x = cvt_pk_bf16(v[j].x, v[j].y); w.y = cvt_pk_bf16(v[j].z, v[j].w); o8[64 * j] = w; }
}
__device__ __forceinline__ void rms_phase(const Frame& F, const float* x, const float* gain, bf16_t* hn) {
    const int gw = F.c * NWAVES + F.wave_(), NGW = F.G * NWAVES;
    f32x4 g[4]; load_row(gain, F.lane_(), g);
    for (int m = gw; m < MTOK; m += NGW) {
        f32x4 v[4]; load_row(x + (size_t)m * DM, F.lane_(), v);
        const float rstd = row_rstd(v);
#pragma unroll
        for (int j = 0; j < 4; ++j) v[j] = v[j] * rstd * g[j];
        store_row_bf16(hn + (size_t)m * DM, F.lane_(), v);
    }
}

__device__ __forceinline__ int keyperm(int rho) { return (rho & 0x13) | ((rho & 4) << 1) | ((rho & 8) >> 1); }
template <int NVB> struct AttnAcc { f32x16 o[NVB]; float m, l; };
template <int NVB>
__device__ __forceinline__ void attn_tile(AttnAcc<NVB>& st, const bf16x8 (&qf)[4], const char* kptr, const char* vptr, const size_t vblk, const LAS float* bt) {
    bf16x8 kf[4], vf[NVB][2];
#pragma unroll
    for (int t = 0; t < 4; ++t) kf[t] = *(const bf16x8*)(kptr + t * 32);
#pragma unroll
    for (int b = 0; b < NVB; ++b)
#pragma unroll
        for (int t = 0; t < 2; ++t) vf[b][t] = *(const bf16x8*)(vptr + b * vblk + t * 32);
    f32x16 s;
#pragma unroll
    for (int r = 0; r < 16; ++r) s[r] = bt[(r >> 3) * 16 + (r & 7)];
#pragma unroll
    for (int t = 0; t < 4; ++t) s = __builtin_amdgcn_mfma_f32_32x32x16_bf16(kf[t], qf[t], s, 0, 0, 0);
    float mx = s[0];
#pragma unroll
    for (int r = 1; r < 16; ++r) mx = fmaxf(mx, s[r]);
    mx = fmaxf(mx, __shfl_xor(mx, 32));
    const float mn = fmaxf(st.m, mx), alpha = __builtin_amdgcn_exp2f(st.m - mn); st.m = mn;
    float ps = 0.f;
#pragma unroll
    for (int r = 0; r < 16; ++r) { s[r] = __builtin_amdgcn_exp2f(s[r] - mn); ps += s[r]; }
    st.l = st.l * alpha + ps;
#pragma unroll
    for (int b = 0; b < NVB; ++b) st.o[b] = st.o[b] * alpha;
    u32x4 p0, p1;
    p0.x = cvt_pk_bf16(s[0], s[1]); p0.y = cvt_pk_bf16(s[2], s[3]); p0.z = cvt_pk_bf16(s[4], s[5]); p0.w = cvt_pk_bf16(s[6], s[7]);
    p1.x = cvt_pk_bf16(s[8], s[9]); p1.y = cvt_pk_bf16(s[10], s[11]); p1.z = cvt_pk_bf16(s[12], s[13]); p1.w = cvt_pk_bf16(s[14], s[15]);
    const bf16x8 pf0 = __builtin_bit_cast(bf16x8, p0), pf1 = __builtin_bit_cast(bf16x8, p1);
#pragma unroll
    for (int b = 0; b < NVB; ++b) { st.o[b] = __builtin_amdgcn_mfma_f32_32x32x16_bf16(vf[b][0], pf0, st.o[b], 0, 0, 0); st.o[b] = __builtin_amdgcn_mfma_f32_32x32x16_bf16(vf[b][1], pf1, st.o[b], 0, 0, 0); }
}

template <int HALF>
__device__ __forceinline__ void band_item(const bf16_t* Qp, const bf16_t* Kp, const int ldqk, const size_t tok0, const int dil, const int L, const int q0,
                                          const bf16_t* Vt, const size_t vn0, const float* gtab_h, LAS float* tbl, const float m_init, const float l_init,
                                          bf16_t* out_row0  , const int ldo, float* lse_out  , const int lane) {
    const int ql = lane & 31, hf = lane >> 5;
    for (int i = lane; i < 2 * HALF + 63; i += 64) { const int j = i - HALF - 31; tbl[i] = (j >= -HALF && j <= HALF) ? gtab_h[j * dil + 2048] : NEG_BIG; }
    LDS_WAIT();
    const size_t qtok = tok0 + (size_t)(q0 + ql) * dil;
    bf16x8 qf[4];
#pragma unroll
    for (int t = 0; t < 4; ++t) qf[t] = *(const bf16x8*)(Qp + qtok * ldqk + 16 * t + 8 * hf);
    AttnAcc<2> st;
    st.o[0] = (f32x16){}; st.o[1] = (f32x16){}; st.m = m_init; st.l = (hf == 0) ? l_init : 0.f;
    const int kr = keyperm(ql);
    for (int kt = q0 - HALF; kt <= q0 + HALF; kt += 32) {
        if (kt < 0 || kt >= L) continue;
        const char* kptr = (const char*)(Kp + (tok0 + (size_t)(kt + kr) * dil) * ldqk + 8 * hf);
        const char* vptr = (const char*)(Vt + (size_t)ql * MTOK + vn0 + kt + 8 * hf);
        const LAS float* bt = tbl + (kt - q0 + HALF) + 8 * hf - ql + 31;
        attn_tile<2>(st, qf, kptr, vptr, (size_t)32 * MTOK * 2, bt);
    }
    const float lt = st.l + __shfl_xor(st.l, 32), inv = 1.0f / lt;
    bf16_t* orow = out_row0 + qtok * ldo;
#pragma unroll
    for (int b = 0; b < 2; ++b)
#pragma unroll
        for (int i = 0; i < 4; ++i) { u32x2 w; w.x = cvt_pk_bf16(st.o[b][4 * i] * inv, st.o[b][4 * i + 1] * inv); w.y = cvt_pk_bf16(st.o[b][4 * i + 2] * inv, st.o[b][4 * i + 3] * inv);
            *(u32x2*)(orow + 32 * b + 8 * i + 4 * hf) = w; }
    if (lse_out && hf == 0) lse_out[qtok * 16] = st.m + __builtin_amdgcn_logf(lt);
}

struct PlainSched {
    const char* A; const char* B; unsigned lda, ldb; int nM, nN, G, c; size_t co_m, co_n;
    __device__ __forceinline__ bool next(int i, pg8::Unit& u) const {
        const long L = (long)i * G + c; if (L >= (long)nM * nN) return false;
        int pm, pn; pg8::tile_order(nM, nN, (int)L, pm, pn);
        u.A = A + (size_t)pm * 256 * lda; u.B = B + (size_t)pn * 256 * ldb; u.ldb = ldb; u.hsb = 128u * ldb; u.co = (size_t)pm * co_m + (size_t)pn * co_n; u.tag = 0; return true;
    }
};
struct QkvSched {
    const char* hn; const char* Wqk; const char* Wv; int nNqk, nvp, nMv, dshift, G, c; int ldqk;
    __device__ __forceinline__ bool next(int i, pg8::Unit& u) const {
        long L = (long)i * G + c; const int n0 = 64 * nNqk, nv = nMv * 64;
        if (L < n0) { int pm, pn; pg8::tile_order(64, nNqk, (int)L, pm, pn);
            u.A = hn + (size_t)pm * 256 * 2048; u.B = Wqk + (size_t)pn * 256 * 2048; u.ldb = 2048u; u.hsb = 128u * 2048u; u.co = (size_t)pm * 256 * ldqk + (size_t)pn * 256; u.tag = 0; return true; }
        L -= n0; if (L >= (long)nvp * nv) return false;
        const int g = (int)(L / nv); int pm, pn; pg8::tile_order(nMv, 64, (int)(L % nv), pm, pn);
        const int d = 1 << (dshift * g), b = pn >> 3, nn = (pn & 7) * 256;
        size_t tok; unsigned ldb, hsb;
        if (d == 1) { tok = (size_t)b * SEQ + nn; ldb = 2048u; hsb = 128u * 2048u; }
        else if (d == 4) { tok = (size_t)b * SEQ + (size_t)(nn & 511) * 4 + (nn >> 9); ldb = 4u * 2048u; hsb = 128u * 4u * 2048u; }
        else { tok = (size_t)b * SEQ + (nn >> 7); ldb = 16u * 2048u; hsb = 2048u; }
        u.A = Wv + (size_t)(g * nMv + pm) * 256 * 2048; u.B = hn + tok * 2048; u.ldb = ldb; u.hsb = hsb;
        u.co = (size_t)(g * nMv + pm) * 256 * MTOK + (size_t)pn * 256; u.tag = 1; return true;
    }
};
struct MoeSched {
    const char* A; const char* B; unsigned lda, ldb; const int* panel; size_t estride; int nN, G, c; size_t co_m, co_n;
    __device__ __forceinline__ bool next(int i, pg8::Unit& u) const {
        const int nM = panel[0]; const long L = (long)i * G + c; if (L >= (long)nM * nN) return false;
        int pm, pn; pg8::tile_order(nM, nN, (int)L, pm, pn); const int e = panel[4 + pm];
        u.A = A + (size_t)pm * 256 * lda; u.B = B + (size_t)e * estride + (size_t)pn * 256 * ldb; u.ldb = ldb; u.hsb = 128u * ldb; u.co = (size_t)pm * co_m + (size_t)pn * co_n; u.tag = 0; return true;
    }
};

__device__ __forceinline__ void moe_route(const Frame& F, const float* x, const float* gain, const float* router, bf16_t* hn, int* e12, float* g1o, float* g2o, int* cnt_wg) {
    LAS float* Rt = (LAS float*)F.lds;
    LAS int* cnt = (LAS int*)(F.lds + 32768);
    for (int i = F.tid_(); i < DM * NE; i += NWAVES * 64) { const int k = i >> 3, e = i & 7; Rt[e * DM + k] = router[i]; }
    f32x4 g[4]; load_row(gain, F.lane_(), g);
    for (int ch = F.c; ch < MTOK / 64; ch += F.G) {
        if (F.tid_() < 8) cnt[F.tid_()] = 0;
        __syncthreads();
        for (int i = 0; i < 8; ++i) {
            const int m = ch * 64 + F.wave_() * 8 + i;
            f32x4 v[4]; load_row(x + (size_t)m * DM, F.lane_(), v);
            const float rstd = row_rstd(v);
#pragma unroll
            for (int j = 0; j < 4; ++j) v[j] = v[j] * rstd * g[j];
            store_row_bf16(hn + (size_t)m * DM, F.lane_(), v);
            float lg[8];
#pragma unroll
            for (int e = 0; e < 8; ++e) { float s = 0.f;
#pragma unroll
                for (int j = 0; j < 4; ++j) { const f32x4 r = *(const LAS f32x4*)(Rt + e * DM + 4 * F.lane_() + 256 * j); s += (v[j].x * r.x + v[j].y * r.y) + (v[j].z * r.z + v[j].w * r.w); }
                lg[e] = wave_sum(s); }
            int e1 = 0; float v1 = lg[0];
#pragma unroll
            for (int e = 1; e < 8; ++e) if (lg[e] > v1) { v1 = lg[e]; e1 = e; }
            int e2 = -1; float v2 = -3.4e38f;
#pragma unroll
            for (int e = 0; e < 8; ++e) if (e != e1 && lg[e] > v2) { v2 = lg[e]; e2 = e; }
            const float ex = __expf(v2 - v1), ga = 1.0f / (1.0f + ex), gb = ex * ga;
            if (F.lane_() == 0) { e12[m] = e1 | (e2 << 8); g1o[m] = ga; g2o[m] = gb; atomicAdd((int*)&cnt[e1], 1); atomicAdd((int*)&cnt[e2], 1); }
        }
        __syncthreads();
        if (F.tid_() < 8) cnt_wg[ch * 8 + F.tid_()] = cnt[F.tid_()];
        __syncthreads();
    }
}
__device__ __forceinline__ void moe_assign(const Frame& F, const bf16_t* hn, const int* e12, const int* cnt_wg, int* p1o, int* p2o, int* panel, bf16_t* hs) {
    LAS int* psum = (LAS int*)F.lds;
    LAS int* tot = psum + 512; LAS int* base = tot + 8; LAS int* off = base + 8;
    LAS int* plist = off + 16;
    for (int ch = F.c; ch < MTOK / 64; ch += F.G) {
        { const int e = F.tid_() & 7, part = F.tid_() >> 3; int s = 0;
#pragma unroll
          for (int q = 0; q < 4; ++q) s += cnt_wg[(4 * part + q) * 8 + e];
          psum[part * 8 + e] = s; }
        __syncthreads();
        if (F.tid_() < 8) { const int e = F.tid_(); int t = 0, b = 0; for (int p = 0; p < 64; ++p) { const int s = psum[p * 8 + e]; if (p < (ch >> 2)) b += s; t += s; }
            for (int q = 0; q < (ch & 3); ++q) b += cnt_wg[(4 * (ch >> 2) + q) * 8 + e];
            tot[e] = t; base[e] = b; }
        __syncthreads();
        if (F.tid_() == 0) { int o = 0; for (int e = 0; e < 8; ++e) { off[e] = o; o += (tot[e] + 255) & ~255; } off[8] = o; }
        __syncthreads();
        if (F.wave_() == 0) {
            const int m = ch * 64 + F.lane_(); const int ee = e12[m]; const int e1 = ee & 255, e2 = ee >> 8; int p1 = 0, p2 = 0;
#pragma unroll
            for (int e = 0; e < 8; ++e) { const unsigned long long mk = __ballot(e1 == e || e2 == e); const int rk = __popcll(mk & ((1ull << F.lane_()) - 1ull));
                if (e1 == e) p1 = off[e] + base[e] + rk; if (e2 == e) p2 = off[e] + base[e] + rk; }
            p1o[m] = p1; p2o[m] = p2; plist[2 * F.lane_()] = p1; plist[2 * F.lane_() + 1] = p2;
        }
        __syncthreads();
        for (int i = 0; i < 16; ++i) { const int pr = F.wave_() * 16 + i; const int m = ch * 64 + (pr >> 1); const int pos = plist[pr];
            const u32x4* s = (const u32x4*)(hn + (size_t)m * DM); u32x4* d = (u32x4*)(hs + (size_t)pos * DM);
            const u32x4 a = s[F.lane_()], b = s[64 + F.lane_()]; d[F.lane_()] = a; d[64 + F.lane_()] = b; }
        if (ch < 8) { const int e = ch; for (int r = off[e] + tot[e] + F.wave_(); r < off[e + 1]; r += NWAVES) { u32x4* d = (u32x4*)(hs + (size_t)r * DM); d[F.lane_()] = (u32x4){0, 0, 0, 0}; d[64 + F.lane_()] = (u32x4){0, 0, 0, 0}; } }
        if (ch == 0) { if (F.tid_() == 0) panel[0] = off[8] >> 8;
            if (F.tid_() < NPANEL_MAX) { const int r = F.tid_() * 256; int e = 0;
#pragma unroll
                for (int q = 1; q < 8; ++q) if (r >= off[q]) e = q;
                panel[4 + F.tid_()] = e; } }
        __syncthreads();
    }
}
__device__ __forceinline__ void moe_combine(const Frame& F, const float* x, const bf16_t* ys, const int* p1, const int* p2, const float* g1, const float* g2, const float* gain, float* xo, bf16_t* hn, float* outf) {
    const int gw = F.c * NWAVES + F.wave_(), NGW = F.G * NWAVES;
    f32x4 g[4]; load_row(gain, F.lane_(), g);
    for (int m = gw; m < MTOK; m += NGW) {
        f32x4 v[4]; load_row(x + (size_t)m * DM, F.lane_(), v);
        const float ga = g1[m], gb = g2[m];
        const u32x2* ya = (const u32x2*)(ys + (size_t)p1[m] * DM) + F.lane_(); const u32x2* yb = (const u32x2*)(ys + (size_t)p2[m] * DM) + F.lane_();
#pragma unroll
        for (int j = 0; j < 4; ++j) { const u32x2 a = ya[64 * j], b = yb[64 * j];
            v[j].x += ga * bf_lo(a.x) + gb * bf_lo(b.x); v[j].y += ga * bf_hi(a.x) + gb * bf_hi(b.x); v[j].z += ga * bf_lo(a.y) + gb * bf_lo(b.y); v[j].w += ga * bf_hi(a.y) + gb * bf_hi(b.y); }
        if (xo) { f32x4* o = (f32x4*)(xo + (size_t)m * DM) + F.lane_();
#pragma unroll
            for (int j = 0; j < 4; ++j) o[64 * j] = v[j]; }
        const float rstd = row_rstd(v);
#pragma unroll
        for (int j = 0; j < 4; ++j) v[j] = v[j] * rstd * g[j];
        if (outf) { f32x4* o = (f32x4*)(outf + (size_t)m * DM) + F.lane_();
#pragma unroll
            for (int j = 0; j < 4; ++j) o[64 * j] = v[j]; }
        else store_row_bf16(hn + (size_t)m * DM, F.lane_(), v);
    }
}


__global__ void __launch_bounds__(NWAVES * 64, 2) enc_fwd(Args args) {
    extern __shared__ __attribute__((aligned(16))) unsigned char lds_raw[];
    Frame F;
    F.lds = (LAS unsigned char*)lds_raw;
    F.G = gridDim.x; F.c = blockIdx.x; F.vcu = (F.G % 8 == 0) ? (F.c % 8) * (F.G / 8) + F.c / 8 : F.c;
    unsigned char* ws = args.ws;
    volatile LAS unsigned* MISC = (volatile LAS unsigned*)(F.lds + MISC_OFF);
    for (int u = F.tid_(); u < (LDS_BYTES - LDSCTL_OFF) / 4; u += NWAVES * 64) ((LAS unsigned*)(F.lds + LDSCTL_OFF))[u] = 0u;
    __syncthreads();
#if MK_MULTI
    #define GRID_BAR() do { } while (0)
#else
    XcdBarrier bar = xcd_barrier_post((unsigned*)(ws + WS_CTL) + CW_BAR, MISC + 8);
    #define GRID_BAR() xcd_barrier(bar)
#endif
    const int lo = args.ph_lo, hi = args.ph_hi;
#define IN(k) (lo <= (k) && (k) < hi)
#define SEAM(k) do { if (IN((k) + 1)) GRID_BAR(); } while (0)
#define PREP(k) ((((unsigned long long)(PROBE_MASK) >> (k)) & 1ull) ? PROBE_N : 1)
#define PH_BEGIN(k) if (IN(k)) { for (int rep_ = 0; rep_ < PREP(k); ++rep_) {
#define PH_END(k) } SEAM(k); }

    const float* x_in = args.in[0]; const float* rel_bias = args.in[1]; const float* norm_mix = args.in[2]; const float* norm_ffn = args.in[3]; const float* norm_final = args.in[4];
    bf16_t* Wb = (bf16_t*)(ws + WS_W);
    float* gtab = (float*)(ws + WS_TAB); float* misc = (float*)(ws + WS_MISC);
    int* r_e12 = (int*)(ws + WS_ROUTE); float* r_g1 = (float*)(ws + WS_ROUTE + 65536); float* r_g2 = (float*)(ws + WS_ROUTE + 2 * 65536);
    int* r_p1 = (int*)(ws + WS_ROUTE + 3 * 65536); int* r_p2 = (int*)(ws + WS_ROUTE + 4 * 65536);
    int* cnt_wg = (int*)(ws + WS_CNT); int* panel = (int*)(ws + WS_PANEL);
    float* XA = (float*)(ws + WS_XA); float* XB = (float*)(ws + WS_XB);
    bf16_t* HN = (bf16_t*)(ws + WS_HN); bf16_t* BUFA = (bf16_t*)(ws + WS_BUFA); bf16_t* BUFB = (bf16_t*)(ws + WS_BUFB); bf16_t* BUFC = (bf16_t*)(ws + WS_BUFC);
    bf16_t* BIG = (bf16_t*)(ws + WS_BIG); bf16_t* VT = (bf16_t*)(ws + WS_VT); bf16_t* OG = (bf16_t*)(ws + WS_OG); float* LSE = (float*)(ws + WS_LSE);
    bf16_t* HS = VT; bf16_t* YS = OG;
    LAS unsigned char* ring = F.lds;

#define PLAIN_GEMM(EPI, Aptr, Bptr, K_, lda_, ldb_, nM_, nN_, com_, con_) do { \
        PlainSched S_{(const char*)(Aptr), (const char*)(Bptr), (unsigned)(lda_), (unsigned)(ldb_), (nM_), (nN_), F.G, F.c, (size_t)(com_), (size_t)(con_)}; \
        pg8::gemm_phase(ring, (K_), (unsigned)(lda_), S_, EPI); } while (0)

#define DENSE_FFN(p, l, xr, xo) \
    PH_BEGIN(p) pg8::EpiSwiglu E_{BIG, DFF}; PLAIN_GEMM(E_, HN, Wb + W_F_GU + (size_t)(l) * 7168 * 1024, 1024, 2048, 2048, 64, 28, 256 * DFF, 128); PH_END(p) \
    PH_BEGIN((p) + 1) pg8::EpiResid E_{(xr), (xo)}; PLAIN_GEMM(E_, BIG, Wb + W_F_D + (size_t)(l) * 3584 * 1024, 3584, 7168, 7168, 64, 4, 256 * DM, 256); PH_END((p) + 1)

#define MOE_FFN(p, l, xr, gain) \
    PH_BEGIN(p) moe_route(F, (xr), (gain), args.in[20] + (size_t)(l) * DM * NE, HN, r_e12, r_g1, r_g2, cnt_wg); PH_END(p) \
    PH_BEGIN((p) + 1) moe_assign(F, HN, r_e12, cnt_wg, r_p1, r_p2, panel, HS); PH_END((p) + 1) \
    PH_BEGIN((p) + 2) pg8::EpiSwiglu E_{BIG, DFF}; MoeSched S_{(const char*)HS, (const char*)(Wb + W_M_GU + (size_t)(l) * 8 * 7168 * 1024), 2048u, 2048u, panel, (size_t)7168 * 1024 * 2, 28, F.G, F.c, (size_t)256 * DFF, (size_t)128}; \
        pg8::gemm_phase(ring, 1024, 2048u, S_, E_); PH_END((p) + 2) \
    PH_BEGIN((p) + 3) pg8::EpiBf16 E_{YS, DM, YS, DM}; MoeSched S_{(const char*)BIG, (const char*)(Wb + W_M_D + (size_t)(l) * 8 * 3584 * 1024), 7168u, 7168u, panel, (size_t)3584 * 1024 * 2, 4, F.G, F.c, (size_t)256 * DM, (size_t)256}; \
        pg8::gemm_phase(ring, 3584, 7168u, S_, E_); PH_END((p) + 3)

    PH_BEGIN(0)
        LAS unsigned* scr = (LAS unsigned*)(F.lds + F.wave_() * 8448);
        const unsigned gw = (unsigned)(F.c * NWAVES + F.wave_()), NGW = (unsigned)(F.G * NWAVES);
        int jn = 0;
        for (unsigned it = gw; it < g_jobs.nitems; it += NGW) {
            while (jn + 1 < NJOBS && g_jobs.j[jn + 1].item0 <= it) ++jn;
            const Job& jb = g_jobs.j[jn];
            conv_item(jb, args.in[jb.in] + jb.src, Wb + jb.dst, args.in[7], scr, it - jb.item0, F.lane_());
        }
        for (int i = F.c * NWAVES * 64 + F.tid_(); i < 16 * 4096; i += F.G * NWAVES * 64) { const int h = i >> 12, idx = i & 4095; gtab[i] = rel_bias[rel_bucket(idx - 2048) * 16 + h] * LOG2E; }
        if (F.c == 1) for (int i = F.tid_(); i < 4096; i += NWAVES * 64) ((unsigned char*)(ws + WS_BID))[i] = (unsigned char)rel_bucket(i - 2048);
        if (F.c == 0 && F.tid_() == 0) { const float* lv = args.in[12]; float s0 = 0.f, s1 = 0.f; for (int i = 0; i < 64; ++i) { s0 += lv[i] * lv[64 + i]; s1 += lv[128 + i] * lv[192 + i]; }
            const float lam_init = 0.8f - 0.6f * expf(-0.3f * 2.0f); misc[0] = expf(s0) - expf(s1) + lam_init; misc[1] = lam_init; }
        rms_phase(F, x_in, norm_mix, HN);
        PH_END(0)
    PH_BEGIN(1) pg8::EpiBf16 E_{BUFA, DM, BUFA, DM}; PLAIN_GEMM(E_, HN, Wb + W_A_IN, 1024, 2048, 2048, 64, 4, 256 * DM, 256); PH_END(1)
    PH_BEGIN(2)
        for (int it = F.c * NWAVES * 64 + F.tid_(); it < MTOK * 128; it += F.G * NWAVES * 64) {
            const int t = it >> 7, cc = it & 127, g = cc >> 5, hw = 1 << g, s = t & (SEQ - 1);
            const int lo_ = (s - hw) < 0 ? 0 : s - hw, hi_ = (s + hw) > SEQ ? SEQ : s + hw;
            const bf16_t* base = BUFA + (size_t)(t - s) * DM + cc * 8;
            float a[8] = {0, 0, 0, 0, 0, 0, 0, 0};
            for (int r = lo_; r < hi_; ++r) { const u32x4 w = *(const u32x4*)(base + (size_t)r * DM);
                a[0] += bf_lo(w.x); a[1] += bf_hi(w.x); a[2] += bf_lo(w.y); a[3] += bf_hi(w.y); a[4] += bf_lo(w.z); a[5] += bf_hi(w.z); a[6] += bf_lo(w.w); a[7] += bf_hi(w.w); }
            const float ic = 1.0f / (float)(hi_ - lo_); const u32x4 w = *(const u32x4*)(base + (size_t)s * DM);
            u32x4 o; o.x = cvt_pk_bf16(a[0] * ic - bf_lo(w.x), a[1] * ic - bf_hi(w.x)); o.y = cvt_pk_bf16(a[2] * ic - bf_lo(w.y), a[3] * ic - bf_hi(w.y));
            o.z = cvt_pk_bf16(a[4] * ic - bf_lo(w.z), a[5] * ic - bf_hi(w.z)); o.w = cvt_pk_bf16(a[6] * ic - bf_lo(w.w), a[7] * ic - bf_hi(w.w));
            *(u32x4*)(BUFB + (size_t)t * DM + cc * 8) = o;
        }
        PH_END(2)
    PH_BEGIN(3)
        struct GrpSched { const char* A; const char* B; int G, c;
            __device__ __forceinline__ bool next(int i, pg8::Unit& u) const { const int L = i * G + c; if (L >= 256) return false; int pm, pn; pg8::tile_order(64, 4, L, pm, pn);
                u.A = A + (size_t)pm * 256 * 2048 + pn * 512; u.B = B + (size_t)pn * 65536 * 2; u.ldb = 512u; u.hsb = 128u * 512u; u.co = (size_t)pm * 256 * DM + pn * 256; u.tag = 0; return true; } };
        GrpSched S_{(const char*)BUFB, (const char*)(Wb + W_A_GRP), F.G, F.c}; pg8::EpiBf16 E_{BUFC, DM, BUFC, DM};
        pg8::gemm_phase(ring, 256, 2048u, S_, E_); PH_END(3)
    PH_BEGIN(4) pg8::EpiResid E_{x_in, XA}; PLAIN_GEMM(E_, BUFC, Wb + W_A_OUT, 1024, 2048, 2048, 64, 4, 256 * DM, 256); PH_END(4)
    PH_BEGIN(5) rms_phase(F, XA, norm_ffn, HN); PH_END(5)
    DENSE_FFN(6, 0, XA, XB)
    PH_BEGIN(8) rms_phase(F, XB, norm_mix + DM, HN); PH_END(8)
    PH_BEGIN(9)
        QkvSched S_{(const char*)HN, (const char*)(Wb + W_B_QK), (const char*)(Wb + W_B_V), 24, 3, 4, 2, F.G, F.c, 6144};
        pg8::EpiBf16 E_{BIG, 6144, VT, MTOK}; pg8::gemm_phase(ring, 1024, 2048u, S_, E_); PH_END(9)
    PH_BEGIN(10)
        LAS float* tbl = (LAS float*)(F.lds + F.wave_() * 2048);
        for (int i = 0; i < 12; ++i) {
            const int w = (i * F.G + F.vcu) * NWAVES + F.wave_(); if (w >= 3 * 8192) break;
            const int g = w >> 13, rest = w & 8191, b = rest >> 10, h = (rest >> 6) & 15, blk = rest & 63;
            const int dil = (g == 0) ? 1 : (g == 1 ? 4 : 16), L = SEQ / dil, nqb = L >> 5, r = blk / nqb, qb = blk % nqb;
            band_item<64>(BIG + g * 1024 + h * 64, BIG + 3072 + g * 1024 + h * 64, 6144, (size_t)b * SEQ + r, dil, L, qb * 32,
                          VT + (size_t)(g * 1024 + h * 64) * MTOK, (size_t)b * SEQ + (size_t)r * L, gtab + h * 4096, tbl, NEG_BIG, 0.f,
                          OG + (size_t)g * MTOK * DM + h * 64, DM, LSE + (size_t)g * MTOK * 16 + h, F.lane_());
        }
        PH_END(10)
    PH_BEGIN(11)
        for (int it = F.c * NWAVES * 64 + F.tid_(); it < MTOK * 128; it += F.G * NWAVES * 64) {
            const int t = it >> 7, cc = it & 127, h = cc >> 3;
            const float l0 = LSE[(size_t)t * 16 + h], l1 = LSE[(size_t)(MTOK + t) * 16 + h], l2 = LSE[(size_t)(2 * MTOK + t) * 16 + h];
            const float mx = fmaxf(l0, fmaxf(l1, l2)); float w0 = __builtin_amdgcn_exp2f(l0 - mx), w1 = __builtin_amdgcn_exp2f(l1 - mx), w2 = __builtin_amdgcn_exp2f(l2 - mx);
            const float inv = 1.0f / (w0 + w1 + w2); w0 *= inv; w1 *= inv; w2 *= inv;
            const size_t o = (size_t)t * DM + cc * 8;
            const u32x4 a = *(const u32x4*)(OG + o), b = *(const u32x4*)(OG + (size_t)MTOK * DM + o), c = *(const u32x4*)(OG + 2 * (size_t)MTOK * DM + o);
            u32x4 r;
            r.x = cvt_pk_bf16(w0 * bf_lo(a.x) + w1 * bf_lo(b.x) + w2 * bf_lo(c.x), w0 * bf_hi(a.x) + w1 * bf_hi(b.x) + w2 * bf_hi(c.x));
            r.y = cvt_pk_bf16(w0 * bf_lo(a.y) + w1 * bf_lo(b.y) + w2 * bf_lo(c.y), w0 * bf_hi(a.y) + w1 * bf_hi(b.y) + w2 * bf_hi(c.y));
            r.z = cvt_pk_bf16(w0 * bf_lo(a.z) + w1 * bf_lo(b.z) + w2 * bf_lo(c.z), w0 * bf_hi(a.z) + w1 * bf_hi(b.z) + w2 * bf_hi(c.z));
            r.w = cvt_pk_bf16(w0 * bf_lo(a.w) + w1 * bf_lo(b.w) + w2 * bf_lo(c.w), w0 * bf_hi(a.w) + w1 * bf_hi(b.w) + w2 * bf_hi(c.w));
            *(u32x4*)(BUFA + o) = r;
        }
        PH_END(11)
    PH_BEGIN(12) pg8::EpiResid E_{XB, XA}; PLAIN_GEMM(E_, BUFA, Wb + W_B_OUT, 1024, 2048, 2048, 64, 4, 256 * DM, 256); PH_END(12)
    MOE_FFN(13, 0, XA, norm_ffn + DM)
    PH_BEGIN(17) moe_combine(F, XA, YS, r_p1, r_p2, r_g1, r_g2, norm_mix + 2 * DM, XB, HN, nullptr); PH_END(17)
    PH_BEGIN(18)
        QkvSched S_{(const char*)HN, (const char*)(Wb + W_C_QK), (const char*)(Wb + W_C_V), 8, 1, 4, 0, F.G, F.c, 2048};
        pg8::EpiBf16 E_{BIG, 2048, VT, MTOK}; pg8::gemm_phase(ring, 1024, 2048u, S_, E_); PH_END(18)
    PH_BEGIN(19)
        const int tid = F.tid_(), lane = tid & 63, wv = F.wave_();
        const int j = wv & 1, sub = wv >> 1, ql = lane & 31, hf = lane >> 5, kp = keyperm(ql);
        LAS float* tabL = (LAS float*)(F.lds + DA_TAB);
        LAS unsigned char* bidL = F.lds + DA_BID;
        LAS float* xch = (LAS float*)(F.lds + DA_XCH);
        const float lam = misc[0], post = 1.0f - misc[1];
        for (int q = tid; q < 1024; q += NWAVES * 64) ((LAS unsigned*)bidL)[q] = ((const unsigned*)(ws + WS_BID))[q];
        unsigned ka[4], va[4];
#pragma unroll
        for (int t = 0; t < 4; ++t) { ka[t] = (unsigned)(kp * 128 + (((2 * t + hf) ^ ((kp >> 1) & 7)) << 4)); va[t] = (unsigned)(ql * 128 + (((2 * t + hf) ^ ((ql >> 1) & 7)) << 4)); }
        const int rr = 8 * wv + (lane >> 3), cc = (lane & 7) ^ ((rr >> 1) & 7);
        const unsigned koff = (unsigned)(rr * 4096 + cc * 16), voff = (unsigned)(rr * (MTOK * 2) + cc * 16);
#define DA_GLDS(g, l) __builtin_amdgcn_global_load_lds((const unsigned*)(g), (LAS unsigned*)(l), 16, 0, 0)
#define DA_ISSUE(tile, stage) do { LAS unsigned char* sb_ = F.lds + DA_STG + (stage) * 32768 + wv * 1024; const size_t kt_ = (size_t)(tile) * 64; \
            DA_GLDS(K0g + kt_ * 4096 + koff, sb_); DA_GLDS(K0g + 128 + kt_ * 4096 + koff, sb_ + 8192); \
            DA_GLDS(Vg + kt_ * 2 + voff, sb_ + 16384); DA_GLDS(Vg + kt_ * 2 + voff + (size_t)64 * MTOK * 2, sb_ + 24576); } while (0)
        for (int i = 0; i < 4; ++i) {
            const int u = i * F.G + F.vcu; if (u >= 1024) break;
            const int b = u >> 7, h = (u >> 4) & 7, qblk = u & 15;
            __syncthreads();
            for (int q = tid; q < 2 * 4096; q += NWAVES * 64) tabL[q] = gtab[(2 * h) * 4096 + q];
            const size_t tok0 = (size_t)b * SEQ; const int q0 = qblk * 128 + sub * 32;
            const char* K0g = (const char*)(BIG + tok0 * 2048 + 1024 + (2 * h) * 64);
            const char* Vg = (const char*)(VT + (size_t)(h * 128) * MTOK + tok0);
            const size_t qtok = tok0 + q0 + ql;
            bf16x8 qf[4];
#pragma unroll
            for (int t = 0; t < 4; ++t) qf[t] = *(const bf16x8*)(BIG + qtok * 2048 + (2 * h + j) * 64 + 16 * t + 8 * hf);
            DA_ISSUE(0, 0); DA_ISSUE(1, 1);
            f32x16 o[4];
#pragma unroll
            for (int bb = 0; bb < 4; ++bb) o[bb] = (f32x16){};
            float m_run = NEG_BIG, l_run = 0.f;
            int stg = 0;
            for (int t = 0; t < 32; ++t) {
                if (t == 31) asm volatile("s_waitcnt vmcnt(0) lgkmcnt(0)" ::: "memory"); else asm volatile("s_waitcnt vmcnt(4) lgkmcnt(0)" ::: "memory");
                __builtin_amdgcn_s_barrier(); asm volatile("" ::: "memory");
                if (t + 2 < 32) { const int s2 = (stg >= 1) ? stg - 1 : 2; DA_ISSUE(t + 2, s2); }
                const LAS unsigned char* Kt = F.lds + DA_STG + stg * 32768 + j * 8192; const LAS unsigned char* Vt_ = F.lds + DA_STG + stg * 32768 + 16384;
                const int kt = t * 64, rel_lo = kt - q0 - 31, rel_hi = kt + 63 - q0;
                f32x16 s0, s1;
                const bool cst = (rel_lo > 0 || rel_hi < 0) && (__builtin_amdgcn_readfirstlane((int)bidL[rel_lo + 2048]) == __builtin_amdgcn_readfirstlane((int)bidL[rel_hi + 2048]));
                if (cst) { const float c = tabL[j * 4096 + rel_lo + 2048];
#pragma unroll
                    for (int r = 0; r < 16; ++r) { s0[r] = c; s1[r] = c; } }
                else { const LAS float* bt = tabL + j * 4096 + kt + 8 * hf - (q0 + ql) + 2048;
#pragma unroll
                    for (int r = 0; r < 16; ++r) { s0[r] = bt[(r >> 3) * 16 + (r & 7)]; s1[r] = bt[32 + (r >> 3) * 16 + (r & 7)]; } }
#pragma unroll
                for (int t4 = 0; t4 < 4; ++t4) { const bf16x8 kf = *(const LAS bf16x8*)(Kt + ka[t4]); s0 = __builtin_amdgcn_mfma_f32_32x32x16_bf16(kf, qf[t4], s0, 0, 0, 0); }
#pragma unroll
                for (int t4 = 0; t4 < 4; ++t4) { const bf16x8 kf = *(const LAS bf16x8*)(Kt + 4096 + ka[t4]); s1 = __builtin_amdgcn_mfma_f32_32x32x16_bf16(kf, qf[t4], s1, 0, 0, 0); }
                float mx = fmaxf(s0[0], s1[0]);
#pragma unroll
                for (int r = 1; r < 16; ++r) mx = fmaxf(mx, fmaxf(s0[r], s1[r]));
                mx = fmaxf(mx, __shfl_xor(mx, 32));
                const float mn = fmaxf(m_run, mx), alpha = __builtin_amdgcn_exp2f(m_run - mn); m_run = mn;
                float ps = 0.f;
#pragma unroll
                for (int r = 0; r < 16; ++r) { s0[r] = __builtin_amdgcn_exp2f(s0[r] - mn); s1[r] = __builtin_amdgcn_exp2f(s1[r] - mn); ps += s0[r] + s1[r]; }
                l_run = l_run * alpha + ps;
#pragma unroll
                for (int bb = 0; bb < 4; ++bb) o[bb] = o[bb] * alpha;
                u32x4 p0, p1, p2, p3;
                p0.x = cvt_pk_bf16(s0[0], s0[1]); p0.y = cvt_pk_bf16(s0[2], s0[3]); p0.z = cvt_pk_bf16(s0[4], s0[5]); p0.w = cvt_pk_bf16(s0[6], s0[7]);
                p1.x = cvt_pk_bf16(s0[8], s0[9]); p1.y = cvt_pk_bf16(s0[10], s0[11]); p1.z = cvt_pk_bf16(s0[12], s0[13]); p1.w = cvt_pk_bf16(s0[14], s0[15]);
                p2.x = cvt_pk_bf16(s1[0], s1[1]); p2.y = cvt_pk_bf16(s1[2], s1[3]); p2.z = cvt_pk_bf16(s1[4], s1[5]); p2.w = cvt_pk_bf16(s1[6], s1[7]);
                p3.x = cvt_pk_bf16(s1[8], s1[9]); p3.y = cvt_pk_bf16(s1[10], s1[11]); p3.z = cvt_pk_bf16(s1[12], s1[13]); p3.w = cvt_pk_bf16(s1[14], s1[15]);
                const bf16x8 pf0 = __builtin_bit_cast(bf16x8, p0), pf1 = __builtin_bit_cast(bf16x8, p1), pf2 = __builtin_bit_cast(bf16x8, p2), pf3 = __builtin_bit_cast(bf16x8, p3);
#pragma unroll
                for (int bb = 0; bb < 4; ++bb) {
                    const bf16x8 v0 = *(const LAS bf16x8*)(Vt_ + bb * 4096 + va[0]), v1 = *(const LAS bf16x8*)(Vt_ + bb * 4096 + va[1]);
                    const bf16x8 v2 = *(const LAS bf16x8*)(Vt_ + bb * 4096 + va[2]), v3 = *(const LAS bf16x8*)(Vt_ + bb * 4096 + va[3]);
                    o[bb] = __builtin_amdgcn_mfma_f32_32x32x16_bf16(v0, pf0, o[bb], 0, 0, 0); o[bb] = __builtin_amdgcn_mfma_f32_32x32x16_bf16(v1, pf1, o[bb], 0, 0, 0);
                    o[bb] = __builtin_amdgcn_mfma_f32_32x32x16_bf16(v2, pf2, o[bb], 0, 0, 0); o[bb] = __builtin_amdgcn_mfma_f32_32x32x16_bf16(v3, pf3, o[bb], 0, 0, 0);
                }
                stg = (stg == 2) ? 0 : stg + 1;
            }
            const float lt = l_run + __shfl_xor(l_run, 32), inv = 1.0f / lt;
            __syncthreads();
            if (j == 1) {
#pragma unroll
                for (int bb = 0; bb < 4; ++bb)
#pragma unroll
                    for (int r = 0; r < 16; ++r) xch[(sub * 64 + bb * 16 + r) * 64 + lane] = o[bb][r] * inv;
            }
            __syncthreads();
            if (j == 0) {
                float ss = 0.f;
#pragma unroll
                for (int bb = 0; bb < 4; ++bb)
#pragma unroll
                    for (int r = 0; r < 16; ++r) { const float v = o[bb][r] * inv - lam * xch[(sub * 64 + bb * 16 + r) * 64 + lane]; o[bb][r] = v; ss += v * v; }
                ss += __shfl_xor(ss, 32);
                const float rstd = post / sqrtf(ss * (1.0f / 128.0f) + RMS_EPS);
                const float* sg = args.in[13];
                bf16_t* orow = BUFA + qtok * DM + h * 128;
#pragma unroll
                for (int bb = 0; bb < 4; ++bb)
#pragma unroll
                    for (int i4 = 0; i4 < 4; ++i4) { const int d = 32 * bb + 8 * i4 + 4 * hf; const f32x4 gg = *(const f32x4*)(sg + d);
                        u32x2 w; w.x = cvt_pk_bf16(o[bb][4 * i4] * rstd * gg.x, o[bb][4 * i4 + 1] * rstd * gg.y); w.y = cvt_pk_bf16(o[bb][4 * i4 + 2] * rstd * gg.z, o[bb][4 * i4 + 3] * rstd * gg.w);
                        *(u32x2*)(orow + d) = w; }
            }
        }
#undef DA_GLDS
#undef DA_ISSUE
        PH_END(19)
    PH_BEGIN(20) pg8::EpiResid E_{XB, XA}; PLAIN_GEMM(E_, BUFA, Wb + W_C_OUT, 1024, 2048, 2048, 64, 4, 256 * DM, 256); PH_END(20)
    PH_BEGIN(21) rms_phase(F, XA, norm_ffn + 2 * DM, HN); PH_END(21)
    DENSE_FFN(22, 1, XA, XB)
    PH_BEGIN(24) rms_phase(F, XB, norm_mix + 3 * DM, HN); PH_END(24)
    PH_BEGIN(25)
        QkvSched S_{(const char*)HN, (const char*)(Wb + W_D_QK), (const char*)(Wb + W_D_V), 5, 1, 1, 0, F.G, F.c, 1280};
        pg8::EpiBf16 E_{BIG, 1280, VT, MTOK}; pg8::gemm_phase(ring, 1024, 2048u, S_, E_); PH_END(25)
    PH_BEGIN(26)
        LAS float* tbl = (LAS float*)(F.lds + F.wave_() * 2048);
        const float* sink = args.in[16];
        for (int i = 0; i < 4; ++i) {
            const int w = (i * F.G + F.vcu) * NWAVES + F.wave_(); if (w >= 8192) break;
            const int b = w >> 10, kvh = (w >> 8) & 3, qb = (w >> 2) & 63, qh = kvh * 4 + (w & 3);
            band_item<128>(BIG + qh * 64, BIG + 1024 + kvh * 64, 1280, (size_t)b * SEQ, 1, SEQ, qb * 32,
                           VT + (size_t)(kvh * 64) * MTOK, (size_t)b * SEQ, gtab + qh * 4096, tbl, sink[qh] * LOG2E, 1.0f,
                           BUFA + qh * 64, DM, nullptr, F.lane_());
        }
        PH_END(26)
    PH_BEGIN(27) pg8::EpiResid E_{XB, XA}; PLAIN_GEMM(E_, BUFA, Wb + W_D_OUT, 1024, 2048, 2048, 64, 4, 256 * DM, 256); PH_END(27)
    MOE_FFN(28, 1, XA, norm_ffn + 3 * DM)
    PH_BEGIN(32) moe_combine(F, XA, YS, r_p1, r_p2, r_g1, r_g2, norm_final, nullptr, nullptr, args.out); } }
#undef IN
#undef SEAM
}
constexpr int N_PHASES = 33;

extern "C" void kernel_launch(void* const* d_in, const int* in_sizes, int n_in, void* d_out, int out_size, void* d_ws, size_t ws_size, hipStream_t stream) {
    static int grid = 0;
    if (grid == 0) {
        if (n_in != 23 || out_size != MTOK * DM || ws_size < WS_END) { fprintf(stderr, "kernel_launch: unexpected problem (n_in %d, out %d, ws %zu, need %zu)\n", n_in, out_size, ws_size, (size_t)WS_END); grid = -1; return; }
        int dev = 0, cus = 0, per_cu = 0;
        if (hipGetDevice(&dev) != hipSuccess || hipDeviceGetAttribute(&cus, hipDeviceAttributeMultiprocessorCount, dev) != hipSuccess) { grid = -1; return; }
        if (hipFuncSetAttribute((const void*)enc_fwd, hipFuncAttributeMaxDynamicSharedMemorySize, LDS_BYTES) != hipSuccess) { fprintf(stderr, "kernel_launch: hipFuncSetAttribute failed\n"); grid = -1; return; }
        if (hipOccupancyMaxActiveBlocksPerMultiprocessor(&per_cu, (const void*)enc_fwd, NWAVES * 64, LDS_BYTES) != hipSuccess || per_cu < 1)
            fprintf(stderr, "kernel_launch: occupancy query reports %d workgroups per CU\n", per_cu);
        (void)hipGetLastError();
        grid = cus;
    }
    if (grid < 0) return;
    if (hipMemsetAsync((char*)d_ws + WS_CTL, 0, CTL_ZERO_BYTES, stream) != hipSuccess) return;
    Args a{};
    for (int i = 0; i < 23; ++i) a.in[i] = (const float*)d_in[i];
    a.out = (float*)d_out; a.ws = (unsigned char*)d_ws;
#if MK_MULTI
    for (int p = 0; p < N_PHASES; ++p) { a.ph_lo = p; a.ph_hi = p + 1; hipLaunchKernelGGL(enc_fwd, dim3(grid), dim3(NWAVES * 64), LDS_BYTES, stream, a); }
#else
    a.ph_lo = 0; a.ph_hi = N_PHASES;
    hipLaunchKernelGGL(enc_fwd, dim3(grid), dim3(NWAVES * 64), LDS_BYTES, stream, a);
#endif
}
```

```cpp
#include <hip/hip_runtime.h>
#include <cstdio>
#include <cstdint>

#ifndef PROBE_MASK
#define PROBE_MASK 0ull
#endif
#ifndef PROBE_N
#define PROBE_N 2
#endif
#ifndef MK_MULTI
#define MK_MULTI 0
#endif

#define LAS __attribute__((address_space(3)))
#define GAS __attribute__((address_space(1)))
typedef unsigned short bf16_t;
typedef short bf16x8 __attribute__((ext_vector_type(8)));
typedef float f32x4 __attribute__((ext_vector_type(4)));
typedef float f32x16 __attribute__((ext_vector_type(16)));
typedef unsigned u32x4 __attribute__((ext_vector_type(4)));
typedef unsigned u32x2 __attribute__((ext_vector_type(2)));

constexpr int NB = 8, SEQ = 2048, DM = 1024, MTOK = NB * SEQ, DFF = 3584, NE = 8;
constexpr int MP_MAX = 2 * MTOK + NE * 256;
constexpr int NPANEL_MAX = MP_MAX / 256;
constexpr float RMS_EPS = 1e-6f;
constexpr float LOG2E = 1.4426950408889634f;
constexpr float QSCALE = 0.125f * LOG2E;
constexpr float NEG_BIG = -1e30f;
constexpr int NWAVES = 8;

constexpr size_t MiB = 1ull << 20;
constexpr size_t WS_CTL = 0, CTL_ZERO_BYTES = 1 * MiB;
constexpr size_t WS_TAB = 1 * MiB;
constexpr size_t WS_MISC = WS_TAB + 256 * 1024;
constexpr size_t WS_BID = WS_MISC + 4096;
constexpr size_t WS_ROUTE = 2 * MiB;
constexpr size_t WS_CNT = WS_ROUTE + 384 * 1024;
constexpr size_t WS_PANEL = WS_ROUTE + 448 * 1024;
constexpr size_t WS_W = 4 * MiB;
constexpr size_t W_A_IN = 0, W_A_GRP = W_A_IN + 1048576, W_A_OUT = W_A_GRP + 262144, W_B_QK = W_A_OUT + 1048576, W_B_V = W_B_QK + 6144 * 1024,
                 W_B_OUT = W_B_V + 3072 * 1024, W_C_QK = W_B_OUT + 1048576, W_C_V = W_C_QK + 2048 * 1024, W_C_OUT = W_C_V + 1048576,
                 W_D_QK = W_C_OUT + 1048576, W_D_V = W_D_QK + 1280 * 1024, W_D_OUT = W_D_V + 256 * 1024, W_F_GU = W_D_OUT + 1048576,
                 W_F_D = W_F_GU + 2 * 7168 * 1024, W_M_GU = W_F_D + 2 * 3584 * 1024, W_M_D = W_M_GU + 16ull * 7168 * 1024, W_END = W_M_D + 16ull * 3584 * 1024;
constexpr size_t WS_XA = WS_W + ((W_END * 2 + MiB - 1) / MiB) * MiB;
constexpr size_t WS_XB = WS_XA + 64 * MiB;
constexpr size_t WS_HN = WS_XB + 64 * MiB;
constexpr size_t WS_BUFA = WS_HN + 32 * MiB;
constexpr size_t WS_BUFB = WS_BUFA + 32 * MiB;
constexpr size_t WS_BUFC = WS_BUFB + 32 * MiB;
constexpr size_t WS_BIG = WS_BUFC + 32 * MiB;
constexpr size_t WS_VT = WS_BIG + 240 * MiB;
constexpr size_t WS_OG = WS_VT + 96 * MiB;
constexpr size_t WS_LSE = WS_OG + 96 * MiB;
constexpr size_t WS_PART = WS_LSE + 4 * MiB;
constexpr size_t WS_END = WS_PART + 64 * MiB;
constexpr int CW_BAR = 4096;
constexpr int RING_BYTES = 131072, LDSCTL_OFF = RING_BYTES, MISC_OFF = LDSCTL_OFF + 320, LDS_BYTES = 147456;
constexpr int BI_TAB = RING_BYTES + 1024;
constexpr int DA_TAB = 0, DA_STG = 32768, DA_XCH = 32768, DA_BID = RING_BYTES + 1024;

__device__ __forceinline__ unsigned cvt_pk_bf16(float lo, float hi) { unsigned r; asm volatile("v_cvt_pk_bf16_f32 %0, %1, %2" : "=v"(r) : "v"(lo), "v"(hi)); return r; }
__device__ __forceinline__ float bf_lo(unsigned w) { return __uint_as_float(w << 16); }
__device__ __forceinline__ float bf_hi(unsigned w) { return __uint_as_float(w & 0xffff0000u); }
__device__ __forceinline__ float wave_sum(float v) {
#pragma unroll
    for (int o = 1; o < 64; o <<= 1) v += __shfl_xor(v, o);
    return v;
}
#define LDS_WAIT() asm volatile("s_waitcnt lgkmcnt(0)" ::: "memory")
#define VM_WAIT() asm volatile("s_waitcnt vmcnt(0)" ::: "memory")

namespace pg8 {
constexpr int BM = 256, BK = 64, HALF = 128, HTB = HALF * BK * 2, STAGE_BYTES = 8 * HTB, NXCD = 8, WGM = 8;
__host__ __device__ __forceinline__ int lds_byte(int r, int c) { const int st = (r >> 4) * 2 + (c >> 5), rr = r & 15, cc = c & 31, ob = rr * 64 + cc * 2; return st * 1024 + (ob ^ (((ob >> 9) & 1) << 5)); }
__host__ __device__ __forceinline__ void stage_rc(int b, int& R, int& C) { const int st = b / 1024, sb = b % 1024, swz = sb ^ (((sb >> 9) & 1) << 5); R = (st >> 1) * 16 + swz / 64; C = (st & 1) * 32 + (swz % 64) / 2; }
__host__ __device__ __forceinline__ int perm32(int rho) { const int n = rho >> 4, i = rho & 15; return 8 * (i >> 2) + 4 * n + (i & 3); }

struct Unit { const char* A; const char* B; unsigned ldb, hsb; size_t co; int tag; };

__device__ __forceinline__ void tile_order(int nM, int nN, int L, int& pm, int& pn) {
    const int nwg = nM * nN; int wgid = L;
    { const int q = nwg / NXCD, r = nwg % NXCD, xcd = wgid % NXCD, off = wgid / NXCD; wgid = (xcd < r ? xcd * (q + 1) : r * (q + 1) + (xcd - r) * q) + off; }
    const int nig = WGM * nN, gid = wgid / nig, fm = gid * WGM, gsz = (nM - fm) < WGM ? (nM - fm) : WGM;
    pm = fm + ((wgid % nig) % gsz); pn = (wgid % nig) / gsz;
}

__device__ __forceinline__ void zero_acc(f32x4 (&acc)[2][2][4][2]) {
#pragma unroll
    for (int a = 0; a < 2; ++a)
#pragma unroll
        for (int b = 0; b < 2; ++b)
#pragma unroll
            for (int m = 0; m < 4; ++m)
#pragma unroll
                for (int n = 0; n < 2; ++n) acc[a][b][m][n] = (f32x4){0.f, 0.f, 0.f, 0.f};
}
struct EpiBf16 {
    static constexpr bool PERM = true;
    bf16_t* out0; int ld0; bf16_t* out1; int ld1;
    __device__ __forceinline__ void init(f32x4 (&acc)[2][2][4][2], const Unit&, int, int, int, int) const { zero_acc(acc); }
    __device__ __forceinline__ void operator()(const f32x4 (&acc)[2][2][4][2], const Unit& u, int wr, int wc, int fr, int fq) const {
        bf16_t* base = (u.tag ? out1 : out0) + u.co; const int ldc = u.tag ? ld1 : ld0;
        int r0 = wr * 64 + fr; asm volatile("" : "+v"(r0));
#pragma unroll
        for (int ai = 0; ai < 2; ++ai)
#pragma unroll
            for (int m = 0; m < 4; ++m) { bf16_t* rowp = base + (unsigned)((ai * HALF + m * 16 + r0) * ldc + wc * 32 + 8 * fq);
#pragma unroll
                for (int bj = 0; bj < 2; ++bj) { const f32x4 v0 = acc[ai][bj][m][0], v1 = acc[ai][bj][m][1];
                    u32x4 w; w.x = cvt_pk_bf16(v0[0], v0[1]); w.y = cvt_pk_bf16(v0[2], v0[3]); w.z = cvt_pk_bf16(v1[0], v1[1]); w.w = cvt_pk_bf16(v1[2], v1[3]);
                    *(u32x4*)(rowp + bj * HALF) = w; } }
    }
};
struct EpiSwiglu {
    static constexpr bool PERM = true;
    bf16_t* out; int ldc;
    __device__ __forceinline__ void init(f32x4 (&acc)[2][2][4][2], const Unit&, int, int, int, int) const { zero_acc(acc); }
    __device__ __forceinline__ void operator()(const f32x4 (&acc)[2][2][4][2], const Unit& u, int wr, int wc, int fr, int fq) const {
        bf16_t* base = out + u.co;
        int r0 = wr * 64 + fr; asm volatile("" : "+v"(r0));
#pragma unroll
        for (int ai = 0; ai < 2; ++ai)
#pragma unroll
            for (int m = 0; m < 4; ++m) { bf16_t* rowp = base + (unsigned)((ai * HALF + m * 16 + r0) * ldc + wc * 32 + 8 * fq);
                float r[8];
#pragma unroll
                for (int n = 0; n < 2; ++n)
#pragma unroll
                    for (int j = 0; j < 4; ++j) { const float g = acc[ai][0][m][n][j], up = acc[ai][1][m][n][j];
                        r[n * 4 + j] = g * __builtin_amdgcn_rcpf(1.0f + __builtin_amdgcn_exp2f(-g * LOG2E)) * up; }
                u32x4 w; w.x = cvt_pk_bf16(r[0], r[1]); w.y = cvt_pk_bf16(r[2], r[3]); w.z = cvt_pk_bf16(r[4], r[5]); w.w = cvt_pk_bf16(r[6], r[7]);
                *(u32x4*)rowp = w; }
    }
};
struct EpiResid {
    static constexpr bool PERM = false;
    const float* __restrict__ resid; float* __restrict__ out;
    __device__ __forceinline__ void init(f32x4 (&acc)[2][2][4][2], const Unit& u, int wr, int wc, int fr, int fq) const {
        int r0 = wr * 64 + fr; asm volatile("" : "+v"(r0));
#pragma unroll
        for (int ai = 0; ai < 2; ++ai)
#pragma unroll
            for (int m = 0; m < 4; ++m) { const size_t off = u.co + (unsigned)((ai * HALF + m * 16 + r0) * DM + wc * 32 + 4 * fq);
#pragma unroll
                for (int bj = 0; bj < 2; ++bj)
#pragma unroll
                    for (int n = 0; n < 2; ++n) acc[ai][bj][m][n] = *(const f32x4*)(resid + off + bj * HALF + n * 16); }
    }
    __device__ __forceinline__ void operator()(const f32x4 (&acc)[2][2][4][2], const Unit& u, int wr, int wc, int fr, int fq) const {
        int r0 = wr * 64 + fr; asm volatile("" : "+v"(r0));
#pragma unroll
        for (int ai = 0; ai < 2; ++ai)
#pragma unroll
            for (int m = 0; m < 4; ++m) { const size_t off = u.co + (unsigned)((ai * HALF + m * 16 + r0) * DM + wc * 32 + 4 * fq);
#pragma unroll
                for (int bj = 0; bj < 2; ++bj)
#pragma unroll
                    for (int n = 0; n < 2; ++n) *(f32x4*)(out + off + bj * HALF + n * 16) = acc[ai][bj][m][n]; }
    }
};

struct EpiPart {
    static constexpr bool PERM = false;
    float* out;
    __device__ __forceinline__ void init(f32x4 (&acc)[2][2][4][2], const Unit&, int, int, int, int) const { zero_acc(acc); }
    __device__ __forceinline__ void operator()(const f32x4 (&acc)[2][2][4][2], const Unit& u, int wr, int wc, int fr, int fq) const {
        int r0 = wr * 64 + fr; asm volatile("" : "+v"(r0));
#pragma unroll
        for (int ai = 0; ai < 2; ++ai)
#pragma unroll
            for (int m = 0; m < 4; ++m) { const size_t off = u.co + (unsigned)((ai * HALF + m * 16 + r0) * 256 + wc * 32 + 4 * fq);
#pragma unroll
                for (int bj = 0; bj < 2; ++bj)
#pragma unroll
                    for (int n = 0; n < 2; ++n) *(f32x4*)(out + off + bj * HALF + n * 16) = acc[ai][bj][m][n]; }
    }
};

template <class Epi, class Sched>
__device__ __forceinline__ void gemm_phase(LAS unsigned char* lds, const int K, const unsigned lda, const Sched& S, const Epi& E) {
    const int tid = threadIdx.x, wid = __builtin_amdgcn_readfirstlane(tid >> 6), lane = tid & 63, wr = wid >> 2, wc = wid & 3, fr = lane & 15, fq = lane >> 4;
    int nt = K / BK; asm volatile("" : "+s"(nt));
    unsigned voffA[2], voffB[2];
#pragma unroll
    for (int i = 0; i < 2; ++i) { int R, C; stage_rc(tid * 16 + i * 8192, R, C); const int Rb = Epi::PERM ? ((R & ~31) + perm32(R & 31)) : R;
        voffA[i] = (unsigned)R * lda + (unsigned)C * 2u; (void)Rb; }
    const size_t kstep = (size_t)(BK * 2);
    const size_t hstepA = (size_t)HALF * lda;
    const unsigned ldsw = (unsigned)wid * 1024u;
    const int aoff = lds_byte(wr * 64 + fr, fq * 8), boff = lds_byte(wc * 32 + fr, fq * 8);
#define PG8_SA(b, h) (((b) * 2 + (h)) * HTB)
#define PG8_SB(b, h) ((4 + (b) * 2 + (h)) * HTB)
#define PG8_STAGE(bufoff, gbase, voff) do { _Pragma("unroll") for (int _i = 0; _i < 2; ++_i) \
        __builtin_amdgcn_global_load_lds((const unsigned*)((const char*)(gbase) + (voff)[_i]), (LAS unsigned*)(lds + (bufoff) + ldsw + _i * 8192), 16, 0, 0); } while (0)
#define PG8_LDA(dst, b, h) do { _Pragma("unroll") for (int m = 0; m < 4; ++m) _Pragma("unroll") for (int k = 0; k < 2; ++k) dst[m][k] = *(const LAS bf16x8*)(lds + PG8_SA(b, h) + aoff + m * 2048 + k * 1024); } while (0)
#define PG8_LDB(dst, b, h) do { _Pragma("unroll") for (int n = 0; n < 2; ++n) _Pragma("unroll") for (int k = 0; k < 2; ++k) dst[n][k] = *(const LAS bf16x8*)(lds + PG8_SB(b, h) + boff + n * 2048 + k * 1024); } while (0)
#define PG8_MMA(ai, bj, At, Bt) do { __builtin_amdgcn_s_setprio(1); _Pragma("unroll") for (int m = 0; m < 4; ++m) _Pragma("unroll") for (int n = 0; n < 2; ++n) _Pragma("unroll") for (int k = 0; k < 2; ++k) \
        acc[ai][bj][m][n] = __builtin_amdgcn_mfma_f32_16x16x32_bf16(Bt[n][k], At[m][k], acc[ai][bj][m][n], 0, 0, 0); __builtin_amdgcn_s_setprio(0); } while (0)
#define PG8_WAIT_V(n) asm volatile("s_waitcnt vmcnt(" #n ")" ::: "memory")
#define PG8_WAIT_L(n) asm volatile("s_waitcnt lgkmcnt(" #n ")" ::: "memory")
#define PG8_BAR __builtin_amdgcn_s_barrier()
#define PG8_SCHED __builtin_amdgcn_sched_barrier(0)
#define PG8_SETB(u) do { _Pragma("unroll") for (int _i = 0; _i < 2; ++_i) { int R_, C_; stage_rc((int)(threadIdx.x) * 16 + _i * 8192, R_, C_); const int Rb_ = Epi::PERM ? ((R_ & ~31) + perm32(R_ & 31)) : R_; \
        voffB[_i] = (unsigned)Rb_ * (u).ldb + (unsigned)C_ * 2u; } hsB = (size_t)(u).hsb; } while (0)
    Unit cur, nxt; int ui = 0;
    if (!S.next(0, cur)) return;
    f32x4 acc[2][2][4][2];
    E.init(acc, cur, wr, wc, fr, fq);
    bf16x8 At[4][2], B0[2][2], B1[2][2];
    const char* cA = cur.A; const char* cB = cur.B; size_t hsB;
    PG8_SETB(cur);
    PG8_STAGE(PG8_SB(0, 0), cB, voffB); PG8_STAGE(PG8_SB(0, 1), cB + hsB, voffB); PG8_STAGE(PG8_SA(0, 0), cA, voffA); PG8_STAGE(PG8_SA(0, 1), cA + hstepA, voffA);
    if (wr == 1) PG8_BAR;
    PG8_WAIT_V(2); PG8_BAR;
    PG8_STAGE(PG8_SB(1, 0), cB + kstep, voffB); PG8_STAGE(PG8_SA(1, 0), cA + kstep, voffA); PG8_STAGE(PG8_SB(1, 1), cB + hsB + kstep, voffB);
    PG8_WAIT_V(6); PG8_BAR;
    for (;;) {
        const bool has_next = S.next(ui + 1, nxt);
        const char* nA = has_next ? nxt.A : cA; const char* nB = has_next ? nxt.B : cB;
        for (int t = 0; t < nt; t += 2) {
            const bool last = (t == nt - 2);
            const char* a1 = cA + (size_t)(t + 1) * kstep;
            const char* a2 = last ? nA : cA + (size_t)(t + 2) * kstep; const char* b2 = last ? nB : cB + (size_t)(t + 2) * kstep;
            const char* a3 = a2 + kstep; const char* b3 = b2 + kstep;
            if (last && has_next) PG8_SETB(nxt);
            PG8_LDB(B0, 0, 0); PG8_LDB(B1, 0, 1); PG8_SCHED; PG8_LDA(At, 0, 0); PG8_STAGE(PG8_SA(1, 1), a1 + hstepA, voffA);
            PG8_WAIT_V(8); PG8_WAIT_L(0); PG8_BAR; PG8_MMA(0, 0, At, B0); PG8_MMA(0, 1, At, B1); PG8_BAR; PG8_SCHED;
            PG8_LDA(At, 0, 1); PG8_STAGE(PG8_SB(0, 0), b2, voffB); PG8_STAGE(PG8_SB(0, 1), b2 + hsB, voffB); PG8_STAGE(PG8_SA(0, 0), a2, voffA);
            PG8_WAIT_V(8); PG8_WAIT_L(0); PG8_BAR; PG8_MMA(1, 0, At, B0); PG8_MMA(1, 1, At, B1); PG8_BAR; PG8_SCHED;
            PG8_LDB(B0, 1, 0); PG8_LDB(B1, 1, 1); PG8_SCHED; PG8_LDA(At, 1, 0); PG8_STAGE(PG8_SA(0, 1), a2 + hstepA, voffA);
            PG8_WAIT_V(8); PG8_WAIT_L(0); PG8_BAR; PG8_MMA(0, 0, At, B0); PG8_MMA(0, 1, At, B1); PG8_BAR; PG8_SCHED;
            PG8_LDA(At, 1, 1); PG8_STAGE(PG8_SB(1, 0), b3, voffB); PG8_STAGE(PG8_SB(1, 1), b3 + hsB, voffB); PG8_STAGE(PG8_SA(1, 0), a3, voffA);
            PG8_WAIT_V(8); PG8_WAIT_L(0); PG8_BAR; PG8_MMA(1, 0, At, B0); PG8_MMA(1, 1, At, B1); PG8_BAR; PG8_SCHED;
        }
        if (wr == 0) PG8_BAR;
        E(acc, cur, wr, wc, fr, fq);
        if (!has_next) break;
        E.init(acc, nxt, wr, wc, fr, fq);
        cur = nxt; cA = nA; cB = nB; ++ui;
        if (wr == 1) PG8_BAR;
    }
    PG8_WAIT_V(0);
    PG8_BAR;
#undef PG8_SA
#undef PG8_SB
#undef PG8_STAGE
#undef PG8_LDA
#undef PG8_LDB
#undef PG8_MMA
#undef PG8_WAIT_V
#undef PG8_WAIT_L
#undef PG8_BAR
#undef PG8_SCHED
#undef PG8_SETB
}
}

#define XB_TMO      128
#define XB_XCNT(j)  (256  + 64 * (j))
#define XB_XSUB(j)  (1280 + 64 * (j))
#define XB_XGEN(j)  (2304 + 64 * (j))
#define XB_TOP      3328
#define XB_TOPGEN   3392
#define XCD_BAR_WORDS 3456
#define XB_SPIN_CAP (1u << 18)
__device__ __forceinline__ unsigned xb_ld(unsigned* p)              { return __hip_atomic_load(p, __ATOMIC_RELAXED, __HIP_MEMORY_SCOPE_AGENT); }
__device__ __forceinline__ unsigned xb_add(unsigned* p, unsigned v) { return __hip_atomic_fetch_add(p, v, __ATOMIC_RELAXED, __HIP_MEMORY_SCOPE_AGENT); }
__device__ __forceinline__ unsigned xb_xcc_id() { return (unsigned)__builtin_amdgcn_s_getreg((3 << 11) | 20) & 0xFu; }
#define XB_SPIN(cond, bar) do { unsigned _sp = 0; while (cond) { __builtin_amdgcn_s_sleep(1); \
    if ((++_sp & 255u) == 0u) { if (xb_ld(&(bar)[XB_TMO])) break; if (_sp > XB_SPIN_CAP) { atomicAdd(&(bar)[XB_TMO], 1u); break; } } } } while (0)
struct XcdBarrier { unsigned* bar; unsigned x; volatile LAS unsigned* st; };
__device__ __forceinline__ XcdBarrier xcd_barrier_post(unsigned* bar, volatile LAS unsigned* st) {
    XcdBarrier b; b.bar = bar; b.x = xb_xcc_id(); b.st = st;
    if (threadIdx.x == 0) (void)xb_add(&bar[XB_XCNT(b.x)], 1u);
    return b;
}
__device__ __forceinline__ void xcd_barrier_complete(unsigned* bar, unsigned x, unsigned& nloc, unsigned& nx) {
    const unsigned G = gridDim.x * gridDim.y * gridDim.z;
    unsigned sum, cnt, mine, sp = 0u;
    for (;;) {
        sum = 0u; cnt = 0u; mine = 0u;
#pragma unroll
        for (unsigned j = 0; j < 16; ++j) { const unsigned c = xb_ld(&bar[XB_XCNT(j)]); sum += c; cnt += (c > 0u) ? 1u : 0u; mine = (j == x) ? c : mine; }
        if (sum == G) break;
        __builtin_amdgcn_s_sleep(1);
        if ((++sp & 255u) == 0u) { if (xb_ld(&bar[XB_TMO])) break; if (sp > XB_SPIN_CAP) { atomicAdd(&bar[XB_TMO], 1u); break; } }
    }
    nloc = mine > 0u ? mine : 1u; nx = cnt > 0u ? cnt : 1u;
}
__device__ __forceinline__ void xcd_barrier(const XcdBarrier& b) {
    asm volatile("s_waitcnt vmcnt(0)" ::: "memory");
    __syncthreads();
    if (threadIdx.x == 0) {
        unsigned* bar = b.bar;
        __builtin_amdgcn_s_waitcnt(0);
        unsigned nloc = b.st[0], nx = b.st[1];
        if (nloc == 0u) { xcd_barrier_complete(bar, b.x, nloc, nx); b.st[0] = nloc; b.st[1] = nx; }
        const unsigned old = xb_add(&bar[XB_XSUB(b.x)], 1u);
        const unsigned gen = old / nloc;
        if (old + 1u == (gen + 1u) * nloc) {
            __builtin_amdgcn_fence(__ATOMIC_RELEASE, "agent");
            asm volatile("s_waitcnt vmcnt(0)" ::: "memory");
            const unsigned og = xb_add(&bar[XB_TOP], 1u);
            const unsigned tg = og / nx;
            if (og + 1u == (tg + 1u) * nx) xb_add(&bar[XB_TOPGEN], 1u);
            else XB_SPIN(xb_ld(&bar[XB_TOPGEN]) == tg, bar);
            __builtin_amdgcn_fence(__ATOMIC_ACQUIRE, "agent");
            xb_add(&bar[XB_XGEN(b.x)], 1u);
            asm volatile("s_waitcnt vmcnt(0)" ::: "memory");
        } else {
            XB_SPIN(xb_ld(&bar[XB_XGEN(b.x)]) == gen, bar);
            __builtin_amdgcn_fence(__ATOMIC_ACQUIRE, "agent");
            asm volatile("s_waitcnt vmcnt(0)" ::: "memory");
        }
    }
    __syncthreads();
}

struct Job { int in, K, ld, col0, ncols, mode, sk, sidx; unsigned long long src, dst; unsigned item0; unsigned pad; };
constexpr int NJOBS = 60;
struct JobTab { Job j[NJOBS]; unsigned nitems; unsigned pad[3]; };
constexpr JobTab make_jobs() {
    JobTab t{}; int n = 0; unsigned it = 0;
    auto add = [&](int in, unsigned long long src, int K, int ld, int col0, int ncols, unsigned long long dst_elem, int mode, int sk, int sidx) {
        Job& q = t.j[n++]; q.in = in; q.K = K; q.ld = ld; q.col0 = col0; q.ncols = ncols; q.mode = mode; q.sk = sk; q.sidx = sidx; q.src = src; q.dst = dst_elem; q.item0 = it; q.pad = 0;
        it += (unsigned)((K / 64) * (ncols / 64)); };
    add(5, 0, 1024, 1024, 0, 1024, W_A_IN, 0, 0, 0);
    for (int g = 0; g < 4; ++g) add(6, (unsigned long long)g * 65536, 256, 256, 0, 256, W_A_GRP + (unsigned long long)g * 65536, 0, 2, g * 256);
    add(8, 0, 1024, 1024, 0, 1024, W_A_OUT, 0, 0, 0);
    for (int g = 0; g < 3; ++g) {
        add(9, 0, 1024, 9216, g * 3072, 1024, W_B_QK + (unsigned long long)g * 1048576, 0, 1, 0);
        add(9, 0, 1024, 9216, g * 3072 + 1024, 1024, W_B_QK + (unsigned long long)(3 + g) * 1048576, 0, 0, 0);
        add(9, 0, 1024, 9216, g * 3072 + 2048, 1024, W_B_V + (unsigned long long)g * 1048576, 0, 0, 0);
    }
    add(10, 0, 1024, 1024, 0, 1024, W_B_OUT, 0, 0, 0);
    add(11, 0, 1024, 3072, 0, 1024, W_C_QK, 0, 1, 0);
    add(11, 0, 1024, 3072, 1024, 1024, W_C_QK + 1048576, 0, 0, 0);
    add(11, 0, 1024, 3072, 2048, 1024, W_C_V, 0, 0, 0);
    add(14, 0, 1024, 1024, 0, 1024, W_C_OUT, 0, 0, 0);
    add(15, 0, 1024, 1536, 0, 1024, W_D_QK, 0, 1, 0);
    add(15, 0, 1024, 1536, 1024, 256, W_D_QK + 1048576, 0, 0, 0);
    add(15, 0, 1024, 1536, 1280, 256, W_D_V, 0, 0, 0);
    add(17, 0, 1024, 1024, 0, 1024, W_D_OUT, 0, 0, 0);
    for (int l = 0; l < 2; ++l) add(18, (unsigned long long)l * 1024 * 7168, 1024, 7168, 0, 7168, W_F_GU + (unsigned long long)l * 7168 * 1024, 1, 0, 0);
    for (int l = 0; l < 2; ++l) add(19, (unsigned long long)l * 3584 * 1024, 3584, 1024, 0, 1024, W_F_D + (unsigned long long)l * 3584 * 1024, 0, 0, 0);
    for (int l = 0; l < 16; ++l) add(21, (unsigned long long)l * 1024 * 7168, 1024, 7168, 0, 7168, W_M_GU + (unsigned long long)l * 7168 * 1024, 1, 0, 0);
    for (int l = 0; l < 16; ++l) add(22, (unsigned long long)l * 3584 * 1024, 3584, 1024, 0, 1024, W_M_D + (unsigned long long)l * 3584 * 1024, 0, 0, 0);
    t.nitems = it;
    return t;
}
__constant__ JobTab g_jobs = make_jobs();
static_assert(make_jobs().j[NJOBS - 1].K == 3584, "job count");

struct Args { const float* in[23]; float* out; unsigned char* ws; int ph_lo, ph_hi; };

struct Frame {
    LAS unsigned char* lds;
    int G, c, vcu;
    __device__ __forceinline__ int tid_() const { return (int)threadIdx.x; }
    __device__ __forceinline__ int lane_() const { return (int)threadIdx.x & 63; }
    __device__ __forceinline__ int wave_() const { return __builtin_amdgcn_readfirstlane((int)threadIdx.x >> 6); }
};

__device__ __forceinline__ void conv_item(const Job& jb, const float* __restrict__ src, bf16_t* __restrict__ dst, const float* __restrict__ cs, LAS unsigned* scr, unsigned item, int lane) {
    const int ntn = jb.ncols >> 6; const int kb = (int)item / ntn, nb = (int)item % ntn, k0 = kb * 64, n0 = nb * 64;
    int drow = n0;
    if (jb.mode == 1) { int n = n0; const bool up = n >= DFF; if (up) n -= DFF; drow = (n >> 7) * 256 + (n & 127) + (up ? 128 : 0); }
    const int a = lane & 15, b = lane >> 4;
    const float sc = (jb.sk == 1) ? QSCALE : 1.0f;
    f32x4 csv = (f32x4){sc, sc, sc, sc};
    if (jb.sk == 2) csv = *(const f32x4*)(cs + jb.sidx + n0 + 4 * a);
    const float* sp = src + (size_t)(k0 + 2 * b) * jb.ld + jb.col0 + n0 + 4 * a;
    f32x4 v0[8], v1[8];
#pragma unroll
    for (int i = 0; i < 8; ++i) { v0[i] = *(const f32x4*)(sp + (size_t)(8 * i) * jb.ld); v1[i] = *(const f32x4*)(sp + (size_t)(8 * i + 1) * jb.ld); }
#pragma unroll
    for (int i = 0; i < 8; ++i) { const f32x4 x0 = v0[i] * csv, x1 = v1[i] * csv; const int kp = 4 * i + b;
#pragma unroll
        for (int j = 0; j < 4; ++j) scr[(4 * a + j) * 33 + kp] = cvt_pk_bf16(x0[j], x1[j]); }
    LDS_WAIT();
    const int c = lane & 7;
#pragma unroll
    for (int jj = 0; jj < 8; ++jj) { const int n = (lane >> 3) + 8 * jj; const LAS unsigned* s = scr + n * 33 + 4 * c;
        u32x4 o; o.x = s[0]; o.y = s[1]; o.z = s[2]; o.w = s[3];
        *(u32x4*)(dst + (size_t)(drow + n) * jb.K + k0 + 8 * c) = o; }
    LDS_WAIT();
}

__device__ __forceinline__ int rel_bucket(int rel) {
    const int n = rel < 0 ? -rel : rel;
    int big = 8 + (int)(logf((float)(n < 1 ? 1 : n) / 8.0f) / 4.852030263919617f * 8.0f);
    big = big < 15 ? big : 15;
    return (rel > 0 ? 16 : 0) + (n < 8 ? n : big);
}

__device__ __forceinline__ void load_row(const float* xrow, int lane, f32x4 (&v)[4]) {
    const f32x4* xr = (const f32x4*)xrow + lane;
#pragma unroll
    for (int j = 0; j < 4; ++j) v[j] = xr[64 * j];
}
__device__ __forceinline__ float row_rstd(const f32x4 (&v)[4]) {
    float s = 0.f;
#pragma unroll
    for (int j = 0; j < 4; ++j) s += (v[j].x * v[j].x + v[j].y * v[j].y) + (v[j].z * v[j].z + v[j].w * v[j].w);
    return 1.0f / sqrtf(wave_sum(s) * (1.0f / DM) + RMS_EPS);
}
__device__ __forceinline__ void store_row_bf16(bf16_t* orow, int lane, const f32x4 (&v)[4]) {
    u32x2* o8 = (u32x2*)orow + lane;
#pragma unroll
    for (int j = 0; j < 4; ++j) { u32x2 w; w.x = cvt_pk_bf16(v[j].x, v[j].y); w.y = cvt_pk_bf16(v[j].z, v[j].w); o8[64 * j] = w; }
}
__device__ __forceinline__ void rms_phase(const Frame& F, const float* x, const float* gain, bf16_t* hn) {
    const int gw = F.c * NWAVES + F.wave_(), NGW = F.G * NWAVES;
    f32x4 g[4]; load_row(gain, F.lane_(), g);
    for (int m = gw; m < MTOK; m += NGW) {
        f32x4 v[4]; load_row(x + (size_t)m * DM, F.lane_(), v);
        const float rstd = row_rstd(v);
#pragma unroll
        for (int j = 0; j < 4; ++j) v[j] = v[j] * rstd * g[j];
        store_row_bf16(hn + (size_t)m * DM, F.lane_(), v);
    }
}

__device__ __forceinline__ int keyperm(int rho) { return (rho & 0x13) | ((rho & 4) << 1) | ((rho & 8) >> 1); }
template <int NVB> struct AttnAcc { f32x16 o[NVB]; float m, l; };
template <int NVB>
__device__ __forceinline__ void attn_tile(AttnAcc<NVB>& st, const bf16x8 (&qf)[4], const char* kptr, const char* vptr, const size_t vblk, const LAS float* bt) {
    bf16x8 kf[4], vf[NVB][2];
#pragma unroll
    for (int t = 0; t < 4; ++t) kf[t] = *(const bf16x8*)(kptr + t * 32);
#pragma unroll
    for (int b = 0; b < NVB; ++b)
#pragma unroll
        for (int t = 0; t < 2; ++t) vf[b][t] = *(const bf16x8*)(vptr + b * vblk + t * 32);
    f32x16 s;
#pragma unroll
    for (int r = 0; r < 16; ++r) s[r] = bt[(r >> 3) * 16 + (r & 7)];
#pragma unroll
    for (int t = 0; t < 4; ++t) s = __builtin_amdgcn_mfma_f32_32x32x16_bf16(kf[t], qf[t], s, 0, 0, 0);
    float mx = s[0];
#pragma unroll
    for (int r = 1; r < 16; ++r) mx = fmaxf(mx, s[r]);
    mx = fmaxf(mx, __shfl_xor(mx, 32));
    const float mn = fmaxf(st.m, mx), alpha = __builtin_amdgcn_exp2f(st.m - mn); st.m = mn;
    float ps = 0.f;
#pragma unroll
    for (int r = 0; r < 16; ++r) { s[r] = __builtin_amdgcn_exp2f(s[r] - mn); ps += s[r]; }
    st.l = st.l * alpha + ps;
#pragma unroll
    for (int b = 0; b < NVB; ++b) st.o[b] = st.o[b] * alpha;
    u32x4 p0, p1;
    p0.x = cvt_pk_bf16(s[0], s[1]); p0.y = cvt_pk_bf16(s[2], s[3]); p0.z = cvt_pk_bf16(s[4], s[5]); p0.w = cvt_pk_bf16(s[6], s[7]);
    p1.x = cvt_pk_bf16(s[8], s[9]); p1.y = cvt_pk_bf16(s[10], s[11]); p1.z = cvt_pk_bf16(s[12], s[13]); p1.w = cvt_pk_bf16(s[14], s[15]);
    const bf16x8 pf0 = __builtin_bit_cast(bf16x8, p0), pf1 = __builtin_bit_cast(bf16x8, p1);
#pragma unroll
    for (int b = 0; b < NVB; ++b) { st.o[b] = __builtin_amdgcn_mfma_f32_32x32x16_bf16(vf[b][0], pf0, st.o[b], 0, 0, 0); st.o[b] = __builtin_amdgcn_mfma_f32_32x32x16_bf16(vf[b][1], pf1, st.o[b], 0, 0, 0); }
}

template <int HALF>
__device__ __forceinline__ void band_item(const bf16_t* Qp, const bf16_t* Kp, const int ldqk, const size_t tok0, const int dil, const int L, const int q0,
                                          const bf16_t* Vt, const size_t vn0, const float* gtab_h, LAS float* tbl, const float m_init, const float l_init,
                                          bf16_t* out_row0  , const int ldo, float* lse_out  , const int lane) {
    const int ql = lane & 31, hf = lane >> 5;
    for (int i = lane; i < 2 * HALF + 63; i += 64) { const int j = i - HALF - 31; tbl[i] = (j >= -HALF && j <= HALF) ? gtab_h[j * dil + 2048] : NEG_BIG; }
    LDS_WAIT();
    const size_t qtok = tok0 + (size_t)(q0 + ql) * dil;
    bf16x8 qf[4];
#pragma unroll
    for (int t = 0; t < 4; ++t) qf[t] = *(const bf16x8*)(Qp + qtok * ldqk + 16 * t + 8 * hf);
    AttnAcc<2> st;
    st.o[0] = (f32x16){}; st.o[1] = (f32x16){}; st.m = m_init; st.l = (hf == 0) ? l_init : 0.f;
    const int kr = keyperm(ql);
    for (int kt = q0 - HALF; kt <= q0 + HALF; kt += 32) {
        if (kt < 0 || kt >= L) continue;
        const char* kptr = (const char*)(Kp + (tok0 + (size_t)(kt + kr) * dil) * ldqk + 8 * hf);
        const char* vptr = (const char*)(Vt + (size_t)ql * MTOK + vn0 + kt + 8 * hf);
        const LAS float* bt = tbl + (kt - q0 + HALF) + 8 * hf - ql + 31;
        attn_tile<2>(st, qf, kptr, vptr, (size_t)32 * MTOK * 2, bt);
    }
    const float lt = st.l + __shfl_xor(st.l, 32), inv = 1.0f / lt;
    bf16_t* orow = out_row0 + qtok * ldo;
#pragma unroll
    for (int b = 0; b < 2; ++b)
#pragma unroll
        for (int i = 0; i < 4; ++i) { u32x2 w; w.x = cvt_pk_bf16(st.o[b][4 * i] * inv, st.o[b][4 * i + 1] * inv); w.y = cvt_pk_bf16(st.o[b][4 * i + 2] * inv, st.o[b][4 * i + 3] * inv);
            *(u32x2*)(orow + 32 * b + 8 * i + 4 * hf) = w; }
    if (lse_out && hf == 0) lse_out[qtok * 16] = st.m + __builtin_amdgcn_logf(lt);
}


template <int HALF>
__device__ __forceinline__ void band_item64(const bf16_t* Qp, const bf16_t* Kp, const int ldqk, const size_t tok0, const int dil, const int L, const int q0,
                                            const bf16_t* Vt, const size_t vn0, const float* gtab_h, LAS float* tbl, LAS unsigned char* stg, const float m_init, const float l_init,
                                            bf16_t* out0, const int ldo, float* lse_out, const int lane) {
    const int ql = lane & 31, hf = lane >> 5, kp = keyperm(ql);
    for (int i = lane; i < 2 * HALF + 63; i += 64) { const int j = i - HALF - 31; tbl[i] = (j >= -HALF && j <= HALF) ? gtab_h[j * dil + 2048] : NEG_BIG; }
    unsigned ka[4], va[2];
#pragma unroll
    for (int t = 0; t < 4; ++t) ka[t] = (unsigned)(kp * 128 + (((2 * t + hf) ^ ((kp >> 1) & 7)) << 4));
#pragma unroll
    for (int t = 0; t < 2; ++t) va[t] = (unsigned)(ql * 64 + (((2 * t + hf) ^ ((ql >> 2) & 3)) << 4));
    const size_t krow = (size_t)dil * ldqk * 2;
    const char* kg = (const char*)Kp + (tok0 + (size_t)(lane >> 3) * dil) * ldqk * 2;
    const unsigned kcE = (unsigned)(((lane & 7) ^ (lane >> 4)) << 4), kcO = (unsigned)(((lane & 7) ^ (4 + (lane >> 4))) << 4);
    const char* vg = (const char*)(Vt + (size_t)(lane >> 2) * MTOK + vn0) + ((((lane & 3) ^ (lane >> 4))) << 4);
#define BI_GLDS(g, l) __builtin_amdgcn_global_load_lds((const unsigned*)(g), (LAS unsigned*)(l), 16, 0, 0)
#define BI_ISSUE(kt_, s_) do { LAS unsigned char* sb_ = stg + (s_) * 8192; const char* k_ = kg + (size_t)(kt_) * krow; const char* v_ = vg + (size_t)(kt_) * 2; \
        BI_GLDS(k_ + kcE, sb_); BI_GLDS(k_ + 8 * krow + kcO, sb_ + 1024); BI_GLDS(k_ + 16 * krow + kcE, sb_ + 2048); BI_GLDS(k_ + 24 * krow + kcO, sb_ + 3072); \
        BI_GLDS(v_, sb_ + 4096); BI_GLDS(v_ + (size_t)16 * MTOK * 2, sb_ + 5120); BI_GLDS(v_ + (size_t)32 * MTOK * 2, sb_ + 6144); BI_GLDS(v_ + (size_t)48 * MTOK * 2, sb_ + 7168); } while (0)
    bf16x8 qf[2][4];
#pragma unroll
    for (int g = 0; g < 2; ++g)
#pragma unroll
        for (int t = 0; t < 4; ++t) qf[g][t] = *(const bf16x8*)(Qp + (tok0 + (size_t)(q0 + 32 * g + ql) * dil) * ldqk + 16 * t + 8 * hf);
    f32x16 o[2][2]; float mr[2], lr[2];
#pragma unroll
    for (int g = 0; g < 2; ++g) { o[g][0] = (f32x16){}; o[g][1] = (f32x16){}; mr[g] = m_init; lr[g] = (hf == 0) ? l_init : 0.f; }
    const int kt_lo = (q0 - HALF) < 0 ? 0 : q0 - HALF, kt_hi = (q0 + 32 + HALF) > (L - 32) ? (L - 32) : q0 + 32 + HALF;
    asm volatile("s_waitcnt lgkmcnt(0)" ::: "memory");
    BI_ISSUE(kt_lo, 0);
    int s = 0;
    for (int kt = kt_lo; kt <= kt_hi; kt += 32) {
        if (kt + 32 <= kt_hi) { BI_ISSUE(kt + 32, s ^ 1); asm volatile("s_waitcnt vmcnt(8)" ::: "memory"); }
        else asm volatile("s_waitcnt vmcnt(0)" ::: "memory");
        const LAS unsigned char* Kt = stg + s * 8192; const LAS unsigned char* Vs = Kt + 4096;
        bf16x8 kf[4], vf[2][2];
#pragma unroll
        for (int t = 0; t < 4; ++t) kf[t] = *(const LAS bf16x8*)(Kt + ka[t]);
#pragma unroll
        for (int b = 0; b < 2; ++b)
#pragma unroll
            for (int t = 0; t < 2; ++t) vf[b][t] = *(const LAS bf16x8*)(Vs + b * 2048 + va[t]);
#pragma unroll
        for (int g = 0; g < 2; ++g) {
            const int qg = q0 + 32 * g;
            if (kt >= qg - HALF && kt <= qg + HALF) {
                const LAS float* bt = tbl + (kt - qg + HALF) + 8 * hf - ql + 31;
                f32x16 sc;
#pragma unroll
                for (int r = 0; r < 16; ++r) sc[r] = bt[(r >> 3) * 16 + (r & 7)];
#pragma unroll
                for (int t = 0; t < 4; ++t) sc = __builtin_amdgcn_mfma_f32_32x32x16_bf16(kf[t], qf[g][t], sc, 0, 0, 0);
                float mx = sc[0];
#pragma unroll
                for (int r = 1; r < 16; ++r) mx = fmaxf(mx, sc[r]);
                mx = fmaxf(mx, __shfl_xor(mx, 32));
                const float mn = fmaxf(mr[g], mx), alpha = __builtin_amdgcn_exp2f(mr[g] - mn); mr[g] = mn;
                float ps = 0.f;
#pragma unroll
                for (int r = 0; r < 16; ++r) { sc[r] = __builtin_amdgcn_exp2f(sc[r] - mn); ps += sc[r]; }
                lr[g] = lr[g] * alpha + ps;
                o[g][0] = o[g][0] * alpha; o[g][1] = o[g][1] * alpha;
                u32x4 p0, p1;
                p0.x = cvt_pk_bf16(sc[0], sc[1]); p0.y = cvt_pk_bf16(sc[2], sc[3]); p0.z = cvt_pk_bf16(sc[4], sc[5]); p0.w = cvt_pk_bf16(sc[6], sc[7]);
                p1.x = cvt_pk_bf16(sc[8], sc[9]); p1.y = cvt_pk_bf16(sc[10], sc[11]); p1.z = cvt_pk_bf16(sc[12], sc[13]); p1.w = cvt_pk_bf16(sc[14], sc[15]);
                const bf16x8 pf0 = __builtin_bit_cast(bf16x8, p0), pf1 = __builtin_bit_cast(bf16x8, p1);
#pragma unroll
                for (int b = 0; b < 2; ++b) { o[g][b] = __builtin_amdgcn_mfma_f32_32x32x16_bf16(vf[b][0], pf0, o[g][b], 0, 0, 0); o[g][b] = __builtin_amdgcn_mfma_f32_32x32x16_bf16(vf[b][1], pf1, o[g][b], 0, 0, 0); }
            }
        }
        s ^= 1;
    }
#pragma unroll
    for (int g = 0; g < 2; ++g) {
        const float lt = lr[g] + __shfl_xor(lr[g], 32), inv = 1.0f / lt;
        const size_t qtok = tok0 + (size_t)(q0 + 32 * g + ql) * dil;
        bf16_t* orow = out0 + qtok * ldo;
#pragma unroll
        for (int b = 0; b < 2; ++b)
#pragma unroll
            for (int i = 0; i < 4; ++i) { u32x2 w; w.x = cvt_pk_bf16(o[g][b][4 * i] * inv, o[g][b][4 * i + 1] * inv); w.y = cvt_pk_bf16(o[g][b][4 * i + 2] * inv, o[g][b][4 * i + 3] * inv);
                *(u32x2*)(orow + 32 * b + 8 * i + 4 * hf) = w; }
        if (lse_out && hf == 0) lse_out[qtok * 16] = mr[g] + __builtin_amdgcn_logf(lt);
    }
#undef BI_GLDS
#undef BI_ISSUE
}

struct PlainSched {
    const char* A; const char* B; unsigned lda, ldb; int nM, nN, G, c; size_t co_m, co_n;
    __device__ __forceinline__ bool next(int i, pg8::Unit& u) const {
        const long L = (long)i * G + c; if (L >= (long)nM * nN) return false;
        int pm, pn; pg8::tile_order(nM, nN, (int)L, pm, pn);
        u.A = A + (size_t)pm * 256 * lda; u.B = B + (size_t)pn * 256 * ldb; u.ldb = ldb; u.hsb = 128u * ldb; u.co = (size_t)pm * co_m + (size_t)pn * co_n; u.tag = 0; return true;
    }
};
struct QkvSched {
    const char* hn; const char* Wqk; const char* Wv; int nNqk, nvp, nMv, dshift, G, c; int ldqk;
    __device__ __forceinline__ bool next(int i, pg8::Unit& u) const {
        long L = (long)i * G + c; const int n0 = 64 * nNqk, nv = nMv * 64;
        if (L < n0) { int pm, pn; pg8::tile_order(64, nNqk, (int)L, pm, pn);
            u.A = hn + (size_t)pm * 256 * 2048; u.B = Wqk + (size_t)pn * 256 * 2048; u.ldb = 2048u; u.hsb = 128u * 2048u; u.co = (size_t)pm * 256 * ldqk + (size_t)pn * 256; u.tag = 0; return true; }
        L -= n0; if (L >= (long)nvp * nv) return false;
        const int g = (int)(L / nv); int pm, pn; pg8::tile_order(nMv, 64, (int)(L % nv), pm, pn);
        const int d = 1 << (dshift * g), b = pn >> 3, nn = (pn & 7) * 256;
        size_t tok; unsigned ldb, hsb;
        if (d == 1) { tok = (size_t)b * SEQ + nn; ldb = 2048u; hsb = 128u * 2048u; }
        else if (d == 4) { tok = (size_t)b * SEQ + (size_t)(nn & 511) * 4 + (nn >> 9); ldb = 4u * 2048u; hsb = 128u * 4u * 2048u; }
        else { tok = (size_t)b * SEQ + (nn >> 7); ldb = 16u * 2048u; hsb = 2048u; }
        u.A = Wv + (size_t)(g * nMv + pm) * 256 * 2048; u.B = hn + tok * 2048; u.ldb = ldb; u.hsb = hsb;
        u.co = (size_t)(g * nMv + pm) * 256 * MTOK + (size_t)pn * 256; u.tag = 1; return true;
    }
};
struct MoeSched {
    const char* A; const char* B; unsigned lda, ldb; const int* panel; size_t estride; int nN, G, c; size_t co_m, co_n; int use_limit;
    __device__ __forceinline__ bool next(int i, pg8::Unit& u) const {
        const int nM = panel[0]; const long L = (long)i * G + c; const long lim = (use_limit && panel[3] > 1) ? (long)panel[1] : (long)nM * nN; if (L >= lim) return false;
        int pm, pn; pg8::tile_order(nM, nN, (int)L, pm, pn); const int e = panel[4 + pm];
        u.A = A + (size_t)pm * 256 * lda; u.B = B + (size_t)e * estride + (size_t)pn * 256 * ldb; u.ldb = ldb; u.hsb = 128u * ldb; u.co = (size_t)pm * co_m + (size_t)pn * co_n; u.tag = 0; return true;
    }
};
struct MoeSplitSched {
    const char* A; const char* B; const int* panel; size_t estride; int c;
    __device__ __forceinline__ bool next(int i, pg8::Unit& u) const {
        const int S = panel[3], rem = panel[2]; if (i > 0 || S <= 1 || c >= rem * S) return false;
        const int q = c / S, ks = c - q * S, ksub = (DFF / S) * 2;
        int pm, pn; pg8::tile_order(panel[0], 4, panel[1] + q, pm, pn); const int e = panel[4 + pm];
        u.A = A + (size_t)pm * 256 * 7168 + (size_t)ks * ksub; u.B = B + (size_t)e * estride + (size_t)pn * 256 * 7168 + (size_t)ks * ksub; u.ldb = 7168u; u.hsb = 128u * 7168u; u.co = (size_t)c * 65536; u.tag = 0; return true;
    }
};

__device__ __forceinline__ void moe_route(const Frame& F, const float* x, const float* gain, const float* router, bf16_t* hn, int* e12, float* g1o, float* g2o, int* cnt_wg) {
    LAS float* Rt = (LAS float*)F.lds;
    LAS int* cnt = (LAS int*)(F.lds + 32768);
    for (int i = F.tid_(); i < DM * NE; i += NWAVES * 64) { const int k = i >> 3, e = i & 7; Rt[e * DM + k] = router[i]; }
    f32x4 g[4]; load_row(gain, F.lane_(), g);
    for (int ch = F.c; ch < MTOK / 64; ch += F.G) {
        if (F.tid_() < 8) cnt[F.tid_()] = 0;
        __syncthreads();
        for (int i = 0; i < 8; ++i) {
            const int m = ch * 64 + F.wave_() * 8 + i;
            f32x4 v[4]; load_row(x + (size_t)m * DM, F.lane_(), v);
            const float rstd = row_rstd(v);
#pragma unroll
            for (int j = 0; j < 4; ++j) v[j] = v[j] * rstd * g[j];
            store_row_bf16(hn + (size_t)m * DM, F.lane_(), v);
            float lg[8];
#pragma unroll
            for (int e = 0; e < 8; ++e) { float s = 0.f;
#pragma unroll
                for (int j = 0; j < 4; ++j) { const f32x4 r = *(const LAS f32x4*)(Rt + e * DM + 4 * F.lane_() + 256 * j); s += (v[j].x * r.x + v[j].y * r.y) + (v[j].z * r.z + v[j].w * r.w); }
                lg[e] = wave_sum(s); }
            int e1 = 0; float v1 = lg[0];
#pragma unroll
            for (int e = 1; e < 8; ++e) if (lg[e] > v1) { v1 = lg[e]; e1 = e; }
            int e2 = -1; float v2 = -3.4e38f;
#pragma unroll
            for (int e = 0; e < 8; ++e) if (e != e1 && lg[e] > v2) { v2 = lg[e]; e2 = e; }
            const float ex = __expf(v2 - v1), ga = 1.0f / (1.0f + ex), gb = ex * ga;
            if (F.lane_() == 0) { e12[m] = e1 | (e2 << 8); g1o[m] = ga; g2o[m] = gb; atomicAdd((int*)&cnt[e1], 1); atomicAdd((int*)&cnt[e2], 1); }
        }
        __syncthreads();
        if (F.tid_() < 8) cnt_wg[ch * 8 + F.tid_()] = cnt[F.tid_()];
        __syncthreads();
    }
}
__device__ __forceinline__ void moe_assign(const Frame& F, const bf16_t* hn, const int* e12, const int* cnt_wg, int* p1o, int* p2o, int* panel, bf16_t* hs) {
    LAS int* psum = (LAS int*)F.lds;
    LAS int* tot = psum + 512; LAS int* base = tot + 8; LAS int* off = base + 8;
    LAS int* plist = off + 16;
    for (int ch = F.c; ch < MTOK / 64; ch += F.G) {
        { const int e = F.tid_() & 7, part = F.tid_() >> 3; int s = 0;
#pragma unroll
          for (int q = 0; q < 4; ++q) s += cnt_wg[(4 * part + q) * 8 + e];
          psum[part * 8 + e] = s; }
        __syncthreads();
        if (F.tid_() < 8) { const int e = F.tid_(); int t = 0, b = 0; for (int p = 0; p < 64; ++p) { const int s = psum[p * 8 + e]; if (p < (ch >> 2)) b += s; t += s; }
            for (int q = 0; q < (ch & 3); ++q) b += cnt_wg[(4 * (ch >> 2) + q) * 8 + e];
            tot[e] = t; base[e] = b; }
        __syncthreads();
        if (F.tid_() == 0) { int o = 0; for (int e = 0; e < 8; ++e) { off[e] = o; o += (tot[e] + 255) & ~255; } off[8] = o; }
        __syncthreads();
        if (F.wave_() == 0) {
            const int m = ch * 64 + F.lane_(); const int ee = e12[m]; const int e1 = ee & 255, e2 = ee >> 8; int p1 = 0, p2 = 0;
#pragma unroll
            for (int e = 0; e < 8; ++e) { const unsigned long long mk = __ballot(e1 == e || e2 == e); const int rk = __popcll(mk & ((1ull << F.lane_()) - 1ull));
                if (e1 == e) p1 = off[e] + base[e] + rk; if (e2 == e) p2 = off[e] + base[e] + rk; }
            p1o[m] = p1; p2o[m] = p2; plist[2 * F.lane_()] = p1; plist[2 * F.lane_() + 1] = p2;
        }
        __syncthreads();
        for (int i = 0; i < 16; ++i) { const int pr = F.wave_() * 16 + i; const int m = ch * 64 + (pr >> 1); const int pos = plist[pr];
            const u32x4* s = (const u32x4*)(hn + (size_t)m * DM); u32x4* d = (u32x4*)(hs + (size_t)pos * DM);
            const u32x4 a = s[F.lane_()], b = s[64 + F.lane_()]; d[F.lane_()] = a; d[64 + F.lane_()] = b; }
        if (ch < 8) { const int e = ch; for (int r = off[e] + tot[e] + F.wave_(); r < off[e + 1]; r += NWAVES) { u32x4* d = (u32x4*)(hs + (size_t)r * DM); d[F.lane_()] = (u32x4){0, 0, 0, 0}; d[64 + F.lane_()] = (u32x4){0, 0, 0, 0}; } }
        if (ch == 0) { const int P_ = off[8] >> 8, U_ = 4 * P_, full_ = (U_ / F.G) * F.G, rem_ = U_ - full_;
            const int S_ = (rem_ == 0) ? 1 : (rem_ * 7 <= F.G ? 7 : (rem_ * 4 <= F.G ? 4 : 1));
            if (F.tid_() == 0) { panel[0] = P_; panel[1] = full_; panel[2] = rem_; panel[3] = S_; }
            for (int L = F.tid_(); L < U_; L += NWAVES * 64) { int pm, pn; pg8::tile_order(P_, 4, L, pm, pn); panel[160 + pm * 4 + pn] = (S_ > 1 && L >= full_) ? L - full_ : -1; }
            if (F.tid_() < NPANEL_MAX) { const int r = F.tid_() * 256; int e = 0;
#pragma unroll
                for (int q = 1; q < 8; ++q) if (r >= off[q]) e = q;
                panel[4 + F.tid_()] = e; } }
        __syncthreads();
    }
}
__device__ __forceinline__ void moe_add_row(const Frame& F, f32x4 (&v)[4], const bf16_t* ys, const float* part, const int* panel, const int pos, const float gt) {
    const int pm = pos >> 8, S = panel[3];
    const u32x2* ya = (const u32x2*)(ys + (size_t)pos * DM) + F.lane_();
#pragma unroll
    for (int j = 0; j < 4; ++j) {
        const int sid = (S > 1) ? panel[160 + pm * 4 + j] : -1;
        if (sid < 0) { const u32x2 a = ya[64 * j]; v[j].x += gt * bf_lo(a.x); v[j].y += gt * bf_hi(a.x); v[j].z += gt * bf_lo(a.y); v[j].w += gt * bf_hi(a.y); }
        else { const float* pp = part + (size_t)sid * S * 65536 + (size_t)(pos & 255) * 256 + 4 * F.lane_(); f32x4 t[7];
#pragma unroll
            for (int ks = 0; ks < 7; ++ks) t[ks] = (ks < S) ? *(const f32x4*)(pp + (size_t)ks * 65536) : (f32x4){0.f, 0.f, 0.f, 0.f};
            v[j] += (((t[0] + t[1]) + (t[2] + t[3])) + ((t[4] + t[5]) + t[6])) * gt; }
    }
}
__device__ __forceinline__ void moe_combine(const Frame& F, const float* x, const bf16_t* ys, const float* part, const int* panel, const int* p1, const int* p2, const float* g1, const float* g2, const float* gain, float* xo, bf16_t* hn, float* outf) {
    const int gw = F.c * NWAVES + F.wave_(), NGW = F.G * NWAVES;
    f32x4 g[4]; load_row(gain, F.lane_(), g);
    for (int m = gw; m < MTOK; m += NGW) {
        f32x4 v[4]; load_row(x + (size_t)m * DM, F.lane_(), v);
        moe_add_row(F, v, ys, part, panel, p1[m], g1[m]);
        moe_add_row(F, v, ys, part, panel, p2[m], g2[m]);
        if (xo) { f32x4* o = (f32x4*)(xo + (size_t)m * DM) + F.lane_();
#pragma unroll
            for (int j = 0; j < 4; ++j) o[64 * j] = v[j]; }
        const float rstd = row_rstd(v);
#pragma unroll
        for (int j = 0; j < 4; ++j) v[j] = v[j] * rstd * g[j];
        if (outf) { f32x4* o = (f32x4*)(outf + (size_t)m * DM) + F.lane_();
#pragma unroll
            for (int j = 0; j < 4; ++j) o[64 * j] = v[j]; }
        else store_row_bf16(hn + (size_t)m * DM, F.lane_(), v);
    }
}


__global__ void __launch_bounds__(NWAVES * 64, 2) enc_fwd(Args args) {
    extern __shared__ __attribute__((aligned(16))) unsigned char lds_raw[];
    Frame F;
    F.lds = (LAS unsigned char*)lds_raw;
    F.G = gridDim.x; F.c = blockIdx.x; F.vcu = (F.G % 8 == 0) ? (F.c % 8) * (F.G / 8) + F.c / 8 : F.c;
    unsigned char* ws = args.ws;
    volatile LAS unsigned* MISC = (volatile LAS unsigned*)(F.lds + MISC_OFF);
    for (int u = F.tid_(); u < (LDS_BYTES - LDSCTL_OFF) / 4; u += NWAVES * 64) ((LAS unsigned*)(F.lds + LDSCTL_OFF))[u] = 0u;
    __syncthreads();
#if MK_MULTI
    #define GRID_BAR() do { } while (0)
#else
    XcdBarrier bar = xcd_barrier_post((unsigned*)(ws + WS_CTL) + CW_BAR, MISC + 8);
    #define GRID_BAR() xcd_barrier(bar)
#endif
    const int lo = args.ph_lo, hi = args.ph_hi;
#define IN(k) (lo <= (k) && (k) < hi)
#define SEAM(k) do { if (IN((k) + 1)) GRID_BAR(); } while (0)
#define PREP(k) ((((unsigned long long)(PROBE_MASK) >> (k)) & 1ull) ? PROBE_N : 1)
#define PH_BEGIN(k) if (IN(k)) { for (int rep_ = 0; rep_ < PREP(k); ++rep_) {
#define PH_END(k) } SEAM(k); }

    const float* x_in = args.in[0]; const float* rel_bias = args.in[1]; const float* norm_mix = args.in[2]; const float* norm_ffn = args.in[3]; const float* norm_final = args.in[4];
    bf16_t* Wb = (bf16_t*)(ws + WS_W);
    float* gtab = (float*)(ws + WS_TAB); float* misc = (float*)(ws + WS_MISC);
    int* r_e12 = (int*)(ws + WS_ROUTE); float* r_g1 = (float*)(ws + WS_ROUTE + 65536); float* r_g2 = (float*)(ws + WS_ROUTE + 2 * 65536);
    int* r_p1 = (int*)(ws + WS_ROUTE + 3 * 65536); int* r_p2 = (int*)(ws + WS_ROUTE + 4 * 65536);
    int* cnt_wg = (int*)(ws + WS_CNT); int* panel = (int*)(ws + WS_PANEL);
    float* XA = (float*)(ws + WS_XA); float* XB = (float*)(ws + WS_XB);
    bf16_t* HN = (bf16_t*)(ws + WS_HN); bf16_t* BUFA = (bf16_t*)(ws + WS_BUFA); bf16_t* BUFB = (bf16_t*)(ws + WS_BUFB); bf16_t* BUFC = (bf16_t*)(ws + WS_BUFC);
    bf16_t* BIG = (bf16_t*)(ws + WS_BIG); bf16_t* VT = (bf16_t*)(ws + WS_VT); bf16_t* OG = (bf16_t*)(ws + WS_OG); float* LSE = (float*)(ws + WS_LSE);
    bf16_t* HS = VT; bf16_t* YS = OG; float* PART = (float*)(ws + WS_PART);
    LAS unsigned char* ring = F.lds;

#define PLAIN_GEMM(EPI, Aptr, Bptr, K_, lda_, ldb_, nM_, nN_, com_, con_) do { \
        PlainSched S_{(const char*)(Aptr), (const char*)(Bptr), (unsigned)(lda_), (unsigned)(ldb_), (nM_), (nN_), F.G, F.c, (size_t)(com_), (size_t)(con_)}; \
        pg8::gemm_phase(ring, (K_), (unsigned)(lda_), S_, EPI); } while (0)

#define DENSE_FFN(p, l, xr, xo) \
    PH_BEGIN(p) pg8::EpiSwiglu E_{BIG, DFF}; PLAIN_GEMM(E_, HN, Wb + W_F_GU + (size_t)(l) * 7168 * 1024, 1024, 2048, 2048, 64, 28, 256 * DFF, 128); PH_END(p) \
    PH_BEGIN((p) + 1) pg8::EpiResid E_{(xr), (xo)}; PLAIN_GEMM(E_, BIG, Wb + W_F_D + (size_t)(l) * 3584 * 1024, 3584, 7168, 7168, 64, 4, 256 * DM, 256); PH_END((p) + 1)

#define MOE_FFN(p, l, xr, gain) \
    PH_BEGIN(p) moe_route(F, (xr), (gain), args.in[20] + (size_t)(l) * DM * NE, HN, r_e12, r_g1, r_g2, cnt_wg); PH_END(p) \
    PH_BEGIN((p) + 1) moe_assign(F, HN, r_e12, cnt_wg, r_p1, r_p2, panel, HS); PH_END((p) + 1) \
    PH_BEGIN((p) + 2) pg8::EpiSwiglu E_{BIG, DFF}; MoeSched S_{(const char*)HS, (const char*)(Wb + W_M_GU + (size_t)(l) * 8 * 7168 * 1024), 2048u, 2048u, panel, (size_t)7168 * 1024 * 2, 28, F.G, F.c, (size_t)256 * DFF, (size_t)128, 0}; \
        pg8::gemm_phase(ring, 1024, 2048u, S_, E_); PH_END((p) + 2) \
    PH_BEGIN((p) + 3) pg8::EpiBf16 E_{YS, DM, YS, DM}; MoeSched S_{(const char*)BIG, (const char*)(Wb + W_M_D + (size_t)(l) * 8 * 3584 * 1024), 7168u, 7168u, panel, (size_t)3584 * 1024 * 2, 4, F.G, F.c, (size_t)256 * DM, (size_t)256, 1}; \
        pg8::gemm_phase(ring, 3584, 7168u, S_, E_); \
        { pg8::EpiPart E2_{PART}; MoeSplitSched S2_{(const char*)BIG, (const char*)(Wb + W_M_D + (size_t)(l) * 8 * 3584 * 1024), panel, (size_t)3584 * 1024 * 2, F.c}; \
          const int sp_ = panel[3] > 1 ? panel[3] : 1; pg8::gemm_phase(ring, DFF / sp_, 7168u, S2_, E2_); } PH_END((p) + 3)

    PH_BEGIN(0)
        LAS unsigned* scr = (LAS unsigned*)(F.lds + F.wave_() * 8448);
        const unsigned gw = (unsigned)(F.c * NWAVES + F.wave_()), NGW = (unsigned)(F.G * NWAVES);
        int jn = 0;
        for (unsigned it = gw; it < g_jobs.nitems; it += NGW) {
            while (jn + 1 < NJOBS && g_jobs.j[jn + 1].item0 <= it) ++jn;
            const Job& jb = g_jobs.j[jn];
            conv_item(jb, args.in[jb.in] + jb.src, Wb + jb.dst, args.in[7], scr, it - jb.item0, F.lane_());
        }
        for (int i = F.c * NWAVES * 64 + F.tid_(); i < 16 * 4096; i += F.G * NWAVES * 64) { const int h = i >> 12, idx = i & 4095; gtab[i] = rel_bias[rel_bucket(idx - 2048) * 16 + h] * LOG2E; }
        if (F.c == 1) for (int i = F.tid_(); i < 4096; i += NWAVES * 64) ((unsigned char*)(ws + WS_BID))[i] = (unsigned char)rel_bucket(i - 2048);
        if (F.c == 0 && F.tid_() == 0) { const float* lv = args.in[12]; float s0 = 0.f, s1 = 0.f; for (int i = 0; i < 64; ++i) { s0 += lv[i] * lv[64 + i]; s1 += lv[128 + i] * lv[192 + i]; }
            const float lam_init = 0.8f - 0.6f * expf(-0.3f * 2.0f); misc[0] = expf(s0) - expf(s1) + lam_init; misc[1] = lam_init; }
        rms_phase(F, x_in, norm_mix, HN);
        PH_END(0)
    PH_BEGIN(1) pg8::EpiBf16 E_{BUFA, DM, BUFA, DM}; PLAIN_GEMM(E_, HN, Wb + W_A_IN, 1024, 2048, 2048, 64, 4, 256 * DM, 256); PH_END(1)
    PH_BEGIN(2)
        for (int it = F.c * NWAVES * 64 + F.tid_(); it < MTOK * 128; it += F.G * NWAVES * 64) {
            const int t = it >> 7, cc = it & 127, g = cc >> 5, hw = 1 << g, s = t & (SEQ - 1);
            const int lo_ = (s - hw) < 0 ? 0 : s - hw, hi_ = (s + hw) > SEQ ? SEQ : s + hw;
            const bf16_t* base = BUFA + (size_t)(t - s) * DM + cc * 8;
            float a[8] = {0, 0, 0, 0, 0, 0, 0, 0};
            for (int r = lo_; r < hi_; ++r) { const u32x4 w = *(const u32x4*)(base + (size_t)r * DM);
                a[0] += bf_lo(w.x); a[1] += bf_hi(w.x); a[2] += bf_lo(w.y); a[3] += bf_hi(w.y); a[4] += bf_lo(w.z); a[5] += bf_hi(w.z); a[6] += bf_lo(w.w); a[7] += bf_hi(w.w); }
            const float ic = 1.0f / (float)(hi_ - lo_); const u32x4 w = *(const u32x4*)(base + (size_t)s * DM);
            u32x4 o; o.x = cvt_pk_bf16(a[0] * ic - bf_lo(w.x), a[1] * ic - bf_hi(w.x)); o.y = cvt_pk_bf16(a[2] * ic - bf_lo(w.y), a[3] * ic - bf_hi(w.y));
            o.z = cvt_pk_bf16(a[4] * ic - bf_lo(w.z), a[5] * ic - bf_hi(w.z)); o.w = cvt_pk_bf16(a[6] * ic - bf_lo(w.w), a[7] * ic - bf_hi(w.w));
            *(u32x4*)(BUFB + (size_t)t * DM + cc * 8) = o;
        }
        PH_END(2)
    PH_BEGIN(3)
        struct GrpSched { const char* A; const char* B; int G, c;
            __device__ __forceinline__ bool next(int i, pg8::Unit& u) const { const int L = i * G + c; if (L >= 256) return false; int pm, pn; pg8::tile_order(64, 4, L, pm, pn);
                u.A = A + (size_t)pm * 256 * 2048 + pn * 512; u.B = B + (size_t)pn * 65536 * 2; u.ldb = 512u; u.hsb = 128u * 512u; u.co = (size_t)pm * 256 * DM + pn * 256; u.tag = 0; return true; } };
        GrpSched S_{(const char*)BUFB, (const char*)(Wb + W_A_GRP), F.G, F.c}; pg8::EpiBf16 E_{BUFC, DM, BUFC, DM};
        pg8::gemm_phase(ring, 256, 2048u, S_, E_); PH_END(3)
    PH_BEGIN(4) pg8::EpiResid E_{x_in, XA}; PLAIN_GEMM(E_, BUFC, Wb + W_A_OUT, 1024, 2048, 2048, 64, 4, 256 * DM, 256); PH_END(4)
    PH_BEGIN(5) rms_phase(F, XA, norm_ffn, HN); PH_END(5)
    DENSE_FFN(6, 0, XA, XB)
    PH_BEGIN(8) rms_phase(F, XB, norm_mix + DM, HN); PH_END(8)
    PH_BEGIN(9)
        QkvSched S_{(const char*)HN, (const char*)(Wb + W_B_QK), (const char*)(Wb + W_B_V), 24, 3, 4, 2, F.G, F.c, 6144};
        pg8::EpiBf16 E_{BIG, 6144, VT, MTOK}; pg8::gemm_phase(ring, 1024, 2048u, S_, E_); PH_END(9)
    PH_BEGIN(10)
        LAS float* tbl = (LAS float*)(F.lds + BI_TAB + F.wave_() * 1280); LAS unsigned char* stgw = F.lds + F.wave_() * 16384;
        int lane10 = F.lane_(); asm volatile("" : "+v"(lane10));
        for (int i = 0; i < 6; ++i) {
            const int w = (i * F.G + F.vcu) * NWAVES + F.wave_(); if (w >= 3 * 4096) break;
            const int g = w >> 12, rest = w & 4095, b = rest >> 9, h = (rest >> 5) & 15, blk = rest & 31;
            const int dil = (g == 0) ? 1 : (g == 1 ? 4 : 16), L = SEQ / dil, nqb = L >> 6, r = blk / nqb, qb = blk % nqb;
            band_item64<64>(BIG + g * 1024 + h * 64, BIG + 3072 + g * 1024 + h * 64, 6144, (size_t)b * SEQ + r, dil, L, qb * 64,
                            VT + (size_t)(g * 1024 + h * 64) * MTOK, (size_t)b * SEQ + (size_t)r * L, gtab + h * 4096, tbl, stgw, NEG_BIG, 0.f,
                            OG + (size_t)g * MTOK * DM + h * 64, DM, LSE + (size_t)g * MTOK * 16 + h, lane10);
        }
        PH_END(10)
    PH_BEGIN(11)
        for (int it = F.c * NWAVES * 64 + F.tid_(); it < MTOK * 128; it += F.G * NWAVES * 64) {
            const int t = it >> 7, cc = it & 127, h = cc >> 3;
            const float l0 = LSE[(size_t)t * 16 + h], l1 = LSE[(size_t)(MTOK + t) * 16 + h], l2 = LSE[(size_t)(2 * MTOK + t) * 16 + h];
            const float mx = fmaxf(l0, fmaxf(l1, l2)); float w0 = __builtin_amdgcn_exp2f(l0 - mx), w1 = __builtin_amdgcn_exp2f(l1 - mx), w2 = __builtin_amdgcn_exp2f(l2 - mx);
            const float inv = 1.0f / (w0 + w1 + w2); w0 *= inv; w1 *= inv; w2 *= inv;
            const size_t o = (size_t)t * DM + cc * 8;
            const u32x4 a = *(const u32x4*)(OG + o), b = *(const u32x4*)(OG + (size_t)MTOK * DM + o), c = *(const u32x4*)(OG + 2 * (size_t)MTOK * DM + o);
            u32x4 r;
            r.x = cvt_pk_bf16(w0 * bf_lo(a.x) + w1 * bf_lo(b.x) + w2 * bf_lo(c.x), w0 * bf_hi(a.x) + w1 * bf_hi(b.x) + w2 * bf_hi(c.x));
            r.y = cvt_pk_bf16(w0 * bf_lo(a.y) + w1 * bf_lo(b.y) + w2 * bf_lo(c.y), w0 * bf_hi(a.y) + w1 * bf_hi(b.y) + w2 * bf_hi(c.y));
            r.z = cvt_pk_bf16(w0 * bf_lo(a.z) + w1 * bf_lo(b.z) + w2 * bf_lo(c.z), w0 * bf_hi(a.z) + w1 * bf_hi(b.z) + w2 * bf_hi(c.z));
            r.w = cvt_pk_bf16(w0 * bf_lo(a.w) + w1 * bf_lo(b.w) + w2 * bf_lo(c.w), w0 * bf_hi(a.w) + w1 * bf_hi(b.w) + w2 * bf_hi(c.w));
            *(u32x4*)(BUFA + o) = r;
        }
        PH_END(11)
    PH_BEGIN(12) pg8::EpiResid E_{XB, XA}; PLAIN_GEMM(E_, BUFA, Wb + W_B_OUT, 1024, 2048, 2048, 64, 4, 256 * DM, 256); PH_END(12)
    MOE_FFN(13, 0, XA, norm_ffn + DM)
    PH_BEGIN(17) moe_combine(F, XA, YS, PART, panel, r_p1, r_p2, r_g1, r_g2, norm_mix + 2 * DM, XB, HN, nullptr); PH_END(17)
    PH_BEGIN(18)
        QkvSched S_{(const char*)HN, (const char*)(Wb + W_C_QK), (const char*)(Wb + W_C_V), 8, 1, 4, 0, F.G, F.c, 2048};
        pg8::EpiBf16 E_{BIG, 2048, VT, MTOK}; pg8::gemm_phase(ring, 1024, 2048u, S_, E_); PH_END(18)
    PH_BEGIN(19)
        int tid = F.tid_(); asm volatile("" : "+v"(tid)); const int lane = tid & 63, wv = F.wave_();
        const int j = wv & 1, sub = wv >> 1, ql = lane & 31, hf = lane >> 5, kp = keyperm(ql), half1 = wv >> 2;
        LAS float* tabL = (LAS float*)(F.lds + DA_TAB);
        LAS unsigned char* bidL = F.lds + DA_BID;
        LAS float* xch = (LAS float*)(F.lds + DA_XCH);
        const float lam = misc[0], post = 1.0f - misc[1];
        for (int q = tid; q < 1024; q += NWAVES * 64) ((LAS unsigned*)bidL)[q] = ((const unsigned*)(ws + WS_BID))[q];
        unsigned ka[4], va[4];
#pragma unroll
        for (int t = 0; t < 4; ++t) { ka[t] = (unsigned)(kp * 128 + (((2 * t + hf) ^ ((kp >> 1) & 7)) << 4)); va[t] = (unsigned)(ql * 128 + (((2 * t + hf) ^ ((ql >> 1) & 7)) << 4)); }
        const int rr = 8 * wv + (lane >> 3), cc = (lane & 7) ^ ((rr >> 1) & 7);
        const unsigned koff = (unsigned)(rr * 4096 + cc * 16), voff = (unsigned)(rr * (MTOK * 2) + cc * 16);
#define DA_GLDS(g, l) __builtin_amdgcn_global_load_lds((const unsigned*)(g), (LAS unsigned*)(l), 16, 0, 0)
#define DA_ISSUE(tile, stage) do { LAS unsigned char* sb_ = F.lds + DA_STG + (stage) * 32768 + wv * 1024; const size_t kt_ = (size_t)(tile) * 64; \
            DA_GLDS(K0g + kt_ * 4096 + koff, sb_); DA_GLDS(K0g + 128 + kt_ * 4096 + koff, sb_ + 8192); \
            DA_GLDS(Vg + kt_ * 2 + voff, sb_ + 16384); DA_GLDS(Vg + kt_ * 2 + voff + (size_t)64 * MTOK * 2, sb_ + 24576); } while (0)
#define DA_BAR() do { __builtin_amdgcn_s_barrier(); asm volatile("" ::: "memory"); } while (0)
#define DA_WAIT_TILE(more) do { if (more) asm volatile("s_waitcnt vmcnt(4) lgkmcnt(0)" ::: "memory"); else asm volatile("s_waitcnt vmcnt(0) lgkmcnt(0)" ::: "memory"); } while (0)
#define DA_WAIT_LDS() asm volatile("s_waitcnt lgkmcnt(0)" ::: "memory")
#define DA_SEG_A(t_, sg_) do { \
            const LAS unsigned char* Kt = F.lds + DA_STG + (sg_) * 32768 + j * 8192; \
            const int kt = (t_) * 64, rel_lo = kt - q0 - 31, rel_hi = kt + 63 - q0; \
            bf16x8 kfa[4], kfb[4]; \
            _Pragma("unroll") for (int t4 = 0; t4 < 4; ++t4) { kfa[t4] = *(const LAS bf16x8*)(Kt + ka[t4]); kfb[t4] = *(const LAS bf16x8*)(Kt + 4096 + ka[t4]); } \
            const bool cst = (rel_lo > 0 || rel_hi < 0) && (__builtin_amdgcn_readfirstlane((int)bidL[rel_lo + 2048]) == __builtin_amdgcn_readfirstlane((int)bidL[rel_hi + 2048])); \
            if (cst) { const float cu = tabL[j * 4096 + rel_lo + 2048]; const int cui = 0; f32x16 ci; \
                { const float c = cu - mhat; (void)cui; \
                    _Pragma("unroll") for (int r = 0; r < 16; ++r) ci[r] = c; } \
                asm volatile("s_waitcnt lgkmcnt(0)" ::: "memory"); \
                s0 = __builtin_amdgcn_mfma_f32_32x32x16_bf16(kfa[0], qf[0], ci, 0, 0, 0); s1 = __builtin_amdgcn_mfma_f32_32x32x16_bf16(kfb[0], qf[0], ci, 0, 0, 0); } \
            else { const LAS float* bt = tabL + j * 4096 + kt + 8 * hf - (q0 + ql) + 2048; \
                _Pragma("unroll") for (int r = 0; r < 16; ++r) { s0[r] = bt[(r >> 3) * 16 + (r & 7)] - mhat; s1[r] = bt[32 + (r >> 3) * 16 + (r & 7)] - mhat; } \
                asm volatile("s_waitcnt lgkmcnt(0)" ::: "memory"); \
                s0 = __builtin_amdgcn_mfma_f32_32x32x16_bf16(kfa[0], qf[0], s0, 0, 0, 0); s1 = __builtin_amdgcn_mfma_f32_32x32x16_bf16(kfb[0], qf[0], s1, 0, 0, 0); } \
            _Pragma("unroll") for (int t4 = 1; t4 < 4; ++t4) { s0 = __builtin_amdgcn_mfma_f32_32x32x16_bf16(kfa[t4], qf[t4], s0, 0, 0, 0); s1 = __builtin_amdgcn_mfma_f32_32x32x16_bf16(kfb[t4], qf[t4], s1, 0, 0, 0); } \
            float mx = __builtin_fmaxf(s0[0], s1[0]), mx2 = __builtin_fmaxf(s0[1], s1[1]); \
            _Pragma("unroll") for (int r = 2; r < 16; r += 2) { mx = __builtin_fmaxf(__builtin_fmaxf(mx, s0[r]), s1[r]); mx2 = __builtin_fmaxf(__builtin_fmaxf(mx2, s0[r + 1]), s1[r + 1]); } \
            mx = __builtin_fmaxf(mx, mx2); \
            { const unsigned mu = __float_as_uint(mx); auto rr2 = __builtin_amdgcn_permlane32_swap(mu, mu, false, false); mx = fmaxf(__uint_as_float(rr2[0]), __uint_as_float(rr2[1])); } \
            if ((t_) == 0) { mhat = mx; \
                _Pragma("unroll") for (int r = 0; r < 16; ++r) { s0[r] -= mx; s1[r] -= mx; } } \
            else if (__any(mx > 8.0f)) { const float dl = fmaxf(mx, 0.f), f = __builtin_amdgcn_exp2f(-dl); mhat += dl; l_run *= f; \
                _Pragma("unroll") for (int r = 0; r < 16; ++r) { s0[r] -= dl; s1[r] -= dl; } \
                _Pragma("unroll") for (int bb = 0; bb < 4; ++bb) o[bb] = o[bb] * f; } \
            float ps = 0.f; \
            _Pragma("unroll") for (int r = 0; r < 16; ++r) { s0[r] = __builtin_amdgcn_exp2f(s0[r]); ps += s0[r]; } \
            l_run += ps; \
            p0.x = cvt_pk_bf16(s0[0], s0[1]); p0.y = cvt_pk_bf16(s0[2], s0[3]); p0.z = cvt_pk_bf16(s0[4], s0[5]); p0.w = cvt_pk_bf16(s0[6], s0[7]); \
            p1.x = cvt_pk_bf16(s0[8], s0[9]); p1.y = cvt_pk_bf16(s0[10], s0[11]); p1.z = cvt_pk_bf16(s0[12], s0[13]); p1.w = cvt_pk_bf16(s0[14], s0[15]); \
        } while (0)
#define DA_SEG_B(sg_) do { \
            const LAS unsigned char* Vt_ = F.lds + DA_STG + (sg_) * 32768 + 16384; bf16x8 vfr[4][4]; \
            _Pragma("unroll") for (int bb = 0; bb < 4; ++bb) \
                _Pragma("unroll") for (int t4 = 0; t4 < 4; ++t4) vfr[bb][t4] = *(const LAS bf16x8*)(Vt_ + bb * 4096 + va[t4]); \
            asm volatile("" ::: "memory"); \
            float ps = 0.f; \
            _Pragma("unroll") for (int r = 0; r < 16; ++r) { s1[r] = __builtin_amdgcn_exp2f(s1[r]); ps += s1[r]; } \
            l_run += ps; \
            u32x4 p2, p3; \
            p2.x = cvt_pk_bf16(s1[0], s1[1]); p2.y = cvt_pk_bf16(s1[2], s1[3]); p2.z = cvt_pk_bf16(s1[4], s1[5]); p2.w = cvt_pk_bf16(s1[6], s1[7]); \
            p3.x = cvt_pk_bf16(s1[8], s1[9]); p3.y = cvt_pk_bf16(s1[10], s1[11]); p3.z = cvt_pk_bf16(s1[12], s1[13]); p3.w = cvt_pk_bf16(s1[14], s1[15]); \
            const bf16x8 pf0 = __builtin_bit_cast(bf16x8, p0), pf1 = __builtin_bit_cast(bf16x8, p1), pf2 = __builtin_bit_cast(bf16x8, p2), pf3 = __builtin_bit_cast(bf16x8, p3); \
            _Pragma("unroll") for (int bb = 0; bb < 4; ++bb) { \
                o[bb] = __builtin_amdgcn_mfma_f32_32x32x16_bf16(vfr[bb][0], pf0, o[bb], 0, 0, 0); o[bb] = __builtin_amdgcn_mfma_f32_32x32x16_bf16(vfr[bb][1], pf1, o[bb], 0, 0, 0); \
                o[bb] = __builtin_amdgcn_mfma_f32_32x32x16_bf16(vfr[bb][2], pf2, o[bb], 0, 0, 0); o[bb] = __builtin_amdgcn_mfma_f32_32x32x16_bf16(vfr[bb][3], pf3, o[bb], 0, 0, 0); } \
        } while (0)
        for (int i = 0; i < 4; ++i) {
            const int u = i * F.G + F.vcu; if (u >= 1024) break;
            const int b = u >> 7, h = (u >> 4) & 7, qblk = u & 15;
            __syncthreads();
            for (int q = tid; q < 2 * 4096; q += NWAVES * 64) tabL[q] = gtab[(2 * h) * 4096 + q];
            const size_t tok0 = (size_t)b * SEQ; const int q0 = qblk * 128 + sub * 32;
            const char* K0g = (const char*)(BIG + tok0 * 2048 + 1024 + (2 * h) * 64);
            const char* Vg = (const char*)(VT + (size_t)(h * 128) * MTOK + tok0);
            const size_t qtok = tok0 + q0 + ql;
            bf16x8 qf[4];
#pragma unroll
            for (int t = 0; t < 4; ++t) qf[t] = *(const bf16x8*)(BIG + qtok * 2048 + (2 * h + j) * 64 + 16 * t + 8 * hf);
            DA_ISSUE(0, 0); DA_ISSUE(1, 1);
            f32x16 o[4];
#pragma unroll
            for (int bb = 0; bb < 4; ++bb) o[bb] = (f32x16){};
            float mhat = 0.f, l_run = 0.f;
            u32x4 p0, p1; f32x16 s0, s1;
            DA_WAIT_TILE(true); DA_BAR();
            if (half1 == 0) {
                int sg = 0;
                for (int t = 0; t < 32; ++t) {
                    DA_SEG_A(t, sg); DA_WAIT_LDS(); DA_BAR();
                    if (t + 2 < 32) { const int s2 = (sg >= 1) ? sg - 1 : 2; DA_ISSUE(t + 2, s2); }
                    DA_SEG_B(sg); DA_WAIT_TILE(t + 2 < 32); DA_BAR();
                    sg = (sg == 2) ? 0 : sg + 1;
                }
                DA_BAR();
            } else {
                DA_BAR();
                int sg = 0;
                for (int t = 0; t < 32; ++t) {
                    if (t + 2 < 32) { const int s2 = (sg >= 1) ? sg - 1 : 2; DA_ISSUE(t + 2, s2); }
                    DA_SEG_A(t, sg); DA_WAIT_TILE(t + 2 < 32); DA_BAR();
                    DA_SEG_B(sg); DA_WAIT_LDS(); DA_BAR();
                    sg = (sg == 2) ? 0 : sg + 1;
                }
            }
            const float lt = l_run + __shfl_xor(l_run, 32), inv = 1.0f / lt;
            __syncthreads();
            if (j == 1) {
#pragma unroll
                for (int bb = 0; bb < 4; ++bb)
#pragma unroll
                    for (int r = 0; r < 16; ++r) xch[(sub * 64 + bb * 16 + r) * 64 + lane] = o[bb][r] * inv;
            }
            __syncthreads();
            if (j == 0) {
                float ss = 0.f;
#pragma unroll
                for (int bb = 0; bb < 4; ++bb)
#pragma unroll
                    for (int r = 0; r < 16; ++r) { const float v = o[bb][r] * inv - lam * xch[(sub * 64 + bb * 16 + r) * 64 + lane]; o[bb][r] = v; ss += v * v; }
                ss += __shfl_xor(ss, 32);
                const float rstd = post / sqrtf(ss * (1.0f / 128.0f) + RMS_EPS);
                const float* sg_ = args.in[13];
                bf16_t* orow = BUFA + qtok * DM + h * 128;
#pragma unroll
                for (int bb = 0; bb < 4; ++bb)
#pragma unroll
                    for (int i4 = 0; i4 < 4; ++i4) { const int d = 32 * bb + 8 * i4 + 4 * hf; const f32x4 gg = *(const f32x4*)(sg_ + d);
                        u32x2 w; w.x = cvt_pk_bf16(o[bb][4 * i4] * rstd * gg.x, o[bb][4 * i4 + 1] * rstd * gg.y); w.y = cvt_pk_bf16(o[bb][4 * i4 + 2] * rstd * gg.z, o[bb][4 * i4 + 3] * rstd * gg.w);
                        *(u32x2*)(orow + d) = w; }
            }
        }
#undef DA_GLDS
#undef DA_ISSUE
#undef DA_BAR
#undef DA_WAIT_TILE
#undef DA_WAIT_LDS
#undef DA_SEG_A
#undef DA_SEG_B
        PH_END(19)
    PH_BEGIN(20) pg8::EpiResid E_{XB, XA}; PLAIN_GEMM(E_, BUFA, Wb + W_C_OUT, 1024, 2048, 2048, 64, 4, 256 * DM, 256); PH_END(20)
    PH_BEGIN(21) rms_phase(F, XA, norm_ffn + 2 * DM, HN); PH_END(21)
    DENSE_FFN(22, 1, XA, XB)
    PH_BEGIN(24) rms_phase(F, XB, norm_mix + 3 * DM, HN); PH_END(24)
    PH_BEGIN(25)
        QkvSched S_{(const char*)HN, (const char*)(Wb + W_D_QK), (const char*)(Wb + W_D_V), 5, 1, 1, 0, F.G, F.c, 1280};
        pg8::EpiBf16 E_{BIG, 1280, VT, MTOK}; pg8::gemm_phase(ring, 1024, 2048u, S_, E_); PH_END(25)
    PH_BEGIN(26)
        LAS float* tbl = (LAS float*)(F.lds + BI_TAB + F.wave_() * 1280); LAS unsigned char* stgw = F.lds + F.wave_() * 16384;
        const float* sink = args.in[16];
        int lane26 = F.lane_(); asm volatile("" : "+v"(lane26));
        for (int i = 0; i < 2; ++i) {
            const int w = (i * F.G + F.vcu) * NWAVES + F.wave_(); if (w >= 4096) break;
            const int b = w >> 9, kvh = (w >> 7) & 3, qb = (w >> 2) & 31, qh = kvh * 4 + (w & 3);
            band_item64<128>(BIG + qh * 64, BIG + 1024 + kvh * 64, 1280, (size_t)b * SEQ, 1, SEQ, qb * 64,
                             VT + (size_t)(kvh * 64) * MTOK, (size_t)b * SEQ, gtab + qh * 4096, tbl, stgw, sink[qh] * LOG2E, 1.0f,
                             BUFA + qh * 64, DM, nullptr, lane26);
        }
        PH_END(26)
    PH_BEGIN(27) pg8::EpiResid E_{XB, XA}; PLAIN_GEMM(E_, BUFA, Wb + W_D_OUT, 1024, 2048, 2048, 64, 4, 256 * DM, 256); PH_END(27)
    MOE_FFN(28, 1, XA, norm_ffn + 3 * DM)
    PH_BEGIN(32) moe_combine(F, XA, YS, PART, panel, r_p1, r_p2, r_g1, r_g2, norm_final, nullptr, nullptr, args.out); } }
#undef IN
#undef SEAM
}
constexpr int N_PHASES = 33;

extern "C" void kernel_launch(void* const* d_in, const int* in_sizes, int n_in, void* d_out, int out_size, void* d_ws, size_t ws_size, hipStream_t stream) {
    static int grid = 0;
    if (grid == 0) {
        if (n_in != 23 || out_size != MTOK * DM || ws_size < WS_END) { fprintf(stderr, "kernel_launch: unexpected problem (n_in %d, out %d, ws %zu, need %zu)\n", n_in, out_size, ws_size, (size_t)WS_END); grid = -1; return; }
        int dev = 0, cus = 0, per_cu = 0;
        if (hipGetDevice(&dev) != hipSuccess || hipDeviceGetAttribute(&cus, hipDeviceAttributeMultiprocessorCount, dev) != hipSuccess) { grid = -1; return; }
        if (hipFuncSetAttribute((const void*)enc_fwd, hipFuncAttributeMaxDynamicSharedMemorySize, LDS_BYTES) != hipSuccess) { fprintf(stderr, "kernel_launch: hipFuncSetAttribute failed\n"); grid = -1; return; }
        if (hipOccupancyMaxActiveBlocksPerMultiprocessor(&per_cu, (const void*)enc_fwd, NWAVES * 64, LDS_BYTES) != hipSuccess || per_cu < 1)
            fprintf(stderr, "kernel_launch: occupancy query reports %d workgroups per CU\n", per_cu);
        (void)hipGetLastError();
        grid = cus;
    }
    if (grid < 0) return;
    if (hipMemsetAsync((char*)d_ws + WS_CTL, 0, CTL_ZERO_BYTES, stream) != hipSuccess) return;
    Args a{};
    for (int i = 0; i < 23; ++i) a.in[i] = (const float*)d_in[i];
    a.out = (float*)d_out; a.ws = (unsigned char*)d_ws;
#if MK_MULTI
    for (int p = 0; p < N_PHASES; ++p) { a.ph_lo = p; a.ph_hi = p + 1; hipLaunchKernelGGL(enc_fwd, dim3(grid), dim3(NWAVES * 64), LDS_BYTES, stream, a); }
#else
    a.ph_lo = 0; a.ph_hi = N_PHASES;
    hipLaunchKernelGGL(enc_fwd, dim3(grid), dim3(NWAVES * 64), LDS_BYTES, stream, a);
#endif
}
```

```cpp
#include <hip/hip_runtime.h>
#include <cstdio>
#include <cstdint>

#ifndef PROBE_MASK
#define PROBE_MASK 0ull
#endif
#ifndef PROBE_N
#define PROBE_N 2
#endif
#ifndef SLOW_MASK
#define SLOW_MASK 0ull
#endif
#ifndef MOE_SPLIT
#define MOE_SPLIT 1
#endif
#ifndef EXTRA_BARS
#define EXTRA_BARS 0
#endif
#ifndef EPI_TWICE
#define EPI_TWICE 0
#endif
#ifndef GEMM_STAGGER
#define GEMM_STAGGER 0
#endif
#ifndef MK_MULTI
#define MK_MULTI 0
#endif

#define LAS __attribute__((address_space(3)))
#define GAS __attribute__((address_space(1)))
typedef unsigned short bf16_t;
typedef short bf16x8 __attribute__((ext_vector_type(8)));
typedef float f32x4 __attribute__((ext_vector_type(4)));
typedef float f32x16 __attribute__((ext_vector_type(16)));
typedef unsigned u32x4 __attribute__((ext_vector_type(4)));
typedef unsigned u32x2 __attribute__((ext_vector_type(2)));
typedef int i32x4 __attribute__((ext_vector_type(4)));
typedef int i32x8 __attribute__((ext_vector_type(8)));

constexpr int NB = 8, SEQ = 2048, DM = 1024, MTOK = NB * SEQ, DFF = 3584, NE = 8;
constexpr int MP_MAX = 2 * MTOK + NE * 256;
constexpr int NPANEL_MAX = MP_MAX / 256;
constexpr float RMS_EPS = 1e-6f;
constexpr float LOG2E = 1.4426950408889634f;
#define DENSE_F8(l) ((l) == 1)
constexpr float ACT8_SCALE = 8.0f;
constexpr unsigned F8_GU = 1u, F8_DN = 1u;
constexpr float F8_GU_UNSCALE = 1.0f / 256.0f, F8_DN_UNSCALE = 1.0f / 1024.0f;
constexpr float QSCALE = 0.125f * LOG2E;
constexpr float NEG_BIG = -1e30f;
constexpr int NWAVES = 8;

constexpr size_t MiB = 1ull << 20;
constexpr size_t WS_CTL = 0, CTL_ZERO_BYTES = 1 * MiB;
constexpr size_t WS_TAB = 1 * MiB;
constexpr size_t WS_MISC = WS_TAB + 256 * 1024;
constexpr size_t WS_BID = WS_MISC + 4096;
constexpr size_t WS_ROUTE = 2 * MiB;
constexpr size_t WS_PS = WS_ROUTE + 1 * MiB;
constexpr size_t WS_CNT = WS_ROUTE + 384 * 1024;
constexpr size_t WS_PANEL = WS_ROUTE + 448 * 1024;
constexpr size_t WS_W = 4 * MiB;
constexpr size_t W_A_IN = 0, W_A_GRP = W_A_IN + 1048576, W_A_OUT = W_A_GRP + 262144, W_B_QK = W_A_OUT + 1048576, W_B_V = W_B_QK + 6144 * 1024,
                 W_B_OUT = W_B_V + 3072 * 1024, W_C_QK = W_B_OUT + 1048576, W_C_V = W_C_QK + 2048 * 1024, W_C_OUT = W_C_V + 1048576,
                 W_D_QK = W_C_OUT + 1048576, W_D_V = W_D_QK + 1280 * 1024, W_D_OUT = W_D_V + 256 * 1024, W_F_GU = W_D_OUT + 1048576,
                 W_F_D = W_F_GU + 2 * 7168 * 1024, W_M_GU = W_F_D + 2 * 3584 * 1024, W_M_D = W_M_GU + 16ull * 7168 * 1024, W_END = W_M_D + 16ull * 3584 * 1024;
constexpr size_t WS_XA = WS_W + ((W_END * 2 + MiB - 1) / MiB) * MiB;
constexpr size_t WS_XB = WS_XA + 64 * MiB;
constexpr size_t WS_HN = WS_XB + 64 * MiB;
constexpr size_t WS_BUFA = WS_HN + 32 * MiB;
constexpr size_t WS_BUFB = WS_BUFA + 32 * MiB;
constexpr size_t WS_BUFC = WS_BUFB + 32 * MiB;
constexpr size_t WS_BIG = WS_BUFC + 32 * MiB;
constexpr size_t WS_VT = WS_BIG + 240 * MiB;
constexpr size_t WS_OG = WS_VT + 96 * MiB;
constexpr size_t WS_LSE = WS_OG + 96 * MiB;
constexpr size_t WS_PART = WS_LSE + 4 * MiB;
constexpr size_t WS_END = WS_PART + 64 * MiB;
constexpr int CW_BAR = 4096;
constexpr int RING_BYTES = 131072, LDSCTL_OFF = RING_BYTES, MISC_OFF = LDSCTL_OFF + 320, LDS_BYTES = 147456;
constexpr int BI_TAB = RING_BYTES + 1024;
constexpr int DA_TAB = 0, DA_STG = 32768, DA_XCH = 32768, DA_BID = RING_BYTES + 1024;

__device__ __forceinline__ unsigned cvt_pk_bf16(float lo, float hi) { unsigned r; asm volatile("v_cvt_pk_bf16_f32 %0, %1, %2" : "=v"(r) : "v"(lo), "v"(hi)); return r; }
__device__ __forceinline__ float bf_lo(unsigned w) { return __uint_as_float(w << 16); }
__device__ __forceinline__ float bf_hi(unsigned w) { return __uint_as_float(w & 0xffff0000u); }
__device__ __forceinline__ float wave_sum(float v) {
#pragma unroll
    for (int o = 1; o < 64; o <<= 1) v += __shfl_xor(v, o);
    return v;
}
#define LDS_WAIT() asm volatile("s_waitcnt lgkmcnt(0)" ::: "memory")
#define VM_WAIT() asm volatile("s_waitcnt vmcnt(0)" ::: "memory")

namespace pg8 {
constexpr int BM = 256, BK = 64, HALF = 128, HTB = HALF * BK * 2, STAGE_BYTES = 8 * HTB, NXCD = 8, WGM = 8;
__host__ __device__ __forceinline__ int lds_byte(int r, int c) { const int st = (r >> 4) * 2 + (c >> 5), rr = r & 15, cc = c & 31, ob = rr * 64 + cc * 2; return st * 1024 + (ob ^ (((ob >> 9) & 1) << 5)); }
__host__ __device__ __forceinline__ void stage_rc(int b, int& R, int& C) { const int st = b / 1024, sb = b % 1024, swz = sb ^ (((sb >> 9) & 1) << 5); R = (st >> 1) * 16 + swz / 64; C = (st & 1) * 32 + (swz % 64) / 2; }
__host__ __device__ __forceinline__ int perm32(int rho) { const int n = rho >> 4, i = rho & 15; return 8 * (i >> 2) + 4 * n + (i & 3); }

struct Unit { const char* A; const char* B; unsigned ldb, hsb; size_t co; int tag; const int* ridx; int par; };

__device__ __forceinline__ void tile_order(int nM, int nN, int L, int& pm, int& pn) {
    const int nwg = nM * nN; int wgid = L;
    { const int q = nwg / NXCD, r = nwg % NXCD, xcd = wgid % NXCD, off = wgid / NXCD; wgid = (xcd < r ? xcd * (q + 1) : r * (q + 1) + (xcd - r) * q) + off; }
    const int nig = WGM * nN, gid = wgid / nig, fm = gid * WGM, gsz = (nM - fm) < WGM ? (nM - fm) : WGM;
    pm = fm + ((wgid % nig) % gsz); pn = (wgid % nig) / gsz;
}

__device__ __forceinline__ i32x8 cat8(bf16x8 a, bf16x8 b) { const i32x4 x = __builtin_bit_cast(i32x4, a), y = __builtin_bit_cast(i32x4, b); return __builtin_shufflevector(x, y, 0, 1, 2, 3, 4, 5, 6, 7); }
__device__ __forceinline__ void mfma_f8(f32x4& c, const i32x8 a, const i32x8 b) { asm volatile("v_mfma_f32_16x16x128_f8f6f4 %0, %1, %2, %0" : "+v"(c) : "v"(a), "v"(b)); }
__device__ __forceinline__ unsigned pack_fp8x4(float a, float b, float c, float d, float sc) {
    const float ta = __builtin_amdgcn_fmed3f(a * sc, -448.f, 448.f), tb = __builtin_amdgcn_fmed3f(b * sc, -448.f, 448.f);
    const float tc = __builtin_amdgcn_fmed3f(c * sc, -448.f, 448.f), td = __builtin_amdgcn_fmed3f(d * sc, -448.f, 448.f);
    int w = __builtin_amdgcn_cvt_pk_fp8_f32(ta, tb, 0, false); w = __builtin_amdgcn_cvt_pk_fp8_f32(tc, td, w, true); return (unsigned)w;
}
__device__ __forceinline__ void zero_acc(f32x4 (&acc)[2][2][4][2]) {
#pragma unroll
    for (int a = 0; a < 2; ++a)
#pragma unroll
        for (int b = 0; b < 2; ++b)
#pragma unroll
            for (int m = 0; m < 4; ++m)
#pragma unroll
                for (int n = 0; n < 2; ++n) acc[a][b][m][n] = (f32x4){0.f, 0.f, 0.f, 0.f};
}
__device__ __forceinline__ float rstd_of(const float* ps16, size_t token) {
    const f32x4* p = (const f32x4*)(ps16 + token * 16); const f32x4 a = p[0], b = p[1], c = p[2], d = p[3];
    const float s = (((a.x + a.y) + (a.z + a.w)) + ((b.x + b.y) + (b.z + b.w))) + (((c.x + c.y) + (c.z + c.w)) + ((d.x + d.y) + (d.z + d.w)));
    return __builtin_amdgcn_rsqf(s * (1.0f / DM) + RMS_EPS);
}
template <bool RS, int XSH = 11, int O8 = 0> struct EpiBf16T {
    static constexpr bool PERM = true; static constexpr bool VPERM = (O8 == 1);
    bf16_t* out0; int ld0; bf16_t* out1; int ld1; const float* __restrict__ ps; const char* xbase; LAS float* rtab; float osc = 1.0f;
    __device__ __forceinline__ void unit_begin(Unit& u, size_t& key, int& par) const {
        if constexpr (RS) { const size_t k = u.tag ? ((size_t)u.B ^ ((size_t)u.ldb << 44) ^ 1u) : (size_t)u.A;
            if (k != key) { key = k; par ^= 1; const int t = threadIdx.x; if (t < 256) { size_t tok;
                if (u.tag) tok = ((size_t)(u.B - xbase) >> XSH) + (size_t)(t >> 7) * (u.hsb >> XSH) + (size_t)(t & 127) * (u.ldb >> XSH); else tok = ((size_t)(u.A - xbase) >> XSH) + t;
                rtab[par * 256 + t] = rstd_of(ps, tok) * osc; } }
            u.par = par; }
    }
    __device__ __forceinline__ void init(f32x4 (&acc)[2][2][4][2], const Unit&, int, int, int, int) const { zero_acc(acc); }
    __device__ __forceinline__ void operator()(const f32x4 (&acc)[2][2][4][2], const Unit& u, int wr, int wc, int fr, int fq) const {
        bf16_t* base = (u.tag ? out1 : out0) + u.co; const int ldc = u.tag ? ld1 : ld0;
        int r0 = wr * 64 + fr; asm volatile("" : "+v"(r0));
        const LAS float* tb = rtab + u.par * 256;
#pragma unroll
        for (int ai = 0; ai < 2; ++ai)
#pragma unroll
            for (int m = 0; m < 4; ++m) { bf16_t* rowp = base + (unsigned)((ai * HALF + m * 16 + r0) * ldc + wc * 32 + 8 * fq);
#pragma unroll
                for (int bj = 0; bj < 2; ++bj) { f32x4 v0 = acc[ai][bj][m][0], v1 = acc[ai][bj][m][1];
                    if constexpr (!RS) { v0 = v0 * osc; v1 = v1 * osc; }
                    if constexpr (RS) { if (u.tag) { const f32x4 c0 = *(const LAS f32x4*)(tb + bj * HALF + wc * 32 + 8 * fq), c1 = *(const LAS f32x4*)(tb + bj * HALF + wc * 32 + 8 * fq + 4); v0 = v0 * c0; v1 = v1 * c1; }
                                        else { const float rs = tb[ai * HALF + m * 16 + r0]; v0 = v0 * rs; v1 = v1 * rs; } }
                    if constexpr (O8 != 0) { unsigned char* bp = (unsigned char*)(u.tag ? out1 : out0) + u.co + (unsigned)((ai * HALF + m * 16 + r0) * (u.tag ? ld1 : ld0) + wc * 32 + 8 * fq) + bj * HALF; const float sc8 = u.tag ? ACT8_SCALE : 1.0f;
                        u32x2 q; q.x = pack_fp8x4(v0[0], v0[1], v0[2], v0[3], sc8); q.y = pack_fp8x4(v1[0], v1[1], v1[2], v1[3], sc8); *(u32x2*)bp = q; continue; }
                    u32x4 w; w.x = cvt_pk_bf16(v0[0], v0[1]); w.y = cvt_pk_bf16(v0[2], v0[3]); w.z = cvt_pk_bf16(v1[0], v1[1]); w.w = cvt_pk_bf16(v1[2], v1[3]);
                    *(u32x4*)(rowp + bj * HALF) = w; } }
    }
};
typedef EpiBf16T<false> EpiBf16;
struct EpiYs8 {
    static constexpr bool PERM = true; static constexpr bool VPERM = false;
    bf16_t* out;
    __device__ __forceinline__ void unit_begin(Unit&, size_t&, int&) const {}
    __device__ __forceinline__ void init(f32x4 (&acc)[2][2][4][2], const Unit&, int, int, int, int) const { zero_acc(acc); }
    __device__ __forceinline__ void operator()(const f32x4 (&acc)[2][2][4][2], const Unit& u, int wr, int wc, int fr, int fq) const {
        bf16_t* base = out + u.co;
        int r0 = wr * 64 + fr; asm volatile("" : "+v"(r0));
#pragma unroll
        for (int ai = 0; ai < 2; ++ai)
#pragma unroll
            for (int m = 0; m < 4; ++m) { bf16_t* rowp = base + (unsigned)((ai * HALF + m * 16 + r0) * DM + wc * 32 + 8 * fq);
#pragma unroll
                for (int bj = 0; bj < 2; ++bj) { const f32x4 v0 = acc[ai][bj][m][0] * F8_DN_UNSCALE, v1 = acc[ai][bj][m][1] * F8_DN_UNSCALE;
                    u32x4 w; w.x = cvt_pk_bf16(v0[0], v0[1]); w.y = cvt_pk_bf16(v0[2], v0[3]); w.z = cvt_pk_bf16(v1[0], v1[1]); w.w = cvt_pk_bf16(v1[2], v1[3]);
                    *(u32x4*)(rowp + bj * HALF) = w; } }
    }
};
template <bool RS> struct EpiSwigluT {
    static constexpr bool PERM = true; static constexpr bool VPERM = false;
    bf16_t* out; int ldc; const float* __restrict__ ps; const char* xbase; LAS float* rtab;
    __device__ __forceinline__ void unit_begin(Unit& u, size_t& key, int& par) const {
        if constexpr (RS) { const size_t k = (size_t)u.A;
            if (k != key) { key = k; par ^= 1; const int t = threadIdx.x; if (t < 256) rtab[par * 256 + t] = rstd_of(ps, ((size_t)(u.A - xbase) >> 11) + t); }
            u.par = par; }
    }
    __device__ __forceinline__ void init(f32x4 (&acc)[2][2][4][2], const Unit&, int, int, int, int) const { zero_acc(acc); }
    __device__ __forceinline__ void operator()(const f32x4 (&acc)[2][2][4][2], const Unit& u, int wr, int wc, int fr, int fq) const {
        bf16_t* base = out + u.co;
        int r0 = wr * 64 + fr; asm volatile("" : "+v"(r0));
#pragma unroll
        for (int ai = 0; ai < 2; ++ai)
#pragma unroll
            for (int m = 0; m < 4; ++m) { bf16_t* rowp = base + (unsigned)((ai * HALF + m * 16 + r0) * ldc + wc * 32 + 8 * fq);
                float rs = 1.0f; if constexpr (RS) rs = rtab[u.par * 256 + ai * HALF + m * 16 + r0];
                float r[8];
                const float c2 = -rs * LOG2E, iK = RS ? __builtin_amdgcn_rcpf(rs * rs) : 1.0f;
#pragma unroll
                for (int n = 0; n < 2; ++n)
#pragma unroll
                    for (int j = 0; j < 4; ++j) { const float G = acc[ai][0][m][n][j], U = acc[ai][1][m][n][j];
                        r[n * 4 + j] = (G * U) * __builtin_amdgcn_rcpf(__builtin_fmaf(__builtin_amdgcn_exp2f(G * c2), iK, iK)); }
                u32x4 w; w.x = cvt_pk_bf16(r[0], r[1]); w.y = cvt_pk_bf16(r[2], r[3]); w.z = cvt_pk_bf16(r[4], r[5]); w.w = cvt_pk_bf16(r[6], r[7]);
                *(u32x4*)rowp = w; }
    }
};
typedef EpiSwigluT<false> EpiSwiglu;
template <bool RS> struct EpiSwiglu8T {
    static constexpr bool PERM = true; static constexpr bool VPERM = false;
    unsigned char* out; int ldc; const float* __restrict__ ps; const char* xbase; LAS float* rtab;
    __device__ __forceinline__ void unit_begin(Unit& u, size_t& key, int& par) const {
        if constexpr (RS) { const size_t k = (size_t)u.A;
            if (k != key) { key = k; par ^= 1; const int t = threadIdx.x; if (t < 256) rtab[par * 256 + t] = rstd_of(ps, ((size_t)(u.A - xbase) >> 10) + t); }
            u.par = par; }
    }
    __device__ __forceinline__ void init(f32x4 (&acc)[2][2][4][2], const Unit&, int, int, int, int) const { zero_acc(acc); }
    __device__ __forceinline__ u32x2 row8(const f32x4 (&acc)[2][2][4][2], const Unit& u, int ai, int m, int r0) const {
        float rs = F8_GU_UNSCALE; if constexpr (RS) rs *= rtab[u.par * 256 + ai * HALF + m * 16 + r0];
        const float c2 = -rs * LOG2E, iK = RS ? __builtin_amdgcn_rcpf(ACT8_SCALE * rs * rs) : 1.0f / (ACT8_SCALE * F8_GU_UNSCALE * F8_GU_UNSCALE);
        float r[8];
#pragma unroll
        for (int n = 0; n < 2; ++n)
#pragma unroll
            for (int j = 0; j < 4; ++j) { const float G = acc[ai][0][m][n][j], U = acc[ai][1][m][n][j];
                r[n * 4 + j] = (G * U) * __builtin_amdgcn_rcpf(__builtin_fmaf(__builtin_amdgcn_exp2f(G * c2), iK, iK)); }
        u32x2 w; w.x = pack_fp8x4(r[0], r[1], r[2], r[3], 1.0f); w.y = pack_fp8x4(r[4], r[5], r[6], r[7], 1.0f); return w;
    }
    __device__ __forceinline__ void operator()(const f32x4 (&acc)[2][2][4][2], const Unit& u, int wr, int wc, int fr, int fq) const {
        unsigned char* base = out + u.co;
        int r0 = wr * 64 + fr; asm volatile("" : "+v"(r0));
#pragma unroll
        for (int ai = 0; ai < 2; ++ai)
#pragma unroll
            for (int mp = 0; mp < 4; mp += 2) {
                const u32x2 a = row8(acc, u, ai, mp, r0), b = row8(acc, u, ai, mp + 1, r0);
                const auto sx = __builtin_amdgcn_permlane16_swap(a.x, b.x, false, false), sy = __builtin_amdgcn_permlane16_swap(a.y, b.y, false, false);
                u32x4 w; w.x = sx[0]; w.y = sy[0]; w.z = sx[1]; w.w = sy[1];
                const int mrow = mp + (fq & 1);
                *(u32x4*)(base + (unsigned)((ai * HALF + mrow * 16 + r0) * ldc + wc * 32 + 8 * (fq & ~1))) = w; }
    }
};
typedef EpiSwiglu8T<false> EpiSwiglu8;
template <bool F32IN, bool NORM = false, int MODE = 0> struct EpiResidT {
    static constexpr bool PERM = true; static constexpr bool VPERM = false;
    const void* __restrict__ resid; bf16_t* __restrict__ out; float* __restrict__ ps; unsigned char* __restrict__ x8;
    __device__ __forceinline__ void unit_begin(Unit&, size_t&, int&) const {}
    __device__ __forceinline__ void init(f32x4 (&acc)[2][2][4][2], const Unit& u, int wr, int wc, int fr, int fq) const {
        int r0 = wr * 64 + fr; asm volatile("" : "+v"(r0));
#pragma unroll
        for (int ai = 0; ai < 2; ++ai)
#pragma unroll
            for (int m = 0; m < 4; ++m) { const size_t off = u.co + (unsigned)((ai * HALF + m * 16 + r0) * DM + wc * 32 + 8 * fq);
#pragma unroll
                for (int bj = 0; bj < 2; ++bj) {
                    if constexpr (F32IN) { const float* p = (const float*)resid + off + bj * HALF; acc[ai][bj][m][0] = *(const f32x4*)p; acc[ai][bj][m][1] = *(const f32x4*)(p + 4); }
                    else { const u32x4 w = *(const u32x4*)((const bf16_t*)resid + off + bj * HALF);
                        acc[ai][bj][m][0] = (f32x4){bf_lo(w.x), bf_hi(w.x), bf_lo(w.y), bf_hi(w.y)}; acc[ai][bj][m][1] = (f32x4){bf_lo(w.z), bf_hi(w.z), bf_lo(w.w), bf_hi(w.w)}; }
                    if constexpr ((MODE & 2) != 0) { acc[ai][bj][m][0] = acc[ai][bj][m][0] * (1.0f / F8_DN_UNSCALE); acc[ai][bj][m][1] = acc[ai][bj][m][1] * (1.0f / F8_DN_UNSCALE); } } }
    }
    __device__ __forceinline__ void operator()(const f32x4 (&acc)[2][2][4][2], const Unit& u, int wr, int wc, int fr, int fq) const {
        int r0 = wr * 64 + fr; asm volatile("" : "+v"(r0));
#pragma unroll
        for (int ai = 0; ai < 2; ++ai)
#pragma unroll
            for (int m = 0; m < 4; ++m) { const size_t off = u.co + (unsigned)((ai * HALF + m * 16 + r0) * DM + wc * 32 + 8 * fq);
                float ss = 0.f;
#pragma unroll
                for (int bj = 0; bj < 2; ++bj) { f32x4 v0 = acc[ai][bj][m][0], v1 = acc[ai][bj][m][1];
                    if constexpr ((MODE & 2) != 0) { v0 = v0 * F8_DN_UNSCALE; v1 = v1 * F8_DN_UNSCALE; }
                    u32x4 w; w.x = cvt_pk_bf16(v0[0], v0[1]); w.y = cvt_pk_bf16(v0[2], v0[3]); w.z = cvt_pk_bf16(v1[0], v1[1]); w.w = cvt_pk_bf16(v1[2], v1[3]);
                    *(u32x4*)(out + off + bj * HALF) = w;
                    if constexpr ((MODE & 1) != 0) { u32x2 q; q.x = pack_fp8x4(v0[0], v0[1], v0[2], v0[3], 1.0f); q.y = pack_fp8x4(v1[0], v1[1], v1[2], v1[3], 1.0f); *(u32x2*)(x8 + off + bj * HALF) = q; }
                    if constexpr (NORM) ss += ((v0[0] * v0[0] + v0[1] * v0[1]) + (v0[2] * v0[2] + v0[3] * v0[3])) + ((v1[0] * v1[0] + v1[1] * v1[1]) + (v1[2] * v1[2] + v1[3] * v1[3])); }
                if constexpr (NORM) { ss += __shfl_xor(ss, 16); ss += __shfl_xor(ss, 32); if (fq == 0) ps[(off >> 10) * 16 + ((u.co >> 8) & 3) * 4 + wc] = ss; } }
    }
};
typedef EpiResidT<false> EpiResid;

struct EpiPart {
    static constexpr bool PERM = false; static constexpr bool VPERM = false;
    float* out; float sc;
    __device__ __forceinline__ void unit_begin(Unit&, size_t&, int&) const {}
    __device__ __forceinline__ void init(f32x4 (&acc)[2][2][4][2], const Unit&, int, int, int, int) const { zero_acc(acc); }
    __device__ __forceinline__ void operator()(const f32x4 (&acc)[2][2][4][2], const Unit& u, int wr, int wc, int fr, int fq) const {
        int r0 = wr * 64 + fr; asm volatile("" : "+v"(r0));
#pragma unroll
        for (int ai = 0; ai < 2; ++ai)
#pragma unroll
            for (int m = 0; m < 4; ++m) { const size_t off = u.co + (unsigned)((ai * HALF + m * 16 + r0) * 256 + wc * 32 + 4 * fq);
#pragma unroll
                for (int bj = 0; bj < 2; ++bj)
#pragma unroll
                    for (int n = 0; n < 2; ++n) *(f32x4*)(out + off + bj * HALF + n * 16) = acc[ai][bj][m][n] * sc; }
    }
};

__device__ __forceinline__ int vperm64(int p) { return ((p >> 4) & 1) * 32 + ((p >> 3) & 1) * 16 + (p & 7) + ((p >> 5) & 1) * 8; }
template <bool GATHER = false, unsigned F8S = 0u, class Epi, class Sched>
__device__ __forceinline__ void gemm_phase(LAS unsigned char* lds, const int K, const unsigned lda, const Sched& S, const Epi& E) {
    const int tid = threadIdx.x, wid = __builtin_amdgcn_readfirstlane(tid >> 6), lane = tid & 63, wr = wid >> 2, wc = wid & 3, fr = lane & 15, fq = lane >> 4;
    int nt = K / BK; asm volatile("" : "+s"(nt));
    unsigned voffA[2], voffB[2], voffA1[2], nvA0[2], nvA1[2];
#pragma unroll
    for (int i = 0; i < 2; ++i) { int R, C; stage_rc(tid * 16 + i * 8192, R, C); const int Rb = Epi::PERM ? ((R & ~31) + perm32(R & 31)) : R;
        voffA[i] = (unsigned)R * lda + (unsigned)C * 2u; voffA1[i] = 0u; nvA0[i] = 0u; nvA1[i] = 0u; (void)Rb; }
    const size_t kstep = (size_t)(BK * 2);
    const size_t hstepA = GATHER ? (size_t)0 : (size_t)HALF * lda;
#define PG8_VA1 (GATHER ? voffA1 : voffA)
#define PG8_GIDX(u, d0, d1) do { _Pragma("unroll") for (int _i = 0; _i < 2; ++_i) { int R_, C_; stage_rc((int)(threadIdx.x) * 16 + _i * 8192, R_, C_); \
        d0[_i] = (unsigned)(u).ridx[R_] * lda + (unsigned)C_ * 2u; d1[_i] = (unsigned)(u).ridx[HALF + R_] * lda + (unsigned)C_ * 2u; } } while (0)
    const unsigned ldsw = (unsigned)wid * 1024u;
    const int aoff = lds_byte(wr * 64 + fr, fq * 8), boff = lds_byte(wc * 32 + fr, fq * 8);
#define PG8_SA(b, h) (((b) * 2 + (h)) * HTB)
#define PG8_SB(b, h) ((4 + (b) * 2 + (h)) * HTB)
#define PG8_STAGE(bufoff, gbase, voff) do { const char* g_ = (const char*)(gbase); asm volatile("" : "+s"(g_)); _Pragma("unroll") for (int _i = 0; _i < 2; ++_i) { unsigned vo_ = (voff)[_i]; asm volatile("" : "+v"(vo_)); \
        __builtin_amdgcn_global_load_lds((const unsigned*)(g_ + vo_), (LAS unsigned*)(lds + (bufoff) + ldsw + _i * 8192), 16, 0, 0); } } while (0)
#define PG8_LDA(dst, b, h) do { _Pragma("unroll") for (int m = 0; m < 4; ++m) _Pragma("unroll") for (int k = 0; k < 2; ++k) dst[m][k] = *(const LAS bf16x8*)(lds + PG8_SA(b, h) + aoff + m * 2048 + k * 1024); } while (0)
#define PG8_LDB(dst, b, h) do { _Pragma("unroll") for (int n = 0; n < 2; ++n) _Pragma("unroll") for (int k = 0; k < 2; ++k) dst[n][k] = *(const LAS bf16x8*)(lds + PG8_SB(b, h) + boff + n * 2048 + k * 1024); } while (0)
#define PG8_MMA(ai, bj, At, Bt) do { __builtin_amdgcn_s_setprio(1); \
        if constexpr (F8S != 0u) { _Pragma("unroll") for (int m = 0; m < 4; ++m) _Pragma("unroll") for (int n = 0; n < 2; ++n) \
            mfma_f8(acc[ai][bj][m][n], cat8(Bt[n][0], Bt[n][1]), cat8(At[m][0], At[m][1])); } \
        else { _Pragma("unroll") for (int m = 0; m < 4; ++m) _Pragma("unroll") for (int n = 0; n < 2; ++n) _Pragma("unroll") for (int k = 0; k < 2; ++k) \
            acc[ai][bj][m][n] = __builtin_amdgcn_mfma_f32_16x16x32_bf16(Bt[n][k], At[m][k], acc[ai][bj][m][n], 0, 0, 0); } __builtin_amdgcn_s_setprio(0); } while (0)
#define PG8_WAIT_V(n) asm volatile("s_waitcnt vmcnt(" #n ")" ::: "memory")
#define PG8_WAIT_L(n) asm volatile("s_waitcnt lgkmcnt(" #n ")" ::: "memory")
#define PG8_BAR __builtin_amdgcn_s_barrier()
#define PG8_SCHED __builtin_amdgcn_sched_barrier(0)
#define PG8_SETB(u) do { _Pragma("unroll") for (int _i = 0; _i < 2; ++_i) { int R_, C_; stage_rc((int)(threadIdx.x) * 16 + _i * 8192, R_, C_); const int Rp_ = Epi::PERM ? ((R_ & ~31) + perm32(R_ & 31)) : R_; \
        const int Rb_ = (Epi::VPERM && (u).tag) ? ((Rp_ & ~63) + vperm64(Rp_ & 63)) : Rp_; \
        voffB[_i] = (unsigned)Rb_ * (u).ldb + (unsigned)C_ * 2u; } hsB = (size_t)(u).hsb; } while (0)
    Unit cur, nxt; int ui = 0;
    if (!S.next(0, cur)) return;
#if GEMM_STAGGER
    { const unsigned long long te_ = wall_clock64() + (unsigned long long)(((blockIdx.x >> 3) & 3) * GEMM_STAGGER); while (wall_clock64() < te_) __builtin_amdgcn_s_sleep(8); }
#endif
    size_t rkey = ~(size_t)0; int rpar = 0; cur.par = 0; E.unit_begin(cur, rkey, rpar);
    f32x4 acc[2][2][4][2];
    bf16x8 At[4][2], B0[2][2], B1[2][2];
    const char* cA = cur.A; const char* cB = cur.B; size_t hsB;
    PG8_SETB(cur);
    if constexpr (GATHER) PG8_GIDX(cur, voffA, voffA1);
    PG8_STAGE(PG8_SB(0, 0), cB, voffB); PG8_STAGE(PG8_SB(0, 1), cB + hsB, voffB); PG8_STAGE(PG8_SA(0, 0), cA, voffA); PG8_STAGE(PG8_SA(0, 1), cA + hstepA, PG8_VA1);
    E.init(acc, cur, wr, wc, fr, fq);
    if (wr == 1) PG8_BAR;
    PG8_WAIT_V(2); PG8_BAR;
    PG8_STAGE(PG8_SB(1, 0), cB + kstep, voffB); PG8_STAGE(PG8_SA(1, 0), cA + kstep, voffA); PG8_STAGE(PG8_SB(1, 1), cB + hsB + kstep, voffB);
    PG8_WAIT_V(6); PG8_BAR;
    for (;;) {
        const bool has_next = S.next(ui + 1, nxt);
        const char* nA = has_next ? nxt.A : cA; const char* nB = has_next ? nxt.B : cB;
        if constexpr (GATHER) { if (has_next) PG8_GIDX(nxt, nvA0, nvA1); }
        for (int t = 0; t < nt; t += 2) {
            const bool last = (t == nt - 2);
            const char* a1 = cA + (size_t)(t + 1) * kstep;
            const char* a2 = last ? nA : cA + (size_t)(t + 2) * kstep; const char* b2 = last ? nB : cB + (size_t)(t + 2) * kstep;
            const char* a3 = a2 + kstep; const char* b3 = b2 + kstep;
            if (last && has_next) { PG8_SETB(nxt); if constexpr (GATHER) { voffA[0] = nvA0[0]; voffA[1] = nvA0[1]; } }
            PG8_LDB(B0, 0, 0); PG8_LDB(B1, 0, 1); PG8_SCHED; PG8_LDA(At, 0, 0); PG8_STAGE(PG8_SA(1, 1), a1 + hstepA, PG8_VA1);
            if constexpr (GATHER) { if (last && has_next) { voffA1[0] = nvA1[0]; voffA1[1] = nvA1[1]; } }
            PG8_WAIT_V(8); PG8_WAIT_L(0); PG8_BAR; PG8_MMA(0, 0, At, B0); PG8_MMA(0, 1, At, B1); PG8_BAR; PG8_SCHED;
            PG8_LDA(At, 0, 1); PG8_STAGE(PG8_SB(0, 0), b2, voffB); PG8_STAGE(PG8_SB(0, 1), b2 + hsB, voffB); PG8_STAGE(PG8_SA(0, 0), a2, voffA);
            PG8_WAIT_V(8); PG8_WAIT_L(0); PG8_BAR; PG8_MMA(1, 0, At, B0); PG8_MMA(1, 1, At, B1); PG8_BAR; PG8_SCHED;
            PG8_LDB(B0, 1, 0); PG8_LDB(B1, 1, 1); PG8_SCHED; PG8_LDA(At, 1, 0); PG8_STAGE(PG8_SA(0, 1), a2 + hstepA, PG8_VA1);
            PG8_WAIT_V(8); PG8_WAIT_L(0); PG8_BAR; PG8_MMA(0, 0, At, B0); PG8_MMA(0, 1, At, B1); PG8_BAR; PG8_SCHED;
            PG8_LDA(At, 1, 1); PG8_STAGE(PG8_SB(1, 0), b3, voffB); PG8_STAGE(PG8_SB(1, 1), b3 + hsB, voffB); PG8_STAGE(PG8_SA(1, 0), a3, voffA);
            PG8_WAIT_V(8); PG8_WAIT_L(0); PG8_BAR; PG8_MMA(1, 0, At, B0); PG8_MMA(1, 1, At, B1); PG8_BAR; PG8_SCHED;
        }
        if (wr == 0) PG8_BAR;
        if constexpr (F8S != 0u) asm volatile("s_nop 15\n\ts_nop 15" ::: "memory");
        E(acc, cur, wr, wc, fr, fq);
#if EPI_TWICE
        asm volatile("" ::: "memory"); E(acc, cur, wr, wc, fr, fq);
#endif
        if (!has_next) break;
        nxt.par = 0; E.unit_begin(nxt, rkey, rpar);
        E.init(acc, nxt, wr, wc, fr, fq);
        cur = nxt; cA = nA; cB = nB; ++ui;
        if (wr == 1) PG8_BAR;
    }
    PG8_WAIT_V(0);
    PG8_BAR;
#undef PG8_SA
#undef PG8_SB
#undef PG8_STAGE
#undef PG8_LDA
#undef PG8_LDB
#undef PG8_MMA
#undef PG8_WAIT_V
#undef PG8_WAIT_L
#undef PG8_BAR
#undef PG8_SCHED
#undef PG8_SETB
#undef PG8_VA1
#undef PG8_GIDX
}
}

#define XB_TMO      128
#define XB_XCNT(j)  (256  + 64 * (j))
#define XB_XSUB(j)  (1280 + 64 * (j))
#define XB_XGEN(j)  (2304 + 64 * (j))
#define XB_TOP      3328
#define XB_TOPGEN   3392
#define XCD_BAR_WORDS 3456
#define XB_SPIN_CAP (1u << 18)
__device__ __forceinline__ unsigned xb_ld(unsigned* p)              { return __hip_atomic_load(p, __ATOMIC_RELAXED, __HIP_MEMORY_SCOPE_AGENT); }
__device__ __forceinline__ unsigned xb_add(unsigned* p, unsigned v) { return __hip_atomic_fetch_add(p, v, __ATOMIC_RELAXED, __HIP_MEMORY_SCOPE_AGENT); }
__device__ __forceinline__ unsigned xb_xcc_id() { return (unsigned)__builtin_amdgcn_s_getreg((3 << 11) | 20) & 0xFu; }
#define XB_SPIN(cond, bar) do { unsigned _sp = 0; while (cond) { __builtin_amdgcn_s_sleep(1); \
    if ((++_sp & 255u) == 0u) { if (xb_ld(&(bar)[XB_TMO])) break; if (_sp > XB_SPIN_CAP) { atomicAdd(&(bar)[XB_TMO], 1u); break; } } } } while (0)
struct XcdBarrier { unsigned* bar; unsigned x; volatile LAS unsigned* st; };
__device__ __forceinline__ XcdBarrier xcd_barrier_post(unsigned* bar, volatile LAS unsigned* st) {
    XcdBarrier b; b.bar = bar; b.x = xb_xcc_id(); b.st = st;
    if (threadIdx.x == 0) (void)xb_add(&bar[XB_XCNT(b.x)], 1u);
    return b;
}
__device__ __forceinline__ void xcd_barrier_complete(unsigned* bar, unsigned x, unsigned& nloc, unsigned& nx) {
    const unsigned G = gridDim.x * gridDim.y * gridDim.z;
    unsigned sum, cnt, mine, sp = 0u;
    for (;;) {
        sum = 0u; cnt = 0u; mine = 0u;
#pragma unroll
        for (unsigned j = 0; j < 16; ++j) { const unsigned c = xb_ld(&bar[XB_XCNT(j)]); sum += c; cnt += (c > 0u) ? 1u : 0u; mine = (j == x) ? c : mine; }
        if (sum == G) break;
        __builtin_amdgcn_s_sleep(1);
        if ((++sp & 255u) == 0u) { if (xb_ld(&bar[XB_TMO])) break; if (sp > XB_SPIN_CAP) { atomicAdd(&bar[XB_TMO], 1u); break; } }
    }
    nloc = mine > 0u ? mine : 1u; nx = cnt > 0u ? cnt : 1u;
}
__device__ __forceinline__ void xcd_barrier(const XcdBarrier& b) {
    asm volatile("s_waitcnt vmcnt(0)" ::: "memory");
    __syncthreads();
    if (threadIdx.x == 0) {
        unsigned* bar = b.bar;
        __builtin_amdgcn_s_waitcnt(0);
        unsigned nloc = b.st[0], nx = b.st[1];
        if (nloc == 0u) { xcd_barrier_complete(bar, b.x, nloc, nx); b.st[0] = nloc; b.st[1] = nx; }
        const unsigned old = xb_add(&bar[XB_XSUB(b.x)], 1u);
        const unsigned gen = old / nloc;
        if (old + 1u == (gen + 1u) * nloc) {
            __builtin_amdgcn_fence(__ATOMIC_RELEASE, "agent");
            asm volatile("s_waitcnt vmcnt(0)" ::: "memory");
            const unsigned og = xb_add(&bar[XB_TOP], 1u);
            const unsigned tg = og / nx;
            if (og + 1u == (tg + 1u) * nx) xb_add(&bar[XB_TOPGEN], 1u);
            else XB_SPIN(xb_ld(&bar[XB_TOPGEN]) == tg, bar);
            __builtin_amdgcn_fence(__ATOMIC_ACQUIRE, "agent");
            xb_add(&bar[XB_XGEN(b.x)], 1u);
            asm volatile("s_waitcnt vmcnt(0)" ::: "memory");
        } else {
            XB_SPIN(xb_ld(&bar[XB_XGEN(b.x)]) == gen, bar);
            __builtin_amdgcn_fence(__ATOMIC_ACQUIRE, "agent");
            asm volatile("s_waitcnt vmcnt(0)" ::: "memory");
        }
    }
    __syncthreads();
}

struct Job { int in, K, ld, col0, ncols, mode, sk, sidx; unsigned long long src, dst; unsigned item0; int rk; int ridx; int pad; };
constexpr int NJOBS = 60;
struct JobTab { Job j[NJOBS]; unsigned nitems; unsigned pad[3]; };
constexpr JobTab make_jobs() {
    JobTab t{}; int n = 0; unsigned it = 0;
    auto add = [&](int in, unsigned long long src, int K, int ld, int col0, int ncols, unsigned long long dst_elem, int mode, int sk, int sidx, int rk = 0, int ridx = 0, int f8 = 0) {
        Job& q = t.j[n++]; q.in = in; q.K = K; q.ld = ld; q.col0 = col0; q.ncols = ncols; q.mode = mode; q.sk = sk; q.sidx = sidx; q.src = src; q.dst = dst_elem; q.item0 = it; q.rk = rk; q.ridx = ridx; q.pad = f8;
        it += (unsigned)((K / (f8 ? 128 : 64)) * (ncols / 64)); };
    add(5, 0, 1024, 1024, 0, 1024, W_A_IN, 0, 0, 0);
    for (int g = 0; g < 4; ++g) add(6, (unsigned long long)g * 65536, 256, 256, 0, 256, W_A_GRP + (unsigned long long)g * 65536, 0, 2, g * 256);
    add(8, 0, 1024, 1024, 0, 1024, W_A_OUT, 0, 0, 0);
    for (int g = 0; g < 3; ++g) {
        add(9, 0, 1024, 9216, g * 3072, 1024, W_B_QK + (unsigned long long)g * 524288, 0, 1, 0, 2, 1 * DM, 1);
        add(9, 0, 1024, 9216, g * 3072 + 1024, 1024, W_B_QK + (unsigned long long)(3 + g) * 524288, 0, 0, 0, 2, 1 * DM, 1);
        add(9, 0, 1024, 9216, g * 3072 + 2048, 1024, W_B_V + (unsigned long long)g * 1048576, 0, 0, 0, 2, 1 * DM);
    }
    add(10, 0, 1024, 1024, 0, 1024, W_B_OUT, 0, 0, 0);
    add(11, 0, 1024, 3072, 0, 1024, W_C_QK, 0, 1, 0, 0, 0, 1);
    add(11, 0, 1024, 3072, 1024, 1024, W_C_QK + 524288, 0, 0, 0, 0, 0, 1);
    add(11, 0, 1024, 3072, 2048, 1024, W_C_V, 0, 0, 0, 0, 0, 1);
    add(14, 0, 1024, 1024, 0, 1024, W_C_OUT, 0, 0, 0, 0, 0, 2);
    add(15, 0, 1024, 1536, 0, 1024, W_D_QK, 0, 1, 0, 2, 3 * DM, 1);
    add(15, 0, 1024, 1536, 1024, 256, W_D_QK + 524288, 0, 0, 0, 2, 3 * DM, 1);
    add(15, 0, 1024, 1536, 1280, 256, W_D_V, 0, 0, 0, 2, 3 * DM, 1);
    add(17, 0, 1024, 1024, 0, 1024, W_D_OUT, 0, 0, 0, 0, 0, 2);
    for (int l = 0; l < 2; ++l) add(18, (unsigned long long)l * 1024 * 7168, 1024, 7168, 0, 7168, W_F_GU + (unsigned long long)l * 7168 * 1024, 1, 0, 0, 3, 2 * l * DM, DENSE_F8(l) ? 1 : 0);
    for (int l = 0; l < 2; ++l) add(19, (unsigned long long)l * 3584 * 1024, 3584, 1024, 0, 1024, W_F_D + (unsigned long long)l * 3584 * 1024, 0, 0, 0, 0, 0, DENSE_F8(l) ? 2 : 0);
    for (int l = 0; l < 16; ++l) add(21, (unsigned long long)l * 1024 * 7168, 1024, 7168, 0, 7168, W_M_GU + (unsigned long long)l * 7168 * 512, 1, 0, 0, 0, 0, 1);
    for (int l = 0; l < 16; ++l) add(22, (unsigned long long)l * 3584 * 1024, 3584, 1024, 0, 1024, W_M_D + (unsigned long long)l * 3584 * 512, 0, 0, 0, 0, 0, 2);
    t.nitems = it;
    return t;
}
__constant__ JobTab g_jobs = make_jobs();
static_assert(make_jobs().j[NJOBS - 1].K == 3584, "job count");

struct Args { const float* in[23]; float* out; unsigned char* ws; int ph_lo, ph_hi; };

struct Frame {
    LAS unsigned char* lds;
    int G, c, vcu;
    __device__ __forceinline__ int tid_() const { return (int)threadIdx.x; }
    __device__ __forceinline__ int lane_() const { return (int)threadIdx.x & 63; }
    __device__ __forceinline__ int wave_() const { return __builtin_amdgcn_readfirstlane((int)threadIdx.x >> 6); }
};

__device__ __forceinline__ void conv_item(const Job& jb, const float* __restrict__ src, bf16_t* __restrict__ dst, const float* __restrict__ cs, const float* __restrict__ rsv, LAS unsigned* scr, unsigned item, int lane) {
    const bool f8 = jb.pad != 0; const float f8s = jb.pad == 1 ? 256.f : 128.f;
    const int ntn = jb.ncols >> 6; const int kb = (int)item / ntn, nb = (int)item % ntn, k0 = kb * (f8 ? 128 : 64), n0 = nb * 64;
    int drow = n0;
    if (jb.mode == 1) { int n = n0; const bool up = n >= DFF; if (up) n -= DFF; drow = (n >> 7) * 256 + (n & 127) + (up ? 128 : 0); }
    const int a = lane & 15, b = lane >> 4;
    const float sc = (jb.sk == 1) ? QSCALE : 1.0f;
    f32x4 csv = (f32x4){sc, sc, sc, sc};
    if (jb.sk == 2) csv = *(const f32x4*)(cs + jb.sidx + n0 + 4 * a);
    const float* sp = src + (size_t)(k0 + 2 * b) * jb.ld + jb.col0 + n0 + 4 * a;
    const int c = lane & 7;
    if (f8) {
        f32x4 v0[16], v1[16];
#pragma unroll
        for (int i = 0; i < 16; ++i) { v0[i] = __builtin_nontemporal_load((const f32x4*)(sp + (size_t)(8 * i) * jb.ld)); v1[i] = __builtin_nontemporal_load((const f32x4*)(sp + (size_t)(8 * i + 1) * jb.ld)); }
#pragma unroll
        for (int i = 0; i < 16; ++i) { float g0 = f8s, g1 = f8s; if (rsv) { g0 *= rsv[k0 + 8 * i + 2 * b]; g1 *= rsv[k0 + 8 * i + 2 * b + 1]; }
            const f32x4 x0 = v0[i] * csv * g0, x1 = v1[i] * csv * g1; const int kp = 4 * i + b;
#pragma unroll
            for (int j = 0; j < 4; ++j) ((LAS unsigned short*)scr)[(4 * a + j) * 66 + kp] = (unsigned short)__builtin_amdgcn_cvt_pk_fp8_f32(x0[j], x1[j], 0, false); }
        LDS_WAIT();
#pragma unroll
        for (int jj = 0; jj < 8; ++jj) { const int n = (lane >> 3) + 8 * jj; const LAS unsigned* s = scr + n * 33 + 4 * c;
            u32x4 o; o.x = s[0]; o.y = s[1]; o.z = s[2]; o.w = s[3];
            __builtin_nontemporal_store(o, (u32x4*)((unsigned char*)dst + (size_t)(drow + n) * jb.K + k0 + 16 * c)); }
        LDS_WAIT();
        return;
    }
    f32x4 v0[8], v1[8];
#pragma unroll
    for (int i = 0; i < 8; ++i) { v0[i] = __builtin_nontemporal_load((const f32x4*)(sp + (size_t)(8 * i) * jb.ld)); v1[i] = __builtin_nontemporal_load((const f32x4*)(sp + (size_t)(8 * i + 1) * jb.ld)); }
#pragma unroll
    for (int i = 0; i < 8; ++i) { float g0 = 1.0f, g1 = 1.0f; if (rsv) { g0 = rsv[k0 + 8 * i + 2 * b]; g1 = rsv[k0 + 8 * i + 2 * b + 1]; }
        const f32x4 x0 = v0[i] * csv * g0, x1 = v1[i] * csv * g1; const int kp = 4 * i + b;
#pragma unroll
        for (int j = 0; j < 4; ++j) scr[(4 * a + j) * 33 + kp] = cvt_pk_bf16(x0[j], x1[j]); }
    LDS_WAIT();
#pragma unroll
    for (int jj = 0; jj < 8; ++jj) { const int n = (lane >> 3) + 8 * jj; const LAS unsigned* s = scr + n * 33 + 4 * c;
        u32x4 o; o.x = s[0]; o.y = s[1]; o.z = s[2]; o.w = s[3];
        __builtin_nontemporal_store(o, (u32x4*)(dst + (size_t)(drow + n) * jb.K + k0 + 8 * c)); }
    LDS_WAIT();
}

__device__ __forceinline__ int rel_bucket(int rel) {
    const int n = rel < 0 ? -rel : rel;
    int big = 8 + (int)(logf((float)(n < 1 ? 1 : n) / 8.0f) / 4.852030263919617f * 8.0f);
    big = big < 15 ? big : 15;
    return (rel > 0 ? 16 : 0) + (n < 8 ? n : big);
}

__device__ __forceinline__ void load_row(const float* xrow, int lane, f32x4 (&v)[4]) {
    const f32x4* xr = (const f32x4*)xrow + lane;
#pragma unroll
    for (int j = 0; j < 4; ++j) v[j] = xr[64 * j];
}
__device__ __forceinline__ void load_row(const bf16_t* xrow, int lane, f32x4 (&v)[4]) {
    const u32x2* xr = (const u32x2*)xrow + lane;
#pragma unroll
    for (int j = 0; j < 4; ++j) { const u32x2 w = xr[64 * j]; v[j] = (f32x4){bf_lo(w.x), bf_hi(w.x), bf_lo(w.y), bf_hi(w.y)}; }
}
__device__ __forceinline__ float row_rstd(const f32x4 (&v)[4]) {
    float s = 0.f;
#pragma unroll
    for (int j = 0; j < 4; ++j) s += (v[j].x * v[j].x + v[j].y * v[j].y) + (v[j].z * v[j].z + v[j].w * v[j].w);
    return 1.0f / sqrtf(wave_sum(s) * (1.0f / DM) + RMS_EPS);
}
__device__ __forceinline__ void store_row_fp8(unsigned char* orow, int lane, const f32x4 (&v)[4]) {
#pragma unroll
    for (int j = 0; j < 4; ++j) *(unsigned*)(orow + 4 * lane + 256 * j) = pg8::pack_fp8x4(v[j].x, v[j].y, v[j].z, v[j].w, 1.0f);
}
__device__ __forceinline__ void store_row_bf16(bf16_t* orow, int lane, const f32x4 (&v)[4]) {
    u32x2* o8 = (u32x2*)orow + lane;
#pragma unroll
    for (int j = 0; j < 4; ++j) { u32x2 w; w.x = cvt_pk_bf16(v[j].x, v[j].y); w.y = cvt_pk_bf16(v[j].z, v[j].w); o8[64 * j] = w; }
}
template <class XT> __device__ __forceinline__ void rms_phase(const Frame& F, const XT* x, const float* gain, bf16_t* hn) {
    const int gw = F.c * NWAVES + F.wave_(), NGW = F.G * NWAVES;
    f32x4 g[4]; load_row(gain, F.lane_(), g);
    for (int m = gw; m < MTOK; m += 2 * NGW) {
        const int m2 = m + NGW; const bool two = m2 < MTOK;
        f32x4 v[4], w[4]; load_row(x + (size_t)m * DM, F.lane_(), v); load_row(x + (size_t)(two ? m2 : m) * DM, F.lane_(), w);
        const float rv = row_rstd(v), rw = row_rstd(w);
#pragma unroll
        for (int j = 0; j < 4; ++j) { v[j] = v[j] * rv * g[j]; w[j] = w[j] * rw * g[j]; }
        store_row_bf16(hn + (size_t)m * DM, F.lane_(), v);
        if (two) store_row_bf16(hn + (size_t)m2 * DM, F.lane_(), w);
    }
}

__device__ __forceinline__ int keyperm(int rho) { return (rho & 0x13) | ((rho & 4) << 1) | ((rho & 8) >> 1); }
template <int NVB> struct AttnAcc { f32x16 o[NVB]; float m, l; };
template <int NVB>
__device__ __forceinline__ void attn_tile(AttnAcc<NVB>& st, const bf16x8 (&qf)[4], const char* kptr, const char* vptr, const size_t vblk, const LAS float* bt) {
    bf16x8 kf[4], vf[NVB][2];
#pragma unroll
    for (int t = 0; t < 4; ++t) kf[t] = *(const bf16x8*)(kptr + t * 32);
#pragma unroll
    for (int b = 0; b < NVB; ++b)
#pragma unroll
        for (int t = 0; t < 2; ++t) vf[b][t] = *(const bf16x8*)(vptr + b * vblk + t * 32);
    f32x16 s;
#pragma unroll
    for (int r = 0; r < 16; ++r) s[r] = bt[(r >> 3) * 16 + (r & 7)];
#pragma unroll
    for (int t = 0; t < 4; ++t) s = __builtin_amdgcn_mfma_f32_32x32x16_bf16(kf[t], qf[t], s, 0, 0, 0);
    float mx = s[0];
#pragma unroll
    for (int r = 1; r < 16; ++r) mx = fmaxf(mx, s[r]);
    mx = fmaxf(mx, __shfl_xor(mx, 32));
    const float mn = fmaxf(st.m, mx), alpha = __builtin_amdgcn_exp2f(st.m - mn); st.m = mn;
    float ps = 0.f;
#pragma unroll
    for (int r = 0; r < 16; ++r) { s[r] = __builtin_amdgcn_exp2f(s[r] - mn); ps += s[r]; }
    st.l = st.l * alpha + ps;
#pragma unroll
    for (int b = 0; b < NVB; ++b) st.o[b] = st.o[b] * alpha;
    u32x4 p0, p1;
    p0.x = cvt_pk_bf16(s[0], s[1]); p0.y = cvt_pk_bf16(s[2], s[3]); p0.z = cvt_pk_bf16(s[4], s[5]); p0.w = cvt_pk_bf16(s[6], s[7]);
    p1.x = cvt_pk_bf16(s[8], s[9]); p1.y = cvt_pk_bf16(s[10], s[11]); p1.z = cvt_pk_bf16(s[12], s[13]); p1.w = cvt_pk_bf16(s[14], s[15]);
    const bf16x8 pf0 = __builtin_bit_cast(bf16x8, p0), pf1 = __builtin_bit_cast(bf16x8, p1);
#pragma unroll
    for (int b = 0; b < NVB; ++b) { st.o[b] = __builtin_amdgcn_mfma_f32_32x32x16_bf16(vf[b][0], pf0, st.o[b], 0, 0, 0); st.o[b] = __builtin_amdgcn_mfma_f32_32x32x16_bf16(vf[b][1], pf1, st.o[b], 0, 0, 0); }
}

template <int HALF>
__device__ __forceinline__ void band_item(const bf16_t* Qp, const bf16_t* Kp, const int ldqk, const size_t tok0, const int dil, const int L, const int q0,
                                          const bf16_t* Vt, const size_t vn0, const float* gtab_h, LAS float* tbl, const float m_init, const float l_init,
                                          bf16_t* out_row0  , const int ldo, float* lse_out  , const int lane) {
    const int ql = lane & 31, hf = lane >> 5;
    for (int i = lane; i < 2 * HALF + 63; i += 64) { const int j = i - HALF - 31; tbl[i] = (j >= -HALF && j <= HALF) ? gtab_h[j * dil + 2048] : NEG_BIG; }
    LDS_WAIT();
    const size_t qtok = tok0 + (size_t)(q0 + ql) * dil;
    bf16x8 qf[4];
#pragma unroll
    for (int t = 0; t < 4; ++t) qf[t] = *(const bf16x8*)(Qp + qtok * ldqk + 16 * t + 8 * hf);
    AttnAcc<2> st;
    st.o[0] = (f32x16){}; st.o[1] = (f32x16){}; st.m = m_init; st.l = (hf == 0) ? l_init : 0.f;
    const int kr = keyperm(ql);
    for (int kt = q0 - HALF; kt <= q0 + HALF; kt += 32) {
        if (kt < 0 || kt >= L) continue;
        const char* kptr = (const char*)(Kp + (tok0 + (size_t)(kt + kr) * dil) * ldqk + 8 * hf);
        const char* vptr = (const char*)(Vt + (size_t)ql * MTOK + vn0 + kt + 8 * hf);
        const LAS float* bt = tbl + (kt - q0 + HALF) + 8 * hf - ql + 31;
        attn_tile<2>(st, qf, kptr, vptr, (size_t)32 * MTOK * 2, bt);
    }
    const float lt = st.l + __shfl_xor(st.l, 32), inv = 1.0f / lt;
    bf16_t* orow = out_row0 + qtok * ldo;
#pragma unroll
    for (int b = 0; b < 2; ++b)
#pragma unroll
        for (int i = 0; i < 4; ++i) { u32x2 w; w.x = cvt_pk_bf16(st.o[b][4 * i] * inv, st.o[b][4 * i + 1] * inv); w.y = cvt_pk_bf16(st.o[b][4 * i + 2] * inv, st.o[b][4 * i + 3] * inv);
            *(u32x2*)(orow + 32 * b + 8 * i + 4 * hf) = w; }
    if (lse_out && hf == 0) lse_out[qtok * 16] = st.m + __builtin_amdgcn_logf(lt);
}


template <int HALF, bool OUT8 = false>
__device__ __forceinline__ void band_item64(const bf16_t* Qp, const bf16_t* Kp, const int ldqk, const size_t tok0, const int dil, const int L, const int q0,
                                            const bf16_t* Vt, const size_t vn0, const float* gtab_h, LAS float* tbl, LAS unsigned char* stg, const float m_init, const float l_init,
                                            bf16_t* out0, const int ldo, float* lse_out, const int lane) {
    const int ql = lane & 31, hf = lane >> 5, kp = keyperm(ql);
    for (int i = lane; i < 2 * HALF + 63; i += 64) { const int j = i - HALF - 31; tbl[i] = (j >= -HALF && j <= HALF) ? gtab_h[j * dil + 2048] : NEG_BIG; }
    unsigned ka[4], va[2];
#pragma unroll
    for (int t = 0; t < 4; ++t) ka[t] = (unsigned)(kp * 128 + (((2 * t + hf) ^ ((kp >> 1) & 7)) << 4));
#pragma unroll
    for (int t = 0; t < 2; ++t) va[t] = (unsigned)(ql * 64 + (((2 * t + hf) ^ ((ql >> 2) & 3)) << 4));
    const size_t krow = (size_t)dil * ldqk * 2;
    const char* kg = (const char*)Kp + (tok0 + (size_t)(lane >> 3) * dil) * ldqk * 2;
    const unsigned kcE = (unsigned)(((lane & 7) ^ (lane >> 4)) << 4), kcO = (unsigned)(((lane & 7) ^ (4 + (lane >> 4))) << 4);
    const char* vg = (const char*)(Vt + (size_t)(lane >> 2) * MTOK + vn0) + ((((lane & 3) ^ (lane >> 4))) << 4);
#define BI_GLDS(g, l) __builtin_amdgcn_global_load_lds((const unsigned*)(g), (LAS unsigned*)(l), 16, 0, 0)
#define BI_ISSUE(kt_, s_) do { LAS unsigned char* sb_ = stg + (s_) * 8192; const char* k_ = kg + (size_t)(kt_) * krow; const char* v_ = vg + (size_t)(kt_) * 2; \
        BI_GLDS(k_ + kcE, sb_); BI_GLDS(k_ + 8 * krow + kcO, sb_ + 1024); BI_GLDS(k_ + 16 * krow + kcE, sb_ + 2048); BI_GLDS(k_ + 24 * krow + kcO, sb_ + 3072); \
        BI_GLDS(v_, sb_ + 4096); BI_GLDS(v_ + (size_t)16 * MTOK * 2, sb_ + 5120); BI_GLDS(v_ + (size_t)32 * MTOK * 2, sb_ + 6144); BI_GLDS(v_ + (size_t)48 * MTOK * 2, sb_ + 7168); } while (0)
    bf16x8 qf[2][4];
#pragma unroll
    for (int g = 0; g < 2; ++g)
#pragma unroll
        for (int t = 0; t < 4; ++t) qf[g][t] = *(const bf16x8*)(Qp + (tok0 + (size_t)(q0 + 32 * g + ql) * dil) * ldqk + 16 * t + 8 * hf);
    f32x16 o[2][2]; float mr[2], lr[2];
#pragma unroll
    for (int g = 0; g < 2; ++g) { o[g][0] = (f32x16){}; o[g][1] = (f32x16){}; mr[g] = m_init; lr[g] = (hf == 0) ? l_init : 0.f; }
    const int kt_lo = (q0 - HALF) < 0 ? 0 : q0 - HALF, kt_hi = (q0 + 32 + HALF) > (L - 32) ? (L - 32) : q0 + 32 + HALF;
    asm volatile("s_waitcnt lgkmcnt(0)" ::: "memory");
    BI_ISSUE(kt_lo, 0);
    int s = 0;
    for (int kt = kt_lo; kt <= kt_hi; kt += 32) {
        if (kt + 32 <= kt_hi) { BI_ISSUE(kt + 32, s ^ 1); asm volatile("s_waitcnt vmcnt(8)" ::: "memory"); }
        else asm volatile("s_waitcnt vmcnt(0)" ::: "memory");
        const LAS unsigned char* Kt = stg + s * 8192; const LAS unsigned char* Vs = Kt + 4096;
        bf16x8 kf[4], vf[2][2];
#pragma unroll
        for (int t = 0; t < 4; ++t) kf[t] = *(const LAS bf16x8*)(Kt + ka[t]);
#pragma unroll
        for (int b = 0; b < 2; ++b)
#pragma unroll
            for (int t = 0; t < 2; ++t) vf[b][t] = *(const LAS bf16x8*)(Vs + b * 2048 + va[t]);
#pragma unroll
        for (int g = 0; g < 2; ++g) {
            const int qg = q0 + 32 * g;
            if (kt >= qg - HALF && kt <= qg + HALF) {
                const LAS float* bt = tbl + (kt - qg + HALF) + 8 * hf - ql + 31;
                f32x16 sc;
#pragma unroll
                for (int r = 0; r < 16; ++r) sc[r] = bt[(r >> 3) * 16 + (r & 7)];
#pragma unroll
                for (int t = 0; t < 4; ++t) sc = __builtin_amdgcn_mfma_f32_32x32x16_bf16(kf[t], qf[g][t], sc, 0, 0, 0);
                float mx = sc[0];
#pragma unroll
                for (int r = 1; r < 16; ++r) mx = fmaxf(mx, sc[r]);
                mx = fmaxf(mx, __shfl_xor(mx, 32));
                const float mn = fmaxf(mr[g], mx), alpha = __builtin_amdgcn_exp2f(mr[g] - mn); mr[g] = mn;
                float ps = 0.f;
#pragma unroll
                for (int r = 0; r < 16; ++r) { sc[r] = __builtin_amdgcn_exp2f(sc[r] - mn); ps += sc[r]; }
                lr[g] = lr[g] * alpha + ps;
                o[g][0] = o[g][0] * alpha; o[g][1] = o[g][1] * alpha;
                u32x4 p0, p1;
                p0.x = cvt_pk_bf16(sc[0], sc[1]); p0.y = cvt_pk_bf16(sc[2], sc[3]); p0.z = cvt_pk_bf16(sc[4], sc[5]); p0.w = cvt_pk_bf16(sc[6], sc[7]);
                p1.x = cvt_pk_bf16(sc[8], sc[9]); p1.y = cvt_pk_bf16(sc[10], sc[11]); p1.z = cvt_pk_bf16(sc[12], sc[13]); p1.w = cvt_pk_bf16(sc[14], sc[15]);
                const bf16x8 pf0 = __builtin_bit_cast(bf16x8, p0), pf1 = __builtin_bit_cast(bf16x8, p1);
#pragma unroll
                for (int b = 0; b < 2; ++b) { o[g][b] = __builtin_amdgcn_mfma_f32_32x32x16_bf16(vf[b][0], pf0, o[g][b], 0, 0, 0); o[g][b] = __builtin_amdgcn_mfma_f32_32x32x16_bf16(vf[b][1], pf1, o[g][b], 0, 0, 0); }
            }
        }
        s ^= 1;
    }
#pragma unroll
    for (int g = 0; g < 2; ++g) {
        const float lt = lr[g] + __shfl_xor(lr[g], 32), inv = 1.0f / lt;
        const size_t qtok = tok0 + (size_t)(q0 + 32 * g + ql) * dil;
        bf16_t* orow = out0 + qtok * ldo;
#pragma unroll
        for (int b = 0; b < 2; ++b)
#pragma unroll
            for (int i = 0; i < 4; ++i) {
                if constexpr (OUT8) { *(unsigned*)((unsigned char*)out0 + qtok * ldo + 32 * b + 8 * i + 4 * hf) = pg8::pack_fp8x4(o[g][b][4 * i], o[g][b][4 * i + 1], o[g][b][4 * i + 2], o[g][b][4 * i + 3], inv * ACT8_SCALE); }
                else { u32x2 w; w.x = cvt_pk_bf16(o[g][b][4 * i] * inv, o[g][b][4 * i + 1] * inv); w.y = cvt_pk_bf16(o[g][b][4 * i + 2] * inv, o[g][b][4 * i + 3] * inv);
                    *(u32x2*)(orow + 32 * b + 8 * i + 4 * hf) = w; } }
        if (lse_out && hf == 0) lse_out[qtok * 16] = mr[g] + __builtin_amdgcn_logf(lt);
    }
#undef BI_GLDS
#undef BI_ISSUE
}

template <int HALF, bool OUT8 = false>
__device__ __forceinline__ void band_item64q(const unsigned char* Qp, const unsigned char* Kp, const int ldqk, const size_t tok0, const int dil, const int L, const int q0,
                                            const unsigned char* Vt, const size_t vn0, const float* gtab_h, LAS float* tbl, LAS unsigned char* stg, const float m_init, const float l_init,
                                            bf16_t* out0, const int ldo, float* lse_out, const int lane) {
    const int ql = lane & 31, hf = lane >> 5, kp = keyperm(ql);
    for (int i = lane; i < 2 * HALF + 63; i += 64) { const int j = i - HALF - 31; tbl[i] = (j >= -HALF && j <= HALF) ? gtab_h[j * dil + 2048] : NEG_BIG; }
    unsigned ka[4], va[2];
#pragma unroll
    for (int t = 0; t < 4; ++t) ka[t] = (unsigned)(kp * 64 + ((t ^ ((kp >> 2) & 3)) << 4) + 8 * hf);
#pragma unroll
    for (int t = 0; t < 2; ++t) va[t] = (unsigned)(ql * 32 + 16 * t + 8 * hf);
    const size_t krow = (size_t)dil * ldqk;
    const char* kg = (const char*)Kp + (tok0 + (size_t)(lane >> 2) * dil) * ldqk + ((((lane & 3) ^ (lane >> 4))) << 4);
    const char* vg = (const char*)Vt + (size_t)(lane >> 1) * MTOK + vn0 + 16 * (lane & 1);
#define BQ_PK8(a_, b_, c_, d_) ((unsigned)__builtin_amdgcn_cvt_pk_fp8_f32((c_), (d_), __builtin_amdgcn_cvt_pk_fp8_f32((a_), (b_), 0, false), true))
#define BI_GLDS(g, l) __builtin_amdgcn_global_load_lds((const unsigned*)(g), (LAS unsigned*)(l), 16, 0, 0)
#define BI_ISSUE(kt_, s_) do { LAS unsigned char* sb_ = stg + (s_) * 8192; const char* k_ = kg + (size_t)(kt_) * krow; const char* v_ = vg + (size_t)(kt_); \
        BI_GLDS(k_, sb_); BI_GLDS(k_ + 16 * krow, sb_ + 1024); BI_GLDS(v_, sb_ + 2048); BI_GLDS(v_ + (size_t)32 * MTOK, sb_ + 3072); } while (0)
    long qf[2][4];
#pragma unroll
    for (int g = 0; g < 2; ++g)
#pragma unroll
        for (int t = 0; t < 4; ++t) qf[g][t] = *(const long*)(Qp + (tok0 + (size_t)(q0 + 32 * g + ql) * dil) * ldqk + 16 * t + 8 * hf);
    f32x16 o[2][2]; float mr[2], lr[2];
#pragma unroll
    for (int g = 0; g < 2; ++g) { o[g][0] = (f32x16){}; o[g][1] = (f32x16){}; mr[g] = m_init; lr[g] = (hf == 0) ? l_init * 16.0f : 0.f; }
    const int kt_lo = (q0 - HALF) < 0 ? 0 : q0 - HALF, kt_hi = (q0 + 32 + HALF) > (L - 32) ? (L - 32) : q0 + 32 + HALF;
    asm volatile("s_waitcnt lgkmcnt(0)" ::: "memory");
    BI_ISSUE(kt_lo, 0);
    int s = 0;
    for (int kt = kt_lo; kt <= kt_hi; kt += 32) {
        if (kt + 32 <= kt_hi) { BI_ISSUE(kt + 32, s ^ 1); asm volatile("s_waitcnt vmcnt(4)" ::: "memory"); }
        else asm volatile("s_waitcnt vmcnt(0)" ::: "memory");
        const LAS unsigned char* Kt = stg + s * 8192; const LAS unsigned char* Vs = Kt + 2048;
        long kf[4], vf[2][2];
#pragma unroll
        for (int t = 0; t < 4; ++t) kf[t] = *(const LAS long*)(Kt + ka[t]);
#pragma unroll
        for (int b = 0; b < 2; ++b)
#pragma unroll
            for (int t = 0; t < 2; ++t) vf[b][t] = *(const LAS long*)(Vs + b * 1024 + va[t]);
#pragma unroll
        for (int g = 0; g < 2; ++g) {
            const int qg = q0 + 32 * g;
            if (kt >= qg - HALF && kt <= qg + HALF) {
                const LAS float* bt = tbl + (kt - qg + HALF) + 8 * hf - ql + 31;
                f32x16 sc;
#pragma unroll
                for (int r = 0; r < 16; ++r) sc[r] = bt[(r >> 3) * 16 + (r & 7)];
#pragma unroll
                for (int t = 0; t < 4; ++t) sc = __builtin_amdgcn_mfma_f32_32x32x16_fp8_fp8(kf[t], qf[g][t], sc, 0, 0, 0);
                float mx = sc[0];
#pragma unroll
                for (int r = 1; r < 16; ++r) mx = fmaxf(mx, sc[r]);
                mx = fmaxf(mx, __shfl_xor(mx, 32));
                const float mn = fmaxf(mr[g], mx), alpha = __builtin_amdgcn_exp2f(mr[g] - mn); mr[g] = mn;
                float ps = 0.f;
                const float mn4 = mn - 4.0f;
#pragma unroll
                for (int r = 0; r < 16; ++r) { sc[r] = __builtin_amdgcn_exp2f(sc[r] - mn4); ps += sc[r]; }
                lr[g] = lr[g] * alpha + ps;
                o[g][0] = o[g][0] * alpha; o[g][1] = o[g][1] * alpha;
                u32x2 p0, p1;
                p0.x = BQ_PK8(sc[0], sc[1], sc[2], sc[3]); p0.y = BQ_PK8(sc[4], sc[5], sc[6], sc[7]); p1.x = BQ_PK8(sc[8], sc[9], sc[10], sc[11]); p1.y = BQ_PK8(sc[12], sc[13], sc[14], sc[15]);
                const long pf0 = __builtin_bit_cast(long, p0), pf1 = __builtin_bit_cast(long, p1);
#pragma unroll
                for (int b = 0; b < 2; ++b) { o[g][b] = __builtin_amdgcn_mfma_f32_32x32x16_fp8_fp8(vf[b][0], pf0, o[g][b], 0, 0, 0); o[g][b] = __builtin_amdgcn_mfma_f32_32x32x16_fp8_fp8(vf[b][1], pf1, o[g][b], 0, 0, 0); }
            }
        }
        s ^= 1;
    }
#pragma unroll
    for (int g = 0; g < 2; ++g) {
        const float lt = lr[g] + __shfl_xor(lr[g], 32), inv = (1.0f / ACT8_SCALE) / lt;
        const size_t qtok = tok0 + (size_t)(q0 + 32 * g + ql) * dil;
        bf16_t* orow = out0 + qtok * ldo;
#pragma unroll
        for (int b = 0; b < 2; ++b)
#pragma unroll
            for (int i = 0; i < 4; ++i) {
                if constexpr (OUT8) { *(unsigned*)((unsigned char*)out0 + qtok * ldo + 32 * b + 8 * i + 4 * hf) = pg8::pack_fp8x4(o[g][b][4 * i], o[g][b][4 * i + 1], o[g][b][4 * i + 2], o[g][b][4 * i + 3], inv * ACT8_SCALE); }
                else { u32x2 w; w.x = cvt_pk_bf16(o[g][b][4 * i] * inv, o[g][b][4 * i + 1] * inv); w.y = cvt_pk_bf16(o[g][b][4 * i + 2] * inv, o[g][b][4 * i + 3] * inv);
                    *(u32x2*)(orow + 32 * b + 8 * i + 4 * hf) = w; } }
        if (lse_out && hf == 0) lse_out[qtok * 16] = mr[g] + __builtin_amdgcn_logf(lt) - 4.0f;
    }
#undef BI_GLDS
#undef BI_ISSUE
#undef BQ_PK8
}

struct PlainSched {
    const char* A; const char* B; unsigned lda, ldb; int nM, nN, G, c; size_t co_m, co_n;
    __device__ __forceinline__ bool next(int i, pg8::Unit& u) const {
        const long L = (long)i * G + c; if (L >= (long)nM * nN) return false;
        int pm, pn; pg8::tile_order(nM, nN, (int)L, pm, pn);
        u.A = A + (size_t)pm * 256 * lda; u.B = B + (size_t)pn * 256 * ldb; u.ldb = ldb; u.hsb = 128u * ldb; u.co = (size_t)pm * co_m + (size_t)pn * co_n; u.tag = 0; return true;
    }
};
struct QkvSched {
    const char* hn; const char* Wqk; const char* Wv; int nNqk, nvp, nMv, dshift, G, c; int ldqk; unsigned rs = 2048u;
    __device__ __forceinline__ bool next(int i, pg8::Unit& u) const {
        long L = (long)i * G + c; const int n0 = 64 * nNqk, nv = nMv * 64;
        if (L < n0) { int pm, pn; pg8::tile_order(64, nNqk, (int)L, pm, pn);
            u.A = hn + (size_t)pm * 256 * rs; u.B = Wqk + (size_t)pn * 256 * rs; u.ldb = rs; u.hsb = 128u * rs; u.co = (size_t)pm * 256 * ldqk + (size_t)pn * 256; u.tag = 0; return true; }
        L -= n0; if (L >= (long)nvp * nv) return false;
        const int g = (int)(L / nv); int pm, pn; pg8::tile_order(nMv, 64, (int)(L % nv), pm, pn);
        const int d = 1 << (dshift * g), b = pn >> 3, nn = (pn & 7) * 256;
        size_t tok; unsigned ldb, hsb;
        if (d == 1) { tok = (size_t)b * SEQ + nn; ldb = rs; hsb = 128u * rs; }
        else if (d == 4) { tok = (size_t)b * SEQ + (size_t)(nn & 511) * 4 + (nn >> 9); ldb = 4u * rs; hsb = 128u * 4u * rs; }
        else { tok = (size_t)b * SEQ + (nn >> 7); ldb = 16u * rs; hsb = rs; }
        u.A = Wv + (size_t)(g * nMv + pm) * 256 * rs; u.B = hn + tok * rs; u.ldb = ldb; u.hsb = hsb;
        u.co = (size_t)(g * nMv + pm) * 256 * MTOK + (size_t)pn * 256; u.tag = 1; return true;
    }
};
struct MoeSched {
    const char* A; const char* B; unsigned lda, ldb; const int* panel; size_t estride; int nN, G, c; size_t co_m, co_n; int use_limit; const int* rows;
    __device__ __forceinline__ bool next(int i, pg8::Unit& u) const {
        const int nM = __builtin_amdgcn_readfirstlane(panel[0]); const long L = (long)i * G + c; const long lim = (use_limit && __builtin_amdgcn_readfirstlane(panel[3]) > 1) ? (long)__builtin_amdgcn_readfirstlane(panel[1]) : (long)nM * nN; if (L >= lim) return false;
        int pm, pn; pg8::tile_order(nM, nN, (int)L, pm, pn); const int e = __builtin_amdgcn_readfirstlane(panel[4 + pm]);
        u.A = rows ? A : A + (size_t)pm * 256 * lda; u.ridx = rows ? rows + pm * 256 : nullptr; u.B = B + (size_t)e * estride + (size_t)pn * 256 * ldb; u.ldb = ldb; u.hsb = 128u * ldb; u.co = (size_t)pm * co_m + (size_t)pn * co_n; u.tag = 0; return true;
    }
};
struct MoeDown8Sched {
    const char* A; const char* B; const int* panel; int G, c;
    __device__ __forceinline__ bool next(int i, pg8::Unit& u) const {
        const int nM = __builtin_amdgcn_readfirstlane(panel[0]); const long L = (long)i * G + c; const long lim = __builtin_amdgcn_readfirstlane(panel[3]) > 1 ? (long)__builtin_amdgcn_readfirstlane(panel[1]) : (long)nM * 4; if (L >= lim) return false;
        int pm, pn; pg8::tile_order(nM, 4, (int)L, pm, pn); const int e = __builtin_amdgcn_readfirstlane(panel[4 + pm]);
        u.A = A + (size_t)pm * 256 * 3584; u.ridx = nullptr; u.B = B + (size_t)e * (3584 * 1024) + (size_t)pn * 256 * 3584; u.ldb = 3584u; u.hsb = 128u * 3584u; u.co = (size_t)pm * 256 * DM + (size_t)pn * 256; u.tag = 0; return true;
    }
};
struct MoeSplitSched {
    const char* A; const char* B; const int* panel; size_t estride; int c;
    __device__ __forceinline__ bool next(int i, pg8::Unit& u) const {
        const int S = __builtin_amdgcn_readfirstlane(panel[3]), rem = __builtin_amdgcn_readfirstlane(panel[2]); if (i > 0 || S <= 1 || c >= rem * S) return false;
        const int q = c / S, ks = c - q * S, ksub = DFF / S;
        int pm, pn; pg8::tile_order(__builtin_amdgcn_readfirstlane(panel[0]), 4, __builtin_amdgcn_readfirstlane(panel[1]) + q, pm, pn); const int e = __builtin_amdgcn_readfirstlane(panel[4 + pm]);
        u.A = A + (size_t)pm * 256 * 3584 + (size_t)ks * ksub; u.B = B + (size_t)e * estride + (size_t)pn * 256 * 3584 + (size_t)ks * ksub; u.ldb = 3584u; u.hsb = 128u * 3584u; u.co = (size_t)c * 65536; u.tag = 0; return true;
    }
};

__device__ __forceinline__ void moe_route(const Frame& F, const bf16_t* x, const float* gain, const float* router, bf16_t* hn, int* e12, float* g1o, float* g2o, int* cnt_wg) {
    LAS int* cnt = (LAS int*)(F.lds + 32768);
    f32x4 R[4][8];
#pragma unroll
    for (int j = 0; j < 4; ++j) { const f32x4* rp = (const f32x4*)(router + (size_t)(4 * F.lane_() + 256 * j) * NE);
#pragma unroll
        for (int q = 0; q < 8; ++q) R[j][q] = rp[q]; }
    f32x4 g[4]; load_row(gain, F.lane_(), g);
    for (int ch = F.c; ch < MTOK / 64; ch += F.G) {
        if (F.tid_() < 8) cnt[F.tid_()] = 0;
        const int m0 = ch * 64 + F.wave_() * 8;
        u32x2 raw[4][4];
#pragma unroll
        for (int i = 0; i < 4; ++i) { const u32x2* xr = (const u32x2*)(x + (size_t)(m0 + i) * DM) + F.lane_();
#pragma unroll
            for (int j = 0; j < 4; ++j) raw[i][j] = xr[64 * j]; }
        __syncthreads();
        int my_e = 0; float my_ga = 0.f, my_gb = 0.f;
#pragma unroll
        for (int i = 0; i < 8; ++i) {
            const int m = m0 + i;
            f32x4 v[4];
#pragma unroll
            for (int j = 0; j < 4; ++j) v[j] = (f32x4){bf_lo(raw[i & 3][j].x), bf_hi(raw[i & 3][j].x), bf_lo(raw[i & 3][j].y), bf_hi(raw[i & 3][j].y)};
            if (i < 4) { const u32x2* xr = (const u32x2*)(x + (size_t)(m + 4) * DM) + F.lane_();
#pragma unroll
                for (int j = 0; j < 4; ++j) raw[i & 3][j] = xr[64 * j]; }
            const float rstd = row_rstd(v);
#pragma unroll
            for (int j = 0; j < 4; ++j) v[j] = v[j] * rstd * g[j];
            { unsigned char* hr = (unsigned char*)hn + (size_t)m * DM + 4 * F.lane_();
#pragma unroll
              for (int j = 0; j < 4; ++j) *(unsigned*)(hr + 256 * j) = pg8::pack_fp8x4(v[j].x, v[j].y, v[j].z, v[j].w, 1.0f); }
            f32x4 l0 = (f32x4){0.f, 0.f, 0.f, 0.f}, l1 = l0;
#pragma unroll
            for (int j = 0; j < 4; ++j)
#pragma unroll
                for (int z = 0; z < 4; ++z) { l0 += R[j][2 * z] * v[j][z]; l1 += R[j][2 * z + 1] * v[j][z]; }
            float lg[8] = {l0.x, l0.y, l0.z, l0.w, l1.x, l1.y, l1.z, l1.w};
            { const int ln = F.lane_(); const bool h5 = (ln & 32) != 0, h4 = (ln & 16) != 0, h3 = (ln & 8) != 0;
              float a4[4];
#pragma unroll
              for (int k = 0; k < 4; ++k) { const float keep = h5 ? lg[4 + k] : lg[k], give = h5 ? lg[k] : lg[4 + k]; a4[k] = keep + __shfl_xor(give, 32); }
              float a2[2];
#pragma unroll
              for (int k = 0; k < 2; ++k) { const float keep = h4 ? a4[2 + k] : a4[k], give = h4 ? a4[k] : a4[2 + k]; a2[k] = keep + __shfl_xor(give, 16); }
              float a1; { const float keep = h3 ? a2[1] : a2[0], give = h3 ? a2[0] : a2[1]; a1 = keep + __shfl_xor(give, 8); }
              a1 += __shfl_xor(a1, 4); a1 += __shfl_xor(a1, 2); a1 += __shfl_xor(a1, 1);
#pragma unroll
              for (int e = 0; e < 8; ++e) lg[e] = __shfl(a1, 8 * e); }
            int e1 = 0; float v1 = lg[0];
#pragma unroll
            for (int e = 1; e < 8; ++e) if (lg[e] > v1) { v1 = lg[e]; e1 = e; }
            int e2 = -1; float v2 = -3.4e38f;
#pragma unroll
            for (int e = 0; e < 8; ++e) if (e != e1 && lg[e] > v2) { v2 = lg[e]; e2 = e; }
            const float ex = __expf(v2 - v1), ga = 1.0f / (1.0f + ex), gb = ex * ga;
            const bool mine = F.lane_() == i;
            my_e = mine ? (e1 | (e2 << 8)) : my_e; my_ga = mine ? ga : my_ga; my_gb = mine ? gb : my_gb;
            if (i & 1) __builtin_amdgcn_sched_barrier(0);
        }
        if (F.lane_() < 8) { const int m = m0 + F.lane_(); e12[m] = my_e; g1o[m] = my_ga; g2o[m] = my_gb; atomicAdd((int*)&cnt[my_e & 255], 1); atomicAdd((int*)&cnt[my_e >> 8], 1); }
        __syncthreads();
        if (F.tid_() < 8) cnt_wg[ch * 8 + F.tid_()] = cnt[F.tid_()];
        __syncthreads();
    }
}
__device__ __forceinline__ void moe_assign(const Frame& F, const int* e12, const int* cnt_wg, int* p1o, int* p2o, int* panel, int* rowtok) {
    LAS int* psum = (LAS int*)F.lds;
    LAS int* tot = psum + 512; LAS int* base = tot + 8; LAS int* off = base + 8;
    LAS int* plist = off + 16;
    for (int ch = F.c; ch < MTOK / 64; ch += F.G) {
        { const int e = F.tid_() & 7, part = F.tid_() >> 3; int s = 0;
#pragma unroll
          for (int q = 0; q < 4; ++q) s += cnt_wg[(4 * part + q) * 8 + e];
          psum[part * 8 + e] = s; }
        __syncthreads();
        if (F.tid_() < 8) { const int e = F.tid_(); int t = 0, b = 0; for (int p = 0; p < 64; ++p) { const int s = psum[p * 8 + e]; if (p < (ch >> 2)) b += s; t += s; }
            for (int q = 0; q < (ch & 3); ++q) b += cnt_wg[(4 * (ch >> 2) + q) * 8 + e];
            tot[e] = t; base[e] = b; }
        __syncthreads();
        if (F.tid_() == 0) { int o = 0; for (int e = 0; e < 8; ++e) { off[e] = o; o += (tot[e] + 255) & ~255; } off[8] = o; }
        __syncthreads();
        if (F.wave_() == 0) {
            const int m = ch * 64 + F.lane_(); const int ee = e12[m]; const int e1 = ee & 255, e2 = ee >> 8; int p1 = 0, p2 = 0;
#pragma unroll
            for (int e = 0; e < 8; ++e) { const unsigned long long mk = __ballot(e1 == e || e2 == e); const int rk = __popcll(mk & ((1ull << F.lane_()) - 1ull));
                if (e1 == e) p1 = off[e] + base[e] + rk; if (e2 == e) p2 = off[e] + base[e] + rk; }
            p1o[m] = p1; p2o[m] = p2; rowtok[p1] = m; rowtok[p2] = m;
        }
        __syncthreads();
        if (ch < 8) { const int e = ch; for (int r = off[e] + tot[e] + F.tid_(); r < off[e + 1]; r += NWAVES * 64) rowtok[r] = 0; }
        if (ch == 0) { const int P_ = off[8] >> 8, U_ = 4 * P_, full_ = (U_ / F.G) * F.G, rem_ = U_ - full_;
            const int S_ = (!MOE_SPLIT || rem_ == 0) ? 1 : (rem_ * 7 <= F.G ? 7 : (rem_ * 4 <= F.G ? 4 : 1));
            if (F.tid_() == 0) { panel[0] = P_; panel[1] = full_; panel[2] = rem_; panel[3] = S_; }
            for (int L = F.tid_(); L < U_; L += NWAVES * 64) { int pm, pn; pg8::tile_order(P_, 4, L, pm, pn); panel[160 + pm * 4 + pn] = (S_ > 1 && L >= full_) ? L - full_ : -1; }
            if (F.tid_() < NPANEL_MAX) { const int r = F.tid_() * 256; int e = 0;
#pragma unroll
                for (int q = 1; q < 8; ++q) if (r >= off[q]) e = q;
                panel[4 + F.tid_()] = e; } }
        __syncthreads();
    }
}
__device__ __forceinline__ void moe_add_row(const Frame& F, f32x4 (&v)[4], const bf16_t* ys, const int pos, const float gt) {
    const u32x2* ya = (const u32x2*)(ys + (size_t)pos * DM) + F.lane_();
#pragma unroll
    for (int j = 0; j < 4; ++j) { const u32x2 a = ya[64 * j]; v[j].x += gt * bf_lo(a.x); v[j].y += gt * bf_hi(a.x); v[j].z += gt * bf_lo(a.y); v[j].w += gt * bf_hi(a.y); }
}
__device__ __forceinline__ void moe_reduce_parts(const Frame& F, const float* part, const int* panel, bf16_t* ys) {
    const int S = panel[3], rem = panel[2]; if (S <= 1) return;
    const int gw = F.c * NWAVES + F.wave_(), NGW = F.G * NWAVES;
    for (int it = gw; it < rem * 64; it += NGW) {
        const int q = it >> 6, r0 = (it & 63) * 4; int pm, pn; pg8::tile_order(panel[0], 4, panel[1] + q, pm, pn);
#pragma unroll
        for (int rr = 0; rr < 4; ++rr) {
            const float* pp = part + (size_t)q * S * 65536 + (size_t)(r0 + rr) * 256 + 4 * F.lane_(); f32x4 t[7];
#pragma unroll
            for (int ks = 0; ks < 7; ++ks) t[ks] = (ks < S) ? *(const f32x4*)(pp + (size_t)ks * 65536) : (f32x4){0.f, 0.f, 0.f, 0.f};
            const f32x4 s = ((t[0] + t[1]) + (t[2] + t[3])) + ((t[4] + t[5]) + t[6]);
            u32x2 w; w.x = cvt_pk_bf16(s.x, s.y); w.y = cvt_pk_bf16(s.z, s.w);
            *(u32x2*)(ys + (size_t)(pm * 256 + r0 + rr) * DM + pn * 256 + 4 * F.lane_()) = w;
        }
    }
}
__device__ __forceinline__ void moe_combine(const Frame& F, const bf16_t* x, const bf16_t* ys, const float* part, const int* panel, const int* p1, const int* p2, const float* g1, const float* g2, const float* gain, bf16_t* xo, bf16_t* hn, float* outf) {
    const int gw = F.c * NWAVES + F.wave_(), NGW = F.G * NWAVES, lane = F.lane_();
    f32x4 g[4]; load_row(gain, lane, g);
    for (int m0 = gw; m0 < MTOK; m0 += 2 * NGW) {
        const int m1 = (m0 + NGW < MTOK) ? m0 + NGW : m0; const bool two = m1 != m0;
        const int pa0 = p1[m0], pb0 = p2[m0], pa1 = p1[m1], pb1 = p2[m1]; const float ga0 = g1[m0], gb0 = g2[m0], ga1 = g1[m1], gb1 = g2[m1];
        f32x4 v[4], w[4]; load_row(x + (size_t)m0 * DM, lane, v); load_row(x + (size_t)m1 * DM, lane, w);
        u32x2 ya[4], yb[4], yc[4], yd[4];
        { const u32x2* a = (const u32x2*)(ys + (size_t)pa0 * DM) + lane; const u32x2* b = (const u32x2*)(ys + (size_t)pb0 * DM) + lane;
          const u32x2* c = (const u32x2*)(ys + (size_t)pa1 * DM) + lane; const u32x2* d = (const u32x2*)(ys + (size_t)pb1 * DM) + lane;
#pragma unroll
          for (int j = 0; j < 4; ++j) { ya[j] = a[64 * j]; yb[j] = b[64 * j]; yc[j] = c[64 * j]; yd[j] = d[64 * j]; } }
#pragma unroll
        for (int j = 0; j < 4; ++j) {
            v[j].x += ga0 * bf_lo(ya[j].x) + gb0 * bf_lo(yb[j].x); v[j].y += ga0 * bf_hi(ya[j].x) + gb0 * bf_hi(yb[j].x); v[j].z += ga0 * bf_lo(ya[j].y) + gb0 * bf_lo(yb[j].y); v[j].w += ga0 * bf_hi(ya[j].y) + gb0 * bf_hi(yb[j].y);
            w[j].x += ga1 * bf_lo(yc[j].x) + gb1 * bf_lo(yd[j].x); w[j].y += ga1 * bf_hi(yc[j].x) + gb1 * bf_hi(yd[j].x); w[j].z += ga1 * bf_lo(yc[j].y) + gb1 * bf_lo(yd[j].y); w[j].w += ga1 * bf_hi(yc[j].y) + gb1 * bf_hi(yd[j].y); }
        if (xo) { store_row_bf16(xo + (size_t)m0 * DM, lane, v); if (two) store_row_bf16(xo + (size_t)m1 * DM, lane, w); }
        const float rv = row_rstd(v), rw = row_rstd(w);
#pragma unroll
        for (int j = 0; j < 4; ++j) { v[j] = v[j] * rv * g[j]; w[j] = w[j] * rw * g[j]; }
        if (outf) { f32x4* o = (f32x4*)(outf + (size_t)m0 * DM) + lane; f32x4* o2 = (f32x4*)(outf + (size_t)m1 * DM) + lane;
#pragma unroll
            for (int j = 0; j < 4; ++j) { o[64 * j] = v[j]; if (two) o2[64 * j] = w[j]; } }
        else { store_row_fp8((unsigned char*)hn + (size_t)m0 * DM, lane, v); if (two) store_row_fp8((unsigned char*)hn + (size_t)m1 * DM, lane, w); }
    }
}


__global__ void __launch_bounds__(NWAVES * 64, 2) enc_fwd(Args args) {
    extern __shared__ __attribute__((aligned(16))) unsigned char lds_raw[];
    Frame F;
    F.lds = (LAS unsigned char*)lds_raw;
    F.G = gridDim.x; F.c = blockIdx.x; F.vcu = (F.G % 8 == 0) ? (F.c % 8) * (F.G / 8) + F.c / 8 : F.c;
    unsigned char* ws = args.ws;
    volatile LAS unsigned* MISC = (volatile LAS unsigned*)(F.lds + MISC_OFF);
    for (int u = F.tid_(); u < (LDS_BYTES - LDSCTL_OFF) / 4; u += NWAVES * 64) ((LAS unsigned*)(F.lds + LDSCTL_OFF))[u] = 0u;
    __syncthreads();
#if MK_MULTI
    #define GRID_BAR() do { } while (0)
#else
    XcdBarrier bar = xcd_barrier_post((unsigned*)(ws + WS_CTL) + CW_BAR, MISC + 8);
    #define GRID_BAR() xcd_barrier(bar)
#endif
    const int lo = args.ph_lo, hi = args.ph_hi;
#define IN(k) (lo <= (k) && (k) < hi)
#define SEAM(k) do { if (IN((k) + 1)) GRID_BAR(); } while (0)
#define PREP(k) ((((unsigned long long)(PROBE_MASK) >> (k)) & 1ull) ? PROBE_N : 1)
#define PH_BEGIN(k) if (IN(k)) { const unsigned long long t0_ = ((((unsigned long long)(SLOW_MASK)) >> (k)) & 1ull) ? wall_clock64() : 0ull; for (int rep_ = 0; rep_ < PREP(k); ++rep_) {
#define PH_END(k) } SEAM(k); if (((((unsigned long long)(SLOW_MASK)) >> (k)) & 1ull) ) { const unsigned long long t1_ = wall_clock64(), te_ = t1_ + 8ull * (t1_ - t0_); while (wall_clock64() < te_) __builtin_amdgcn_s_sleep(32); } }

    const float* x_in = args.in[0]; const float* rel_bias = args.in[1]; const float* norm_mix = args.in[2]; const float* norm_ffn = args.in[3]; const float* norm_final = args.in[4];
    bf16_t* Wb = (bf16_t*)(ws + WS_W);
    float* gtab = (float*)(ws + WS_TAB); float* misc = (float*)(ws + WS_MISC);
    int* r_e12 = (int*)(ws + WS_ROUTE); float* r_g1 = (float*)(ws + WS_ROUTE + 65536); float* r_g2 = (float*)(ws + WS_ROUTE + 2 * 65536);
    int* r_p1 = (int*)(ws + WS_ROUTE + 3 * 65536); int* r_p2 = (int*)(ws + WS_ROUTE + 4 * 65536);
    int* cnt_wg = (int*)(ws + WS_CNT); int* panel = (int*)(ws + WS_PANEL);
    bf16_t* XA = (bf16_t*)(ws + WS_XA); bf16_t* XB = (bf16_t*)(ws + WS_XB);
    bf16_t* HN = (bf16_t*)(ws + WS_HN); bf16_t* BUFA = (bf16_t*)(ws + WS_BUFA); bf16_t* BUFB = (bf16_t*)(ws + WS_BUFB); bf16_t* BUFC = (bf16_t*)(ws + WS_BUFC);
    bf16_t* BIG = (bf16_t*)(ws + WS_BIG); bf16_t* VT = (bf16_t*)(ws + WS_VT); bf16_t* OG = (bf16_t*)(ws + WS_OG); float* LSE = (float*)(ws + WS_LSE);
    int* rowtok = (int*)(ws + WS_ROUTE + 512 * 1024);
    bf16_t* YS = OG; float* PART = (float*)(ws + WS_PART); float* PS = (float*)(ws + WS_PS);
    LAS float* RTAB = (LAS float*)(F.lds + RING_BYTES + 1024);
    LAS unsigned char* ring = F.lds;
    unsigned char* X8 = (unsigned char*)HN;

#define PLAIN_GEMM(EPI, Aptr, Bptr, K_, lda_, ldb_, nM_, nN_, com_, con_) do { \
        PlainSched S_{(const char*)(Aptr), (const char*)(Bptr), (unsigned)(lda_), (unsigned)(ldb_), (nM_), (nN_), F.G, F.c, (size_t)(com_), (size_t)(con_)}; \
        pg8::gemm_phase(ring, (K_), (unsigned)(lda_), S_, EPI); } while (0)

#define DENSE_FFN(p, l, xr, xo) \
    PH_BEGIN(p) pg8::EpiSwigluT<true> E_{BIG, DFF, PS, (const char*)(xr), RTAB}; PLAIN_GEMM(E_, (xr), Wb + W_F_GU + (size_t)(l) * 7168 * 1024, 1024, 2048, 2048, 64, 28, 256 * DFF, 128); PH_END(p) \
    PH_BEGIN((p) + 1) pg8::EpiResidT<false, true, 1> E_{(xr), (xo), PS, X8}; PLAIN_GEMM(E_, BIG, Wb + W_F_D + (size_t)(l) * 3584 * 1024, 3584, 7168, 7168, 64, 4, 256 * DM, 256); PH_END((p) + 1)
#define DENSE_FFN8(p, l, xr, xo) \
    PH_BEGIN(p) pg8::EpiSwiglu8T<true> E_{(unsigned char*)BIG, DFF, PS, (const char*)X8, RTAB}; PlainSched S_{(const char*)X8, (const char*)(Wb + W_F_GU + (size_t)(l) * 7168 * 1024), 1024u, 1024u, 64, 28, F.G, F.c, (size_t)256 * DFF, (size_t)128}; \
        pg8::gemm_phase<false, F8_GU>(ring, 512, 1024u, S_, E_); PH_END(p) \
    PH_BEGIN((p) + 1) pg8::EpiResidT<false, true, 3> E_{(xr), (xo), PS, X8}; PlainSched S_{(const char*)BIG, (const char*)(Wb + W_F_D + (size_t)(l) * 3584 * 1024), 3584u, 3584u, 64, 4, F.G, F.c, (size_t)256 * DM, (size_t)256}; \
        pg8::gemm_phase<false, F8_DN>(ring, 1792, 3584u, S_, E_); PH_END((p) + 1)

#define MOE_FFN(p, l, xr, gain) \
    PH_BEGIN(p) moe_route(F, (xr), (gain), args.in[20] + (size_t)(l) * DM * NE, HN, r_e12, r_g1, r_g2, cnt_wg); PH_END(p) \
    PH_BEGIN((p) + 1) moe_assign(F, r_e12, cnt_wg, r_p1, r_p2, panel, rowtok); PH_END((p) + 1) \
    PH_BEGIN((p) + 2) pg8::EpiSwiglu8 E_{(unsigned char*)BIG, DFF, nullptr, nullptr, nullptr}; MoeSched S_{(const char*)HN, (const char*)(Wb + W_M_GU) + (size_t)(l) * 8 * 7168 * 1024, 1024u, 1024u, panel, (size_t)7168 * 1024, 28, F.G, F.c, (size_t)256 * DFF, (size_t)128, 0, rowtok}; \
        pg8::gemm_phase<true, F8_GU>(ring, 512, 1024u, S_, E_); PH_END((p) + 2) \
    PH_BEGIN((p) + 3) pg8::EpiYs8 E_{YS}; MoeDown8Sched S_{(const char*)BIG, (const char*)(Wb + W_M_D) + (size_t)(l) * 8 * 3584 * 1024, panel, F.G, F.c}; \
        pg8::gemm_phase<false, F8_DN>(ring, 1792, 3584u, S_, E_); \
        { pg8::EpiPart E2_{PART, F8_DN_UNSCALE}; MoeSplitSched S2_{(const char*)BIG, (const char*)(Wb + W_M_D) + (size_t)(l) * 8 * 3584 * 1024, panel, (size_t)3584 * 1024, F.c}; \
          const int sp_ = panel[3] > 1 ? panel[3] : 1; pg8::gemm_phase<false, F8_DN>(ring, DFF / sp_ / 2, 3584u, S2_, E2_); } PH_END((p) + 3)

    PH_BEGIN(0)
        LAS unsigned* scr = (LAS unsigned*)(F.lds + F.wave_() * 8448);
        const unsigned gw = (unsigned)(F.c * NWAVES + F.wave_()), NGW = (unsigned)(F.G * NWAVES);
        int jn = 0;
        for (unsigned it = gw; it < g_jobs.nitems; it += NGW) {
            while (jn + 1 < NJOBS && g_jobs.j[jn + 1].item0 <= it) ++jn;
            const Job& jb = g_jobs.j[jn];
            conv_item(jb, args.in[jb.in] + jb.src, Wb + jb.dst, args.in[7], jb.rk ? args.in[jb.rk] + jb.ridx : nullptr, scr, it - jb.item0, F.lane_());
        }
        for (int i = F.c * NWAVES * 64 + F.tid_(); i < 16 * 4096; i += F.G * NWAVES * 64) { const int h = i >> 12, idx = i & 4095; gtab[i] = rel_bias[rel_bucket(idx - 2048) * 16 + h] * LOG2E; }
        if (F.c == 1) for (int i = F.tid_(); i < 4096; i += NWAVES * 64) ((unsigned char*)(ws + WS_BID))[i] = (unsigned char)rel_bucket(i - 2048);
        if (F.c == 0 && F.tid_() == 0) { const float* lv = args.in[12]; float s0 = 0.f, s1 = 0.f; for (int i = 0; i < 64; ++i) { s0 += lv[i] * lv[64 + i]; s1 += lv[128 + i] * lv[192 + i]; }
            const float lam_init = 0.8f - 0.6f * expf(-0.3f * 2.0f); misc[0] = expf(s0) - expf(s1) + lam_init; misc[1] = lam_init; }
        rms_phase(F, x_in, norm_mix, HN);
        PH_END(0)
#if EXTRA_BARS
    for (int xb_ = 0; xb_ < EXTRA_BARS; ++xb_) GRID_BAR();
#endif
    PH_BEGIN(1) pg8::EpiBf16 E_{BUFA, DM, BUFA, DM, nullptr, nullptr, nullptr}; PLAIN_GEMM(E_, HN, Wb + W_A_IN, 1024, 2048, 2048, 64, 4, 256 * DM, 256); PH_END(1)
    PH_BEGIN(2)
        for (int it = F.c * NWAVES * 64 + F.tid_(); it < MTOK * 128; it += F.G * NWAVES * 64) {
            const int g = __builtin_amdgcn_readfirstlane((it >> 6) & 3), cc = g * 32 + (it & 31), t = ((it >> 8) << 1) + ((it >> 5) & 1), s = t & (SEQ - 1);
            const bf16_t* base = BUFA + (size_t)(t - s) * DM + cc * 8;
            float a[8] = {0, 0, 0, 0, 0, 0, 0, 0};
#define POOL_WIN(HW) do { u32x4 w_[2 * (HW)]; \
                _Pragma("unroll") for (int i = 0; i < 2 * (HW); ++i) { int r = s - (HW) + i; r = r < 0 ? 0 : (r > SEQ - 1 ? SEQ - 1 : r); w_[i] = *(const u32x4*)(base + (size_t)r * DM); } \
                _Pragma("unroll") for (int i = 0; i < 2 * (HW); ++i) { const int r = s - (HW) + i; const float k_ = (r >= 0 && r < SEQ) ? 1.0f : 0.0f; \
                    a[0] += k_ * bf_lo(w_[i].x); a[1] += k_ * bf_hi(w_[i].x); a[2] += k_ * bf_lo(w_[i].y); a[3] += k_ * bf_hi(w_[i].y); \
                    a[4] += k_ * bf_lo(w_[i].z); a[5] += k_ * bf_hi(w_[i].z); a[6] += k_ * bf_lo(w_[i].w); a[7] += k_ * bf_hi(w_[i].w); } } while (0)
            if (g == 0) POOL_WIN(1); else if (g == 1) POOL_WIN(2); else if (g == 2) POOL_WIN(4); else POOL_WIN(8);
#undef POOL_WIN
            const int hw = 1 << g, lo_ = (s - hw) < 0 ? 0 : s - hw, hi_ = (s + hw) > SEQ ? SEQ : s + hw;
            const float ic = 1.0f / (float)(hi_ - lo_); const u32x4 w = *(const u32x4*)(base + (size_t)s * DM);
            u32x4 o; o.x = cvt_pk_bf16(a[0] * ic - bf_lo(w.x), a[1] * ic - bf_hi(w.x)); o.y = cvt_pk_bf16(a[2] * ic - bf_lo(w.y), a[3] * ic - bf_hi(w.y));
            o.z = cvt_pk_bf16(a[4] * ic - bf_lo(w.z), a[5] * ic - bf_hi(w.z)); o.w = cvt_pk_bf16(a[6] * ic - bf_lo(w.w), a[7] * ic - bf_hi(w.w));
            *(u32x4*)(BUFB + (size_t)t * DM + cc * 8) = o;
        }
        PH_END(2)
    PH_BEGIN(3)
        struct GrpSched { const char* A; const char* B; int G, c;
            __device__ __forceinline__ bool next(int i, pg8::Unit& u) const { const int L = i * G + c; if (L >= 256) return false; int pm, pn; pg8::tile_order(64, 4, L, pm, pn);
                u.A = A + (size_t)pm * 256 * 2048 + pn * 512; u.B = B + (size_t)pn * 65536 * 2; u.ldb = 512u; u.hsb = 128u * 512u; u.co = (size_t)pm * 256 * DM + pn * 256; u.tag = 0; return true; } };
        GrpSched S_{(const char*)BUFB, (const char*)(Wb + W_A_GRP), F.G, F.c}; pg8::EpiBf16 E_{BUFC, DM, BUFC, DM, nullptr, nullptr, nullptr};
        pg8::gemm_phase(ring, 256, 2048u, S_, E_); PH_END(3)
    PH_BEGIN(4) pg8::EpiResidT<true, true> E_{x_in, XA, PS}; PLAIN_GEMM(E_, BUFC, Wb + W_A_OUT, 1024, 2048, 2048, 64, 4, 256 * DM, 256); PH_END(4)
    DENSE_FFN(6, 0, XA, XB)
    PH_BEGIN(9)
        { QkvSched S_{(const char*)X8, (const char*)(Wb + W_B_QK), nullptr, 24, 0, 4, 2, F.G, F.c, 6144, 1024u};
          pg8::EpiBf16T<true, 10, 2> E_{BIG, 6144, VT, MTOK, PS, (const char*)X8, RTAB, F8_GU_UNSCALE}; pg8::gemm_phase<false, 1u>(ring, 512, 1024u, S_, E_); }
        { QkvSched S_{(const char*)XB, nullptr, (const char*)(Wb + W_B_V), 0, 3, 4, 2, F.G, F.c, 6144};
          pg8::EpiBf16T<true, 11, 2> E_{BIG, 6144, VT, MTOK, PS, (const char*)XB, RTAB}; pg8::gemm_phase(ring, 1024, 2048u, S_, E_); }
        PH_END(9)
    PH_BEGIN(10)
        LAS float* tbl = (LAS float*)(F.lds + BI_TAB + F.wave_() * 1280); LAS unsigned char* stgw = F.lds + F.wave_() * 16384;
        int lane10 = F.lane_(); asm volatile("" : "+v"(lane10));
        for (int i = 0; i < 6; ++i) {
            const int w = (i * F.G + F.vcu) * NWAVES + F.wave_(); if (w >= 3 * 4096) break;
            const int g = w >> 12, rest = w & 4095, b = rest >> 9, h = (rest >> 5) & 15, blk = rest & 31;
            const int dil = (g == 0) ? 1 : (g == 1 ? 4 : 16), L = SEQ / dil, nqb = L >> 6, r = blk / nqb, qb = blk % nqb;
            band_item64q<64>((const unsigned char*)BIG + g * 1024 + h * 64, (const unsigned char*)BIG + 3072 + g * 1024 + h * 64, 6144, (size_t)b * SEQ + r, dil, L, qb * 64,
                            (const unsigned char*)VT + (size_t)(g * 1024 + h * 64) * MTOK, (size_t)b * SEQ + (size_t)r * L, gtab + h * 4096, tbl, stgw, NEG_BIG, 0.f,
                            OG + (size_t)g * MTOK * DM + h * 64, DM, LSE + (size_t)g * MTOK * 16 + h, lane10);
        }
        PH_END(10)
    PH_BEGIN(11)
        { const int st_ = F.G * NWAVES * 64;
        for (int it0 = F.c * NWAVES * 64 + F.tid_(); it0 < MTOK * 128; it0 += 4 * st_) {
            u32x4 a[4], b[4], c[4]; float l0[4], l1[4], l2[4]; size_t of[4]; bool ok[4];
#pragma unroll
            for (int q = 0; q < 4; ++q) { const int it = it0 + q * st_; ok[q] = it < MTOK * 128; const int itc = ok[q] ? it : it0; const int t = itc >> 7, cc = itc & 127, h = cc >> 3;
                l0[q] = LSE[(size_t)t * 16 + h]; l1[q] = LSE[(size_t)(MTOK + t) * 16 + h]; l2[q] = LSE[(size_t)(2 * MTOK + t) * 16 + h];
                of[q] = (size_t)t * DM + cc * 8;
                a[q] = *(const u32x4*)(OG + of[q]); b[q] = *(const u32x4*)(OG + (size_t)MTOK * DM + of[q]); c[q] = *(const u32x4*)(OG + 2 * (size_t)MTOK * DM + of[q]); }
#pragma unroll
            for (int q = 0; q < 4; ++q) {
                const float mx = fmaxf(l0[q], fmaxf(l1[q], l2[q])); float w0 = __builtin_amdgcn_exp2f(l0[q] - mx), w1 = __builtin_amdgcn_exp2f(l1[q] - mx), w2 = __builtin_amdgcn_exp2f(l2[q] - mx);
                const float inv = 1.0f / (w0 + w1 + w2); w0 *= inv; w1 *= inv; w2 *= inv;
                u32x4 r;
                r.x = cvt_pk_bf16(w0 * bf_lo(a[q].x) + w1 * bf_lo(b[q].x) + w2 * bf_lo(c[q].x), w0 * bf_hi(a[q].x) + w1 * bf_hi(b[q].x) + w2 * bf_hi(c[q].x));
                r.y = cvt_pk_bf16(w0 * bf_lo(a[q].y) + w1 * bf_lo(b[q].y) + w2 * bf_lo(c[q].y), w0 * bf_hi(a[q].y) + w1 * bf_hi(b[q].y) + w2 * bf_hi(c[q].y));
                r.z = cvt_pk_bf16(w0 * bf_lo(a[q].z) + w1 * bf_lo(b[q].z) + w2 * bf_lo(c[q].z), w0 * bf_hi(a[q].z) + w1 * bf_hi(b[q].z) + w2 * bf_hi(c[q].z));
                r.w = cvt_pk_bf16(w0 * bf_lo(a[q].w) + w1 * bf_lo(b[q].w) + w2 * bf_lo(c[q].w), w0 * bf_hi(a[q].w) + w1 * bf_hi(b[q].w) + w2 * bf_hi(c[q].w));
                if (ok[q]) *(u32x4*)(BUFA + of[q]) = r; }
        } }
        PH_END(11)
    PH_BEGIN(12) pg8::EpiResid E_{XB, XA, nullptr}; PLAIN_GEMM(E_, BUFA, Wb + W_B_OUT, 1024, 2048, 2048, 64, 4, 256 * DM, 256); PH_END(12)
    MOE_FFN(13, 0, XA, norm_ffn + DM)
    PH_BEGIN(17) moe_reduce_parts(F, PART, panel, YS); GRID_BAR(); moe_combine(F, XA, YS, PART, panel, r_p1, r_p2, r_g1, r_g2, norm_mix + 2 * DM, XB, HN, nullptr); PH_END(17)
    PH_BEGIN(18)
        QkvSched S_{(const char*)HN, (const char*)(Wb + W_C_QK), (const char*)(Wb + W_C_V), 8, 1, 4, 0, F.G, F.c, 2048, 1024u};
        pg8::EpiBf16T<false, 11, 1> E_{BIG, 2048, VT, MTOK, nullptr, nullptr, nullptr, F8_GU_UNSCALE}; pg8::gemm_phase<false, 1u>(ring, 512, 1024u, S_, E_); PH_END(18)
    PH_BEGIN(19)
        int tid = F.tid_(); asm volatile("" : "+v"(tid)); const int lane = tid & 63, wv = F.wave_();
        const int j = wv & 1, sub = wv >> 1, ql = lane & 31, hf = lane >> 5, kp = keyperm(ql), half1 = wv >> 2;
        LAS float* tabL = (LAS float*)(F.lds + DA_TAB);
        LAS unsigned char* bidL = F.lds + DA_BID;
        LAS float* xch = (LAS float*)(F.lds + DA_XCH);
        const float lam = misc[0], post = 1.0f - misc[1];
        i32x8 ones8; { int o1_ = 0x38383838; asm volatile("" : "+v"(o1_));
#pragma unroll
            for (int q = 0; q < 8; ++q) ones8[q] = o1_; }
        for (int q = tid; q < 1024; q += NWAVES * 64) ((LAS unsigned*)bidL)[q] = ((const unsigned*)(ws + WS_BID))[q];
        unsigned ka[2], va[2];
#pragma unroll
        for (int t = 0; t < 2; ++t) { ka[t] = (unsigned)(kp * 64 + (((2 * hf + t) ^ ((kp >> 2) & 3)) << 4)); va[t] = (unsigned)(ql * 64 + (((2 * hf + t) ^ ((ql >> 2) & 3)) << 4)); }
        const int kr = 16 * (wv & 3) + (lane >> 2), kc = (lane & 3) ^ ((kr >> 2) & 3);
        const int vr = 16 * wv + (lane >> 2), vc = (lane & 3) ^ ((vr >> 2) & 3);
        const unsigned koff = (unsigned)((wv >> 2) * 64 + kr * 2048 + kc * 16), voff = (unsigned)vr * (unsigned)MTOK + (unsigned)(vc * 16);
#define pk8(a_, b_, c_, d_) ((unsigned)__builtin_amdgcn_cvt_pk_fp8_f32((c_), (d_), __builtin_amdgcn_cvt_pk_fp8_f32((a_), (b_), 0, false), true))
#define DA_GLDS(g, l) __builtin_amdgcn_global_load_lds((const unsigned*)(g), (LAS unsigned*)(l), 16, 0, 0)
#define DA_ISSUE(tile, stage) do { LAS unsigned char* sb_ = F.lds + DA_STG + (stage) * 32768 + wv * 1024; const size_t kt_ = (size_t)(tile) * 64; \
            DA_GLDS(K0g + kt_ * 2048 + koff, sb_); DA_GLDS(Vg + kt_ + voff, sb_ + 16384); } while (0)
#define DA_BAR() do { __builtin_amdgcn_s_barrier(); asm volatile("" ::: "memory"); } while (0)
#define DA_WAIT_TILE(more) do { if (more) asm volatile("s_waitcnt vmcnt(2) lgkmcnt(0)" ::: "memory"); else asm volatile("s_waitcnt vmcnt(0) lgkmcnt(0)" ::: "memory"); } while (0)
#define DA_WAIT_LDS() asm volatile("s_waitcnt lgkmcnt(0)" ::: "memory")
#define DA_SEG_A(t_, sg_) do { \
            const LAS unsigned char* Kt = F.lds + DA_STG + (sg_) * 32768 + j * 4096; \
            const int kt = (t_) * 64, rel_lo = kt - q0 - 31, rel_hi = kt + 63 - q0; \
            const i32x8 kfa = __builtin_shufflevector(*(const LAS i32x4*)(Kt + ka[0]), *(const LAS i32x4*)(Kt + ka[1]), 0, 1, 2, 3, 4, 5, 6, 7); \
            const i32x8 kfb = __builtin_shufflevector(*(const LAS i32x4*)(Kt + 2048 + ka[0]), *(const LAS i32x4*)(Kt + 2048 + ka[1]), 0, 1, 2, 3, 4, 5, 6, 7); \
            const bool cst = (rel_lo > 0 || rel_hi < 0) && (__builtin_amdgcn_readfirstlane((int)bidL[rel_lo + 2048]) == __builtin_amdgcn_readfirstlane((int)bidL[rel_hi + 2048])); \
            if (cst) { const float cu = tabL[j * 4096 + rel_lo + 2048]; \
                { const float c = cu - mhat; \
                  if (__any(c != c_last)) { c_last = c; \
                    _Pragma("unroll") for (int r = 0; r < 16; ++r) ci[r] = c; } } \
                asm volatile("s_waitcnt lgkmcnt(0)" ::: "memory"); \
                s0 = __builtin_amdgcn_mfma_scale_f32_32x32x64_f8f6f4(kfa, qf, ci, 0, 0, 0, 0, 0, 0); s1 = __builtin_amdgcn_mfma_scale_f32_32x32x64_f8f6f4(kfb, qf, ci, 0, 0, 0, 0, 0, 0); } \
            else { const LAS float* bt = tabL + j * 4096 + kt + 8 * hf - (q0 + ql) + 2048; \
                _Pragma("unroll") for (int r = 0; r < 16; ++r) { s0[r] = bt[(r >> 3) * 16 + (r & 7)] - mhat; s1[r] = bt[32 + (r >> 3) * 16 + (r & 7)] - mhat; } \
                asm volatile("s_waitcnt lgkmcnt(0)" ::: "memory"); \
                s0 = __builtin_amdgcn_mfma_scale_f32_32x32x64_f8f6f4(kfa, qf, s0, 0, 0, 0, 0, 0, 0); s1 = __builtin_amdgcn_mfma_scale_f32_32x32x64_f8f6f4(kfb, qf, s1, 0, 0, 0, 0, 0, 0); } \
            float mx = __builtin_fmaxf(s0[0], s1[0]), mx2 = __builtin_fmaxf(s0[1], s1[1]); \
            _Pragma("unroll") for (int r = 2; r < 16; r += 2) { mx = __builtin_fmaxf(__builtin_fmaxf(mx, s0[r]), s1[r]); mx2 = __builtin_fmaxf(__builtin_fmaxf(mx2, s0[r + 1]), s1[r + 1]); } \
            mx = __builtin_fmaxf(mx, mx2); \
            { const unsigned mu = __float_as_uint(mx); auto rr2 = __builtin_amdgcn_permlane32_swap(mu, mu, false, false); mx = fmaxf(__uint_as_float(rr2[0]), __uint_as_float(rr2[1])); } \
            if ((t_) == 0) { const float d0 = mx - 4.0f; mhat = d0; \
                _Pragma("unroll") for (int r = 0; r < 16; ++r) { s0[r] -= d0; s1[r] -= d0; } } \
            else if (__any(mx > 8.0f)) { const float dl = fmaxf(mx - 4.0f, 0.f), f = __builtin_amdgcn_exp2f(-dl); mhat += dl; o5 = o5 * f; \
                _Pragma("unroll") for (int r = 0; r < 16; ++r) { s0[r] -= dl; s1[r] -= dl; } \
                _Pragma("unroll") for (int bb = 0; bb < 4; ++bb) o[bb] = o[bb] * f; } \
        } while (0)
#define DA_SEG_B(sg_) do { \
            const LAS unsigned char* Vt_ = F.lds + DA_STG + (sg_) * 32768 + 16384; i32x8 vf8[4]; \
            _Pragma("unroll") for (int bb = 0; bb < 4; ++bb) { const i32x4 lo_ = *(const LAS i32x4*)(Vt_ + bb * 2048 + va[0]), hi_ = *(const LAS i32x4*)(Vt_ + bb * 2048 + va[1]); \
                vf8[bb] = __builtin_shufflevector(lo_, hi_, 0, 1, 2, 3, 4, 5, 6, 7); } \
            asm volatile("" ::: "memory"); \
            _Pragma("unroll") for (int r = 0; r < 16; ++r) { s0[r] = __builtin_amdgcn_exp2f(s0[r]); s1[r] = __builtin_amdgcn_exp2f(s1[r]); } \
            i32x8 p8; p8[0] = (int)pk8(s0[0], s0[1], s0[2], s0[3]); p8[1] = (int)pk8(s0[4], s0[5], s0[6], s0[7]); p8[2] = (int)pk8(s0[8], s0[9], s0[10], s0[11]); p8[3] = (int)pk8(s0[12], s0[13], s0[14], s0[15]); \
            p8[4] = (int)pk8(s1[0], s1[1], s1[2], s1[3]); p8[5] = (int)pk8(s1[4], s1[5], s1[6], s1[7]); p8[6] = (int)pk8(s1[8], s1[9], s1[10], s1[11]); p8[7] = (int)pk8(s1[12], s1[13], s1[14], s1[15]); \
            __builtin_amdgcn_s_setprio(1); \
            _Pragma("unroll") for (int bb = 0; bb < 4; ++bb) o[bb] = __builtin_amdgcn_mfma_scale_f32_32x32x64_f8f6f4(vf8[bb], p8, o[bb], 0, 0, 0, 0, 0, 0); \
            o5 = __builtin_amdgcn_mfma_scale_f32_32x32x64_f8f6f4(ones8, p8, o5, 0, 0, 0, 0, 0, 0);         \
            __builtin_amdgcn_s_setprio(0); \
        } while (0)
        int last_h = -1;
        for (int i = 0; i < 4; ++i) {
            const int u = i * F.G + F.vcu; if (u >= 1024) break;
            const int b = u >> 7, h = (u >> 4) & 7, qblk = u & 15;
            __syncthreads();
            if (h != last_h) { for (int q = tid; q < 2 * 4096; q += NWAVES * 64) tabL[q] = gtab[(2 * h) * 4096 + q]; last_h = h; }
            const size_t tok0 = (size_t)b * SEQ; const int q0 = qblk * 128 + sub * 32;
            const char* K0g = (const char*)BIG + tok0 * 2048 + 1024 + (2 * h) * 64;
            const char* Vg = (const char*)VT + (size_t)(h * 128) * MTOK + tok0;
            const size_t qtok = tok0 + q0 + ql;
            i32x8 qf; { const i32x4* qp_ = (const i32x4*)((const char*)BIG + qtok * 2048 + (2 * h + j) * 64 + 32 * hf); qf = __builtin_shufflevector(qp_[0], qp_[1], 0, 1, 2, 3, 4, 5, 6, 7); }
            DA_ISSUE(0, 0); DA_ISSUE(1, 1);
            f32x16 o[4];
#pragma unroll
            for (int bb = 0; bb < 4; ++bb) o[bb] = (f32x16){};
            float mhat = 0.f, c_last = __builtin_nanf("");
            f32x16 o5 = (f32x16){}, ci = (f32x16){};
            f32x16 s0, s1;
            DA_WAIT_TILE(true); DA_BAR();
            if (half1 == 0) {
                int sg = 0;
                for (int t = 0; t < 32; ++t) {
                    DA_SEG_A(t, sg); DA_WAIT_LDS(); DA_BAR();
                    if (t + 2 < 32) { const int s2 = (sg >= 1) ? sg - 1 : 2; DA_ISSUE(t + 2, s2); }
                    DA_SEG_B(sg); DA_WAIT_TILE(t + 2 < 32); DA_BAR();
                    sg = (sg == 2) ? 0 : sg + 1;
                }
                DA_BAR();
            } else {
                DA_BAR();
                int sg = 0;
                for (int t = 0; t < 32; ++t) {
                    if (t + 2 < 32) { const int s2 = (sg >= 1) ? sg - 1 : 2; DA_ISSUE(t + 2, s2); }
                    DA_SEG_A(t, sg); DA_WAIT_TILE(t + 2 < 32); DA_BAR();
                    DA_SEG_B(sg); DA_WAIT_LDS(); DA_BAR();
                    sg = (sg == 2) ? 0 : sg + 1;
                }
            }
            const float lt = o5[0], inv = (1.0f / ACT8_SCALE) / lt;
            __syncthreads();
            if (j == 1) {
#pragma unroll
                for (int bb = 0; bb < 4; ++bb)
#pragma unroll
                    for (int r = 0; r < 16; ++r) xch[(sub * 64 + bb * 16 + r) * 64 + lane] = o[bb][r] * inv;
            }
            __syncthreads();
            if (j == 0) {
                float ss = 0.f;
#pragma unroll
                for (int bb = 0; bb < 4; ++bb)
#pragma unroll
                    for (int r = 0; r < 16; ++r) { const float v = o[bb][r] * inv - lam * xch[(sub * 64 + bb * 16 + r) * 64 + lane]; o[bb][r] = v; ss += v * v; }
                ss += __shfl_xor(ss, 32);
                const float rstd = post / sqrtf(ss * (1.0f / 128.0f) + RMS_EPS);
                const float* sg_ = args.in[13];
                unsigned char* orow = (unsigned char*)BUFA + qtok * DM + h * 128;
                const float rs8 = rstd * ACT8_SCALE;
#pragma unroll
                for (int bb = 0; bb < 4; ++bb)
#pragma unroll
                    for (int i4 = 0; i4 < 4; ++i4) { const int d = 32 * bb + 8 * i4 + 4 * hf; const f32x4 gg = *(const f32x4*)(sg_ + d);
                        *(unsigned*)(orow + d) = pg8::pack_fp8x4(o[bb][4 * i4] * gg.x, o[bb][4 * i4 + 1] * gg.y, o[bb][4 * i4 + 2] * gg.z, o[bb][4 * i4 + 3] * gg.w, rs8); }
            }
        }
#undef DA_GLDS
#undef DA_ISSUE
#undef DA_BAR
#undef DA_WAIT_TILE
#undef DA_WAIT_LDS
#undef DA_SEG_A
#undef DA_SEG_B
        PH_END(19)
    PH_BEGIN(20) pg8::EpiResidT<false, true, 3> E_{XB, XA, PS, X8}; PlainSched S_{(const char*)BUFA, (const char*)(Wb + W_C_OUT), 1024u, 1024u, 64, 4, F.G, F.c, (size_t)256 * DM, (size_t)256}; pg8::gemm_phase<false, 1u>(ring, 512, 1024u, S_, E_); PH_END(20)
    DENSE_FFN8(22, 1, XA, XB)
    PH_BEGIN(25)
        QkvSched S_{(const char*)X8, (const char*)(Wb + W_D_QK), (const char*)(Wb + W_D_V), 5, 1, 1, 0, F.G, F.c, 1280, 1024u};
        pg8::EpiBf16T<true, 10, 2> E_{BIG, 1280, VT, MTOK, PS, (const char*)X8, RTAB, F8_GU_UNSCALE}; pg8::gemm_phase<false, 1u>(ring, 512, 1024u, S_, E_); PH_END(25)
    PH_BEGIN(26)
        LAS float* tbl = (LAS float*)(F.lds + BI_TAB + F.wave_() * 1280); LAS unsigned char* stgw = F.lds + F.wave_() * 16384;
        const float* sink = args.in[16];
        int lane26 = F.lane_(); asm volatile("" : "+v"(lane26));
        for (int i = 0; i < 2; ++i) {
            const int w = (i * F.G + F.vcu) * NWAVES + F.wave_(); if (w >= 4096) break;
            const int b = w >> 9, kvh = (w >> 7) & 3, qb = (w >> 2) & 31, qh = kvh * 4 + (w & 3);
            band_item64q<128, true>((const unsigned char*)BIG + qh * 64, (const unsigned char*)BIG + 1024 + kvh * 64, 1280, (size_t)b * SEQ, 1, SEQ, qb * 64,
                             (const unsigned char*)VT + (size_t)(kvh * 64) * MTOK, (size_t)b * SEQ, gtab + qh * 4096, tbl, stgw, sink[qh] * LOG2E, 1.0f,
                             (bf16_t*)((unsigned char*)BUFA + qh * 64), DM, nullptr, lane26);
        }
        PH_END(26)
    PH_BEGIN(27) pg8::EpiResidT<false, false, 2> E_{XB, XA, nullptr, nullptr}; PlainSched S_{(const char*)BUFA, (const char*)(Wb + W_D_OUT), 1024u, 1024u, 64, 4, F.G, F.c, (size_t)256 * DM, (size_t)256}; pg8::gemm_phase<false, 1u>(ring, 512, 1024u, S_, E_); PH_END(27)
    MOE_FFN(28, 1, XA, norm_ffn + 3 * DM)
    PH_BEGIN(32) moe_reduce_parts(F, PART, panel, YS); GRID_BAR(); moe_combine(F, XA, YS, PART, panel, r_p1, r_p2, r_g1, r_g2, norm_final, nullptr, nullptr, args.out); } }
#undef IN
#undef SEAM
}
constexpr int N_PHASES = 33;

extern "C" void kernel_launch(void* const* d_in, const int* in_sizes, int n_in, void* d_out, int out_size, void* d_ws, size_t ws_size, hipStream_t stream) {
    static int grid = 0;
    if (grid == 0) {
        if (n_in != 23 || out_size != MTOK * DM || ws_size < WS_END) { fprintf(stderr, "kernel_launch: unexpected problem (n_in %d, out %d, ws %zu, need %zu)\n", n_in, out_size, ws_size, (size_t)WS_END); grid = -1; return; }
        int dev = 0, cus = 0, per_cu = 0;
        if (hipGetDevice(&dev) != hipSuccess || hipDeviceGetAttribute(&cus, hipDeviceAttributeMultiprocessorCount, dev) != hipSuccess) { grid = -1; return; }
        if (hipFuncSetAttribute((const void*)enc_fwd, hipFuncAttributeMaxDynamicSharedMemorySize, LDS_BYTES) != hipSuccess) { fprintf(stderr, "kernel_launch: hipFuncSetAttribute failed\n"); grid = -1; return; }
        if (hipOccupancyMaxActiveBlocksPerMultiprocessor(&per_cu, (const void*)enc_fwd, NWAVES * 64, LDS_BYTES) != hipSuccess || per_cu < 1)
            fprintf(stderr, "kernel_launch: occupancy query reports %d workgroups per CU\n", per_cu);
        (void)hipGetLastError();
        grid = cus;
    }
    if (grid < 0) return;
    if (hipMemsetAsync((char*)d_ws + WS_CTL, 0, CTL_ZERO_BYTES, stream) != hipSuccess) return;
    Args a{};
    for (int i = 0; i < 23; ++i) a.in[i] = (const float*)d_in[i];
    a.out = (float*)d_out; a.ws = (unsigned char*)d_ws;
#if MK_MULTI
    for (int p = 0; p < N_PHASES; ++p) { a.ph_lo = p; a.ph_hi = p + 1; hipLaunchKernelGGL(enc_fwd, dim3(grid), dim3(NWAVES * 64), LDS_BYTES, stream, a); }
#else
    a.ph_lo = 0; a.ph_hi = N_PHASES;
    hipLaunchKernelGGL(enc_fwd, dim3(grid), dim3(NWAVES * 64), LDS_BYTES, stream, a);
#endif
}
```

```cpp
#include <hip/hip_runtime.h>
#include <cstdio>
#include <cstdint>

#ifndef PROBE_MASK
#define PROBE_MASK 0ull
#endif
#ifndef PROBE_N
#define PROBE_N 2
#endif
#ifndef SLOW_MASK
#define SLOW_MASK 0ull
#endif
#ifndef MOE_SPLIT
#define MOE_SPLIT 1
#endif
#ifndef EXTRA_BARS
#define EXTRA_BARS 0
#endif
#ifndef EPI_TWICE
#define EPI_TWICE 0
#endif
#ifndef GEMM_STAGGER
#define GEMM_STAGGER 0
#endif
#ifndef MK_MULTI
#define MK_MULTI 0
#endif

#define LAS __attribute__((address_space(3)))
#define GAS __attribute__((address_space(1)))
typedef unsigned short bf16_t;
typedef short bf16x8 __attribute__((ext_vector_type(8)));
typedef float f32x4 __attribute__((ext_vector_type(4)));
typedef float f32x16 __attribute__((ext_vector_type(16)));
typedef unsigned u32x4 __attribute__((ext_vector_type(4)));
typedef unsigned u32x2 __attribute__((ext_vector_type(2)));
typedef int i32x4 __attribute__((ext_vector_type(4)));
typedef int i32x8 __attribute__((ext_vector_type(8)));

constexpr int NB = 8, SEQ = 2048, DM = 1024, MTOK = NB * SEQ, DFF = 3584, NE = 8;
constexpr int MP_MAX = 2 * MTOK + NE * 256;
constexpr int NPANEL_MAX = MP_MAX / 256;
constexpr float RMS_EPS = 1e-6f;
constexpr float LOG2E = 1.4426950408889634f;
#define DENSE_F8(l) ((l) == 1)
constexpr float ACT8_SCALE = 8.0f;
constexpr unsigned F8_GU = 1u, F8_DN = 1u;
constexpr float F8_GU_UNSCALE = 1.0f / 256.0f, F8_DN_UNSCALE = 1.0f / 1024.0f;
constexpr float QSCALE = 0.125f * LOG2E;
constexpr float NEG_BIG = -1e30f;
constexpr int NWAVES = 8;

constexpr size_t MiB = 1ull << 20;
constexpr size_t WS_CTL = 0, CTL_ZERO_BYTES = 1 * MiB;
constexpr size_t WS_TAB = 1 * MiB;
constexpr size_t WS_MISC = WS_TAB + 256 * 1024;
constexpr size_t WS_BID = WS_MISC + 4096;
constexpr size_t WS_ROUTE = 2 * MiB;
constexpr size_t WS_PS = WS_ROUTE + 1 * MiB;
constexpr size_t WS_CNT = WS_ROUTE + 384 * 1024;
constexpr size_t WS_PANEL = WS_ROUTE + 448 * 1024;
constexpr size_t WS_W = 4 * MiB;
constexpr size_t W_A_IN = 0, W_A_GRP = W_A_IN + 1048576, W_A_OUT = W_A_GRP + 262144, W_B_QK = W_A_OUT + 1048576, W_B_V = W_B_QK + 6144 * 1024,
                 W_B_OUT = W_B_V + 3072 * 1024, W_C_QK = W_B_OUT + 1048576, W_C_V = W_C_QK + 2048 * 1024, W_C_OUT = W_C_V + 1048576,
                 W_D_QK = W_C_OUT + 1048576, W_D_V = W_D_QK + 1280 * 1024, W_D_OUT = W_D_V + 256 * 1024, W_F_GU = W_D_OUT + 1048576,
                 W_F_D = W_F_GU + 2 * 7168 * 1024, W_M_GU = W_F_D + 2 * 3584 * 1024, W_M_D = W_M_GU + 16ull * 7168 * 1024, W_END = W_M_D + 16ull * 3584 * 1024;
constexpr size_t WS_XA = WS_W + ((W_END * 2 + MiB - 1) / MiB) * MiB;
constexpr size_t WS_XB = WS_XA + 64 * MiB;
constexpr size_t WS_HN = WS_XB + 64 * MiB;
constexpr size_t WS_BUFA = WS_HN + 32 * MiB;
constexpr size_t WS_BUFB = WS_BUFA + 32 * MiB;
constexpr size_t WS_BUFC = WS_BUFB + 32 * MiB;
constexpr size_t WS_BIG = WS_BUFC + 32 * MiB;
constexpr size_t WS_VT = WS_BIG + 240 * MiB;
constexpr size_t WS_OG = WS_VT + 96 * MiB;
constexpr size_t WS_LSE = WS_OG + 96 * MiB;
constexpr size_t WS_PART = WS_LSE + 4 * MiB;
constexpr size_t WS_END = WS_PART + 64 * MiB;
constexpr int CW_BAR = 4096;
constexpr int RING_BYTES = 131072, LDSCTL_OFF = RING_BYTES, MISC_OFF = LDSCTL_OFF + 320, LDS_BYTES = 147456;
constexpr int BI_TAB = RING_BYTES + 1024;
constexpr int DA_TAB = 0, DA_STG = 32768, DA_XCH = 32768, DA_BID = RING_BYTES + 1024;

__device__ __forceinline__ unsigned cvt_pk_bf16(float lo, float hi) { unsigned r; asm volatile("v_cvt_pk_bf16_f32 %0, %1, %2" : "=v"(r) : "v"(lo), "v"(hi)); return r; }
__device__ __forceinline__ float bf_lo(unsigned w) { return __uint_as_float(w << 16); }
__device__ __forceinline__ float bf_hi(unsigned w) { return __uint_as_float(w & 0xffff0000u); }
__device__ __forceinline__ float wave_sum(float v) {
#pragma unroll
    for (int o = 1; o < 64; o <<= 1) v += __shfl_xor(v, o);
    return v;
}
#define LDS_WAIT() asm volatile("s_waitcnt lgkmcnt(0)" ::: "memory")
#define VM_WAIT() asm volatile("s_waitcnt vmcnt(0)" ::: "memory")

namespace pg8 {
constexpr int BM = 256, BK = 64, HALF = 128, HTB = HALF * BK * 2, STAGE_BYTES = 8 * HTB, NXCD = 8, WGM = 8;
__host__ __device__ __forceinline__ int lds_byte(int r, int c) { const int st = (r >> 4) * 2 + (c >> 5), rr = r & 15, cc = c & 31, ob = rr * 64 + cc * 2; return st * 1024 + (ob ^ (((ob >> 9) & 1) << 5)); }
__host__ __device__ __forceinline__ void stage_rc(int b, int& R, int& C) { const int st = b / 1024, sb = b % 1024, swz = sb ^ (((sb >> 9) & 1) << 5); R = (st >> 1) * 16 + swz / 64; C = (st & 1) * 32 + (swz % 64) / 2; }
__host__ __device__ __forceinline__ int perm32(int rho) { const int n = rho >> 4, i = rho & 15; return 8 * (i >> 2) + 4 * n + (i & 3); }

struct Unit { const char* A; const char* B; unsigned ldb, hsb; size_t co; int tag; const int* ridx; int par; };

__device__ __forceinline__ void tile_order(int nM, int nN, int L, int& pm, int& pn) {
    const int nwg = nM * nN; int wgid = L;
    { const int q = nwg / NXCD, r = nwg % NXCD, xcd = wgid % NXCD, off = wgid / NXCD; wgid = (xcd < r ? xcd * (q + 1) : r * (q + 1) + (xcd - r) * q) + off; }
    const int nig = WGM * nN, gid = wgid / nig, fm = gid * WGM, gsz = (nM - fm) < WGM ? (nM - fm) : WGM;
    pm = fm + ((wgid % nig) % gsz); pn = (wgid % nig) / gsz;
}

__device__ __forceinline__ i32x8 cat8(bf16x8 a, bf16x8 b) { const i32x4 x = __builtin_bit_cast(i32x4, a), y = __builtin_bit_cast(i32x4, b); return __builtin_shufflevector(x, y, 0, 1, 2, 3, 4, 5, 6, 7); }
__device__ __forceinline__ void mfma_f8(f32x4& c, const i32x8 a, const i32x8 b) { asm volatile("v_mfma_f32_16x16x128_f8f6f4 %0, %1, %2, %0" : "+v"(c) : "v"(a), "v"(b)); }
__device__ __forceinline__ unsigned pack_fp8x4(float a, float b, float c, float d, float sc) {
    const float ta = __builtin_amdgcn_fmed3f(a * sc, -448.f, 448.f), tb = __builtin_amdgcn_fmed3f(b * sc, -448.f, 448.f);
    const float tc = __builtin_amdgcn_fmed3f(c * sc, -448.f, 448.f), td = __builtin_amdgcn_fmed3f(d * sc, -448.f, 448.f);
    int w = __builtin_amdgcn_cvt_pk_fp8_f32(ta, tb, 0, false); w = __builtin_amdgcn_cvt_pk_fp8_f32(tc, td, w, true); return (unsigned)w;
}
__device__ __forceinline__ void zero_acc(f32x4 (&acc)[2][2][4][2]) {
#pragma unroll
    for (int a = 0; a < 2; ++a)
#pragma unroll
        for (int b = 0; b < 2; ++b)
#pragma unroll
            for (int m = 0; m < 4; ++m)
#pragma unroll
                for (int n = 0; n < 2; ++n) acc[a][b][m][n] = (f32x4){0.f, 0.f, 0.f, 0.f};
}
__device__ __forceinline__ float rstd_of(const float* ps16, size_t token) {
    const f32x4* p = (const f32x4*)(ps16 + token * 16); const f32x4 a = p[0], b = p[1], c = p[2], d = p[3];
    const float s = (((a.x + a.y) + (a.z + a.w)) + ((b.x + b.y) + (b.z + b.w))) + (((c.x + c.y) + (c.z + c.w)) + ((d.x + d.y) + (d.z + d.w)));
    return __builtin_amdgcn_rsqf(s * (1.0f / DM) + RMS_EPS);
}
template <bool RS, int XSH = 11, int O8 = 0> struct EpiBf16T {
    static constexpr bool PERM = true; static constexpr bool VPERM = (O8 == 1);
    bf16_t* out0; int ld0; bf16_t* out1; int ld1; const float* __restrict__ ps; const char* xbase; LAS float* rtab; float osc = 1.0f;
    __device__ __forceinline__ void unit_begin(Unit& u, size_t& key, int& par) const {
        if constexpr (RS) { const size_t k = u.tag ? ((size_t)u.B ^ ((size_t)u.ldb << 44) ^ 1u) : (size_t)u.A;
            if (k != key) { key = k; par ^= 1; const int t = threadIdx.x; if (t < 256) { size_t tok;
                if (u.tag) tok = ((size_t)(u.B - xbase) >> XSH) + (size_t)(t >> 7) * (u.hsb >> XSH) + (size_t)(t & 127) * (u.ldb >> XSH); else tok = ((size_t)(u.A - xbase) >> XSH) + t;
                rtab[par * 256 + t] = rstd_of(ps, tok) * osc; } }
            u.par = par; }
    }
    __device__ __forceinline__ void init(f32x4 (&acc)[2][2][4][2], const Unit&, int, int, int, int) const { zero_acc(acc); }
    __device__ __forceinline__ void operator()(const f32x4 (&acc)[2][2][4][2], const Unit& u, int wr, int wc, int fr, int fq) const {
        bf16_t* base = (u.tag ? out1 : out0) + u.co; const int ldc = u.tag ? ld1 : ld0;
        int r0 = wr * 64 + fr; asm volatile("" : "+v"(r0));
        const LAS float* tb = rtab + u.par * 256;
#pragma unroll
        for (int ai = 0; ai < 2; ++ai)
#pragma unroll
            for (int m = 0; m < 4; ++m) { bf16_t* rowp = base + (unsigned)((ai * HALF + m * 16 + r0) * ldc + wc * 32 + 8 * fq);
#pragma unroll
                for (int bj = 0; bj < 2; ++bj) { f32x4 v0 = acc[ai][bj][m][0], v1 = acc[ai][bj][m][1];
                    if constexpr (!RS) { v0 = v0 * osc; v1 = v1 * osc; }
                    if constexpr (RS) { if (u.tag) { const f32x4 c0 = *(const LAS f32x4*)(tb + bj * HALF + wc * 32 + 8 * fq), c1 = *(const LAS f32x4*)(tb + bj * HALF + wc * 32 + 8 * fq + 4); v0 = v0 * c0; v1 = v1 * c1; }
                                        else { const float rs = tb[ai * HALF + m * 16 + r0]; v0 = v0 * rs; v1 = v1 * rs; } }
                    if constexpr (O8 != 0) { unsigned char* bp = (unsigned char*)(u.tag ? out1 : out0) + u.co + (unsigned)((ai * HALF + m * 16 + r0) * (u.tag ? ld1 : ld0) + wc * 32 + 8 * fq) + bj * HALF; const float sc8 = u.tag ? ACT8_SCALE : 1.0f;
                        u32x2 q; q.x = pack_fp8x4(v0[0], v0[1], v0[2], v0[3], sc8); q.y = pack_fp8x4(v1[0], v1[1], v1[2], v1[3], sc8); *(u32x2*)bp = q; continue; }
                    u32x4 w; w.x = cvt_pk_bf16(v0[0], v0[1]); w.y = cvt_pk_bf16(v0[2], v0[3]); w.z = cvt_pk_bf16(v1[0], v1[1]); w.w = cvt_pk_bf16(v1[2], v1[3]);
                    *(u32x4*)(rowp + bj * HALF) = w; } }
    }
};
typedef EpiBf16T<false> EpiBf16;
struct EpiYs8 {
    static constexpr bool PERM = true; static constexpr bool VPERM = false;
    bf16_t* out;
    __device__ __forceinline__ void unit_begin(Unit&, size_t&, int&) const {}
    __device__ __forceinline__ void init(f32x4 (&acc)[2][2][4][2], const Unit&, int, int, int, int) const { zero_acc(acc); }
    __device__ __forceinline__ void operator()(const f32x4 (&acc)[2][2][4][2], const Unit& u, int wr, int wc, int fr, int fq) const {
        bf16_t* base = out + u.co;
        int r0 = wr * 64 + fr; asm volatile("" : "+v"(r0));
#pragma unroll
        for (int ai = 0; ai < 2; ++ai)
#pragma unroll
            for (int m = 0; m < 4; ++m) { bf16_t* rowp = base + (unsigned)((ai * HALF + m * 16 + r0) * DM + wc * 32 + 8 * fq);
#pragma unroll
                for (int bj = 0; bj < 2; ++bj) { const f32x4 v0 = acc[ai][bj][m][0] * F8_DN_UNSCALE, v1 = acc[ai][bj][m][1] * F8_DN_UNSCALE;
                    u32x4 w; w.x = cvt_pk_bf16(v0[0], v0[1]); w.y = cvt_pk_bf16(v0[2], v0[3]); w.z = cvt_pk_bf16(v1[0], v1[1]); w.w = cvt_pk_bf16(v1[2], v1[3]);
                    *(u32x4*)(rowp + bj * HALF) = w; } }
    }
};
template <bool RS> struct EpiSwigluT {
    static constexpr bool PERM = true; static constexpr bool VPERM = false;
    bf16_t* out; int ldc; const float* __restrict__ ps; const char* xbase; LAS float* rtab;
    __device__ __forceinline__ void unit_begin(Unit& u, size_t& key, int& par) const {
        if constexpr (RS) { const size_t k = (size_t)u.A;
            if (k != key) { key = k; par ^= 1; const int t = threadIdx.x; if (t < 256) rtab[par * 256 + t] = rstd_of(ps, ((size_t)(u.A - xbase) >> 11) + t); }
            u.par = par; }
    }
    __device__ __forceinline__ void init(f32x4 (&acc)[2][2][4][2], const Unit&, int, int, int, int) const { zero_acc(acc); }
    __device__ __forceinline__ void operator()(const f32x4 (&acc)[2][2][4][2], const Unit& u, int wr, int wc, int fr, int fq) const {
        bf16_t* base = out + u.co;
        int r0 = wr * 64 + fr; asm volatile("" : "+v"(r0));
#pragma unroll
        for (int ai = 0; ai < 2; ++ai)
#pragma unroll
            for (int m = 0; m < 4; ++m) { bf16_t* rowp = base + (unsigned)((ai * HALF + m * 16 + r0) * ldc + wc * 32 + 8 * fq);
                float rs = 1.0f; if constexpr (RS) rs = rtab[u.par * 256 + ai * HALF + m * 16 + r0];
                float r[8];
                const float c2 = -rs * LOG2E, iK = RS ? __builtin_amdgcn_rcpf(rs * rs) : 1.0f;
#pragma unroll
                for (int n = 0; n < 2; ++n)
#pragma unroll
                    for (int j = 0; j < 4; ++j) { const float G = acc[ai][0][m][n][j], U = acc[ai][1][m][n][j];
                        r[n * 4 + j] = (G * U) * __builtin_amdgcn_rcpf(__builtin_fmaf(__builtin_amdgcn_exp2f(G * c2), iK, iK)); }
                u32x4 w; w.x = cvt_pk_bf16(r[0], r[1]); w.y = cvt_pk_bf16(r[2], r[3]); w.z = cvt_pk_bf16(r[4], r[5]); w.w = cvt_pk_bf16(r[6], r[7]);
                *(u32x4*)rowp = w; }
    }
};
typedef EpiSwigluT<false> EpiSwiglu;
template <bool RS> struct EpiSwiglu8T {
    static constexpr bool PERM = true; static constexpr bool VPERM = false;
    unsigned char* out; int ldc; const float* __restrict__ ps; const char* xbase; LAS float* rtab;
    __device__ __forceinline__ void unit_begin(Unit& u, size_t& key, int& par) const {
        if constexpr (RS) { const size_t k = (size_t)u.A;
            if (k != key) { key = k; par ^= 1; const int t = threadIdx.x; if (t < 256) rtab[par * 256 + t] = rstd_of(ps, ((size_t)(u.A - xbase) >> 10) + t); }
            u.par = par; }
    }
    __device__ __forceinline__ void init(f32x4 (&acc)[2][2][4][2], const Unit&, int, int, int, int) const { zero_acc(acc); }
    __device__ __forceinline__ void operator()(const f32x4 (&acc)[2][2][4][2], const Unit& u, int wr, int wc, int fr, int fq) const {
        unsigned char* base = out + u.co;
        int r0 = wr * 64 + fr; asm volatile("" : "+v"(r0));
#pragma unroll
        for (int ai = 0; ai < 2; ++ai)
#pragma unroll
            for (int m = 0; m < 4; ++m) { unsigned char* rowp = base + (unsigned)((ai * HALF + m * 16 + r0) * ldc + wc * 32 + 8 * fq);
                float rs = F8_GU_UNSCALE; if constexpr (RS) rs *= rtab[u.par * 256 + ai * HALF + m * 16 + r0];
                const float c2 = -rs * LOG2E, iK = RS ? __builtin_amdgcn_rcpf(ACT8_SCALE * rs * rs) : 1.0f / (ACT8_SCALE * F8_GU_UNSCALE * F8_GU_UNSCALE);
                float r[8];
#pragma unroll
                for (int n = 0; n < 2; ++n)
#pragma unroll
                    for (int j = 0; j < 4; ++j) { const float G = acc[ai][0][m][n][j], U = acc[ai][1][m][n][j];
                        r[n * 4 + j] = (G * U) * __builtin_amdgcn_rcpf(__builtin_fmaf(__builtin_amdgcn_exp2f(G * c2), iK, iK)); }
                u32x2 w; w.x = pack_fp8x4(r[0], r[1], r[2], r[3], 1.0f); w.y = pack_fp8x4(r[4], r[5], r[6], r[7], 1.0f);
                *(u32x2*)rowp = w; }
    }
};
typedef EpiSwiglu8T<false> EpiSwiglu8;
template <bool F32IN, bool NORM = false, int MODE = 0> struct EpiResidT {
    static constexpr bool PERM = true; static constexpr bool VPERM = false;
    const void* __restrict__ resid; bf16_t* __restrict__ out; float* __restrict__ ps; unsigned char* __restrict__ x8;
    __device__ __forceinline__ void unit_begin(Unit&, size_t&, int&) const {}
    __device__ __forceinline__ void init(f32x4 (&acc)[2][2][4][2], const Unit& u, int wr, int wc, int fr, int fq) const {
        int r0 = wr * 64 + fr; asm volatile("" : "+v"(r0));
#pragma unroll
        for (int ai = 0; ai < 2; ++ai)
#pragma unroll
            for (int m = 0; m < 4; ++m) { const size_t off = u.co + (unsigned)((ai * HALF + m * 16 + r0) * DM + wc * 32 + 8 * fq);
#pragma unroll
                for (int bj = 0; bj < 2; ++bj) {
                    if constexpr (F32IN) { const float* p = (const float*)resid + off + bj * HALF; acc[ai][bj][m][0] = *(const f32x4*)p; acc[ai][bj][m][1] = *(const f32x4*)(p + 4); }
                    else { const u32x4 w = *(const u32x4*)((const bf16_t*)resid + off + bj * HALF);
                        acc[ai][bj][m][0] = (f32x4){bf_lo(w.x), bf_hi(w.x), bf_lo(w.y), bf_hi(w.y)}; acc[ai][bj][m][1] = (f32x4){bf_lo(w.z), bf_hi(w.z), bf_lo(w.w), bf_hi(w.w)}; }
                    if constexpr ((MODE & 2) != 0) { acc[ai][bj][m][0] = acc[ai][bj][m][0] * (1.0f / F8_DN_UNSCALE); acc[ai][bj][m][1] = acc[ai][bj][m][1] * (1.0f / F8_DN_UNSCALE); } } }
    }
    __device__ __forceinline__ void operator()(const f32x4 (&acc)[2][2][4][2], const Unit& u, int wr, int wc, int fr, int fq) const {
        int r0 = wr * 64 + fr; asm volatile("" : "+v"(r0));
#pragma unroll
        for (int ai = 0; ai < 2; ++ai)
#pragma unroll
            for (int m = 0; m < 4; ++m) { const size_t off = u.co + (unsigned)((ai * HALF + m * 16 + r0) * DM + wc * 32 + 8 * fq);
                float ss = 0.f;
#pragma unroll
                for (int bj = 0; bj < 2; ++bj) { f32x4 v0 = acc[ai][bj][m][0], v1 = acc[ai][bj][m][1];
                    if constexpr ((MODE & 2) != 0) { v0 = v0 * F8_DN_UNSCALE; v1 = v1 * F8_DN_UNSCALE; }
                    u32x4 w; w.x = cvt_pk_bf16(v0[0], v0[1]); w.y = cvt_pk_bf16(v0[2], v0[3]); w.z = cvt_pk_bf16(v1[0], v1[1]); w.w = cvt_pk_bf16(v1[2], v1[3]);
                    *(u32x4*)(out + off + bj * HALF) = w;
                    if constexpr ((MODE & 1) != 0) { u32x2 q; q.x = pack_fp8x4(v0[0], v0[1], v0[2], v0[3], 1.0f); q.y = pack_fp8x4(v1[0], v1[1], v1[2], v1[3], 1.0f); *(u32x2*)(x8 + off + bj * HALF) = q; }
                    if constexpr (NORM) ss += ((v0[0] * v0[0] + v0[1] * v0[1]) + (v0[2] * v0[2] + v0[3] * v0[3])) + ((v1[0] * v1[0] + v1[1] * v1[1]) + (v1[2] * v1[2] + v1[3] * v1[3])); }
                if constexpr (NORM) { ss += __shfl_xor(ss, 16); ss += __shfl_xor(ss, 32); if (fq == 0) ps[(off >> 10) * 16 + ((u.co >> 8) & 3) * 4 + wc] = ss; } }
    }
};
typedef EpiResidT<false> EpiResid;

struct EpiPart {
    static constexpr bool PERM = false; static constexpr bool VPERM = false;
    float* out; float sc;
    __device__ __forceinline__ void unit_begin(Unit&, size_t&, int&) const {}
    __device__ __forceinline__ void init(f32x4 (&acc)[2][2][4][2], const Unit&, int, int, int, int) const { zero_acc(acc); }
    __device__ __forceinline__ void operator()(const f32x4 (&acc)[2][2][4][2], const Unit& u, int wr, int wc, int fr, int fq) const {
        int r0 = wr * 64 + fr; asm volatile("" : "+v"(r0));
#pragma unroll
        for (int ai = 0; ai < 2; ++ai)
#pragma unroll
            for (int m = 0; m < 4; ++m) { const size_t off = u.co + (unsigned)((ai * HALF + m * 16 + r0) * 256 + wc * 32 + 4 * fq);
#pragma unroll
                for (int bj = 0; bj < 2; ++bj)
#pragma unroll
                    for (int n = 0; n < 2; ++n) *(f32x4*)(out + off + bj * HALF + n * 16) = acc[ai][bj][m][n] * sc; }
    }
};

__device__ __forceinline__ int vperm64(int p) { return ((p >> 4) & 1) * 32 + ((p >> 3) & 1) * 16 + (p & 7) + ((p >> 5) & 1) * 8; }
template <bool GATHER = false, unsigned F8S = 0u, class Epi, class Sched>
__device__ __forceinline__ void gemm_phase(LAS unsigned char* lds, const int K, const unsigned lda, const Sched& S, const Epi& E) {
    const int tid = threadIdx.x, wid = __builtin_amdgcn_readfirstlane(tid >> 6), lane = tid & 63, wr = wid >> 2, wc = wid & 3, fr = lane & 15, fq = lane >> 4;
    int nt = K / BK; asm volatile("" : "+s"(nt));
    unsigned voffA[2], voffB[2], voffA1[2], nvA0[2], nvA1[2];
#pragma unroll
    for (int i = 0; i < 2; ++i) { int R, C; stage_rc(tid * 16 + i * 8192, R, C); const int Rb = Epi::PERM ? ((R & ~31) + perm32(R & 31)) : R;
        voffA[i] = (unsigned)R * lda + (unsigned)C * 2u; voffA1[i] = 0u; nvA0[i] = 0u; nvA1[i] = 0u; (void)Rb; }
    const size_t kstep = (size_t)(BK * 2);
    const size_t hstepA = GATHER ? (size_t)0 : (size_t)HALF * lda;
#define PG8_VA1 (GATHER ? voffA1 : voffA)
#define PG8_GIDX(u, d0, d1) do { _Pragma("unroll") for (int _i = 0; _i < 2; ++_i) { int R_, C_; stage_rc((int)(threadIdx.x) * 16 + _i * 8192, R_, C_); \
        d0[_i] = (unsigned)(u).ridx[R_] * lda + (unsigned)C_ * 2u; d1[_i] = (unsigned)(u).ridx[HALF + R_] * lda + (unsigned)C_ * 2u; } } while (0)
    const unsigned ldsw = (unsigned)wid * 1024u;
    const int aoff = lds_byte(wr * 64 + fr, fq * 8), boff = lds_byte(wc * 32 + fr, fq * 8);
#define PG8_SA(b, h) (((b) * 2 + (h)) * HTB)
#define PG8_SB(b, h) ((4 + (b) * 2 + (h)) * HTB)
#define PG8_STAGE(bufoff, gbase, voff) do { const char* g_ = (const char*)(gbase); asm volatile("" : "+s"(g_)); _Pragma("unroll") for (int _i = 0; _i < 2; ++_i) { unsigned vo_ = (voff)[_i]; asm volatile("" : "+v"(vo_)); \
        __builtin_amdgcn_global_load_lds((const unsigned*)(g_ + vo_), (LAS unsigned*)(lds + (bufoff) + ldsw + _i * 8192), 16, 0, 0); } } while (0)
#define PG8_LDA(dst, b, h) do { _Pragma("unroll") for (int m = 0; m < 4; ++m) _Pragma("unroll") for (int k = 0; k < 2; ++k) dst[m][k] = *(const LAS bf16x8*)(lds + PG8_SA(b, h) + aoff + m * 2048 + k * 1024); } while (0)
#define PG8_LDB(dst, b, h) do { _Pragma("unroll") for (int n = 0; n < 2; ++n) _Pragma("unroll") for (int k = 0; k < 2; ++k) dst[n][k] = *(const LAS bf16x8*)(lds + PG8_SB(b, h) + boff + n * 2048 + k * 1024); } while (0)
#define PG8_MMA(ai, bj, At, Bt) do { __builtin_amdgcn_s_setprio(1); \
        if constexpr (F8S != 0u) { _Pragma("unroll") for (int m = 0; m < 4; ++m) _Pragma("unroll") for (int n = 0; n < 2; ++n) \
            mfma_f8(acc[ai][bj][m][n], cat8(Bt[n][0], Bt[n][1]), cat8(At[m][0], At[m][1])); } \
        else { _Pragma("unroll") for (int m = 0; m < 4; ++m) _Pragma("unroll") for (int n = 0; n < 2; ++n) _Pragma("unroll") for (int k = 0; k < 2; ++k) \
            acc[ai][bj][m][n] = __builtin_amdgcn_mfma_f32_16x16x32_bf16(Bt[n][k], At[m][k], acc[ai][bj][m][n], 0, 0, 0); } __builtin_amdgcn_s_setprio(0); } while (0)
#define PG8_WAIT_V(n) asm volatile("s_waitcnt vmcnt(" #n ")" ::: "memory")
#define PG8_WAIT_L(n) asm volatile("s_waitcnt lgkmcnt(" #n ")" ::: "memory")
#define PG8_BAR __builtin_amdgcn_s_barrier()
#define PG8_SCHED __builtin_amdgcn_sched_barrier(0)
#define PG8_SETB(u) do { _Pragma("unroll") for (int _i = 0; _i < 2; ++_i) { int R_, C_; stage_rc((int)(threadIdx.x) * 16 + _i * 8192, R_, C_); const int Rp_ = Epi::PERM ? ((R_ & ~31) + perm32(R_ & 31)) : R_; \
        const int Rb_ = (Epi::VPERM && (u).tag) ? ((Rp_ & ~63) + vperm64(Rp_ & 63)) : Rp_; \
        voffB[_i] = (unsigned)Rb_ * (u).ldb + (unsigned)C_ * 2u; } hsB = (size_t)(u).hsb; } while (0)
    Unit cur, nxt; int ui = 0;
    if (!S.next(0, cur)) return;
#if GEMM_STAGGER
    { const unsigned long long te_ = wall_clock64() + (unsigned long long)(((blockIdx.x >> 3) & 3) * GEMM_STAGGER); while (wall_clock64() < te_) __builtin_amdgcn_s_sleep(8); }
#endif
    size_t rkey = ~(size_t)0; int rpar = 0; cur.par = 0; E.unit_begin(cur, rkey, rpar);
    f32x4 acc[2][2][4][2];
    bf16x8 At[4][2], B0[2][2], B1[2][2];
    const char* cA = cur.A; const char* cB = cur.B; size_t hsB;
    PG8_SETB(cur);
    if constexpr (GATHER) PG8_GIDX(cur, voffA, voffA1);
    PG8_STAGE(PG8_SB(0, 0), cB, voffB); PG8_STAGE(PG8_SB(0, 1), cB + hsB, voffB); PG8_STAGE(PG8_SA(0, 0), cA, voffA); PG8_STAGE(PG8_SA(0, 1), cA + hstepA, PG8_VA1);
    E.init(acc, cur, wr, wc, fr, fq);
    if (wr == 1) PG8_BAR;
    PG8_WAIT_V(2); PG8_BAR;
    PG8_STAGE(PG8_SB(1, 0), cB + kstep, voffB); PG8_STAGE(PG8_SA(1, 0), cA + kstep, voffA); PG8_STAGE(PG8_SB(1, 1), cB + hsB + kstep, voffB);
    PG8_WAIT_V(6); PG8_BAR;
    for (;;) {
        const bool has_next = S.next(ui + 1, nxt);
        const char* nA = has_next ? nxt.A : cA; const char* nB = has_next ? nxt.B : cB;
        if constexpr (GATHER) { if (has_next) PG8_GIDX(nxt, nvA0, nvA1); }
        for (int t = 0; t < nt; t += 2) {
            const bool last = (t == nt - 2);
            const char* a1 = cA + (size_t)(t + 1) * kstep;
            const char* a2 = last ? nA : cA + (size_t)(t + 2) * kstep; const char* b2 = last ? nB : cB + (size_t)(t + 2) * kstep;
            const char* a3 = a2 + kstep; const char* b3 = b2 + kstep;
            if (last && has_next) { PG8_SETB(nxt); if constexpr (GATHER) { voffA[0] = nvA0[0]; voffA[1] = nvA0[1]; } }
            PG8_LDB(B0, 0, 0); PG8_LDB(B1, 0, 1); PG8_SCHED; PG8_LDA(At, 0, 0); PG8_STAGE(PG8_SA(1, 1), a1 + hstepA, PG8_VA1);
            if constexpr (GATHER) { if (last && has_next) { voffA1[0] = nvA1[0]; voffA1[1] = nvA1[1]; } }
            PG8_WAIT_V(8); PG8_WAIT_L(0); PG8_BAR; PG8_MMA(0, 0, At, B0); PG8_MMA(0, 1, At, B1); PG8_BAR; PG8_SCHED;
            PG8_LDA(At, 0, 1); PG8_STAGE(PG8_SB(0, 0), b2, voffB); PG8_STAGE(PG8_SB(0, 1), b2 + hsB, voffB); PG8_STAGE(PG8_SA(0, 0), a2, voffA);
            PG8_WAIT_V(8); PG8_WAIT_L(0); PG8_BAR; PG8_MMA(1, 0, At, B0); PG8_MMA(1, 1, At, B1); PG8_BAR; PG8_SCHED;
            PG8_LDB(B0, 1, 0); PG8_LDB(B1, 1, 1); PG8_SCHED; PG8_LDA(At, 1, 0); PG8_STAGE(PG8_SA(0, 1), a2 + hstepA, PG8_VA1);
            PG8_WAIT_V(8); PG8_WAIT_L(0); PG8_BAR; PG8_MMA(0, 0, At, B0); PG8_MMA(0, 1, At, B1); PG8_BAR; PG8_SCHED;
            PG8_LDA(At, 1, 1); PG8_STAGE(PG8_SB(1, 0), b3, voffB); PG8_STAGE(PG8_SB(1, 1), b3 + hsB, voffB); PG8_STAGE(PG8_SA(1, 0), a3, voffA);
            PG8_WAIT_V(8); PG8_WAIT_L(0); PG8_BAR; PG8_MMA(1, 0, At, B0); PG8_MMA(1, 1, At, B1); PG8_BAR; PG8_SCHED;
        }
        if (wr == 0) PG8_BAR;
        if constexpr (F8S != 0u) asm volatile("s_nop 15\n\ts_nop 15" ::: "memory");
        E(acc, cur, wr, wc, fr, fq);
#if EPI_TWICE
        asm volatile("" ::: "memory"); E(acc, cur, wr, wc, fr, fq);
#endif
        if (!has_next) break;
        nxt.par = 0; E.unit_begin(nxt, rkey, rpar);
        E.init(acc, nxt, wr, wc, fr, fq);
        cur = nxt; cA = nA; cB = nB; ++ui;
        if (wr == 1) PG8_BAR;
    }
    PG8_WAIT_V(0);
    PG8_BAR;
#undef PG8_SA
#undef PG8_SB
#undef PG8_STAGE
#undef PG8_LDA
#undef PG8_LDB
#undef PG8_MMA
#undef PG8_WAIT_V
#undef PG8_WAIT_L
#undef PG8_BAR
#undef PG8_SCHED
#undef PG8_SETB
#undef PG8_VA1
#undef PG8_GIDX
}
}

#define XB_TMO      128
#define XB_XCNT(j)  (256  + 64 * (j))
#define XB_XSUB(j)  (1280 + 64 * (j))
#define XB_XGEN(j)  (2304 + 64 * (j))
#define XB_TOP      3328
#define XB_TOPGEN   3392
#define XCD_BAR_WORDS 3456
#define XB_SPIN_CAP (1u << 18)
__device__ __forceinline__ unsigned xb_ld(unsigned* p)              { return __hip_atomic_load(p, __ATOMIC_RELAXED, __HIP_MEMORY_SCOPE_AGENT); }
__device__ __forceinline__ unsigned xb_add(unsigned* p, unsigned v) { return __hip_atomic_fetch_add(p, v, __ATOMIC_RELAXED, __HIP_MEMORY_SCOPE_AGENT); }
__device__ __forceinline__ unsigned xb_xcc_id() { return (unsigned)__builtin_amdgcn_s_getreg((3 << 11) | 20) & 0xFu; }
#define XB_SPIN(cond, bar) do { unsigned _sp = 0; while (cond) { __builtin_amdgcn_s_sleep(1); \
    if ((++_sp & 255u) == 0u) { if (xb_ld(&(bar)[XB_TMO])) break; if (_sp > XB_SPIN_CAP) { atomicAdd(&(bar)[XB_TMO], 1u); break; } } } } while (0)
struct XcdBarrier { unsigned* bar; unsigned x; volatile LAS unsigned* st; };
__device__ __forceinline__ XcdBarrier xcd_barrier_post(unsigned* bar, volatile LAS unsigned* st) {
    XcdBarrier b; b.bar = bar; b.x = xb_xcc_id(); b.st = st;
    if (threadIdx.x == 0) (void)xb_add(&bar[XB_XCNT(b.x)], 1u);
    return b;
}
__device__ __forceinline__ void xcd_barrier_complete(unsigned* bar, unsigned x, unsigned& nloc, unsigned& nx) {
    const unsigned G = gridDim.x * gridDim.y * gridDim.z;
    unsigned sum, cnt, mine, sp = 0u;
    for (;;) {
        sum = 0u; cnt = 0u; mine = 0u;
#pragma unroll
        for (unsigned j = 0; j < 16; ++j) { const unsigned c = xb_ld(&bar[XB_XCNT(j)]); sum += c; cnt += (c > 0u) ? 1u : 0u; mine = (j == x) ? c : mine; }
        if (sum == G) break;
        __builtin_amdgcn_s_sleep(1);
        if ((++sp & 255u) == 0u) { if (xb_ld(&bar[XB_TMO])) break; if (sp > XB_SPIN_CAP) { atomicAdd(&bar[XB_TMO], 1u); break; } }
    }
    nloc = mine > 0u ? mine : 1u; nx = cnt > 0u ? cnt : 1u;
}
__device__ __forceinline__ void xcd_barrier(const XcdBarrier& b) {
    asm volatile("s_waitcnt vmcnt(0)" ::: "memory");
    __syncthreads();
    if (threadIdx.x == 0) {
        unsigned* bar = b.bar;
        __builtin_amdgcn_s_waitcnt(0);
        unsigned nloc = b.st[0], nx = b.st[1];
        if (nloc == 0u) { xcd_barrier_complete(bar, b.x, nloc, nx); b.st[0] = nloc; b.st[1] = nx; }
        const unsigned old = xb_add(&bar[XB_XSUB(b.x)], 1u);
        const unsigned gen = old / nloc;
        if (old + 1u == (gen + 1u) * nloc) {
            __builtin_amdgcn_fence(__ATOMIC_RELEASE, "agent");
            asm volatile("s_waitcnt vmcnt(0)" ::: "memory");
            const unsigned og = xb_add(&bar[XB_TOP], 1u);
            const unsigned tg = og / nx;
            if (og + 1u == (tg + 1u) * nx) xb_add(&bar[XB_TOPGEN], 1u);
            else XB_SPIN(xb_ld(&bar[XB_TOPGEN]) == tg, bar);
            __builtin_amdgcn_fence(__ATOMIC_ACQUIRE, "agent");
            xb_add(&bar[XB_XGEN(b.x)], 1u);
            asm volatile("s_waitcnt vmcnt(0)" ::: "memory");
        } else {
            XB_SPIN(xb_ld(&bar[XB_XGEN(b.x)]) == gen, bar);
            __builtin_amdgcn_fence(__ATOMIC_ACQUIRE, "agent");
            asm volatile("s_waitcnt vmcnt(0)" ::: "memory");
        }
    }
    __syncthreads();
}

struct Job { int in, K, ld, col0, ncols, mode, sk, sidx; unsigned long long src, dst; unsigned item0; int rk; int ridx; int pad; };
constexpr int NJOBS = 60;
struct JobTab { Job j[NJOBS]; unsigned nitems; unsigned pad[3]; };
constexpr JobTab make_jobs() {
    JobTab t{}; int n = 0; unsigned it = 0;
    auto add = [&](int in, unsigned long long src, int K, int ld, int col0, int ncols, unsigned long long dst_elem, int mode, int sk, int sidx, int rk = 0, int ridx = 0, int f8 = 0) {
        Job& q = t.j[n++]; q.in = in; q.K = K; q.ld = ld; q.col0 = col0; q.ncols = ncols; q.mode = mode; q.sk = sk; q.sidx = sidx; q.src = src; q.dst = dst_elem; q.item0 = it; q.rk = rk; q.ridx = ridx; q.pad = f8;
        it += (unsigned)((K / (f8 ? 128 : 64)) * (ncols / 64)); };
    add(5, 0, 1024, 1024, 0, 1024, W_A_IN, 0, 0, 0);
    for (int g = 0; g < 4; ++g) add(6, (unsigned long long)g * 65536, 256, 256, 0, 256, W_A_GRP + (unsigned long long)g * 65536, 0, 2, g * 256);
    add(8, 0, 1024, 1024, 0, 1024, W_A_OUT, 0, 0, 0);
    for (int g = 0; g < 3; ++g) {
        add(9, 0, 1024, 9216, g * 3072, 1024, W_B_QK + (unsigned long long)g * 524288, 0, 1, 0, 2, 1 * DM, 1);
        add(9, 0, 1024, 9216, g * 3072 + 1024, 1024, W_B_QK + (unsigned long long)(3 + g) * 524288, 0, 0, 0, 2, 1 * DM, 1);
        add(9, 0, 1024, 9216, g * 3072 + 2048, 1024, W_B_V + (unsigned long long)g * 1048576, 0, 0, 0, 2, 1 * DM);
    }
    add(10, 0, 1024, 1024, 0, 1024, W_B_OUT, 0, 0, 0);
    add(11, 0, 1024, 3072, 0, 1024, W_C_QK, 0, 1, 0, 0, 0, 1);
    add(11, 0, 1024, 3072, 1024, 1024, W_C_QK + 524288, 0, 0, 0, 0, 0, 1);
    add(11, 0, 1024, 3072, 2048, 1024, W_C_V, 0, 0, 0, 0, 0, 1);
    add(14, 0, 1024, 1024, 0, 1024, W_C_OUT, 0, 0, 0, 0, 0, 2);
    add(15, 0, 1024, 1536, 0, 1024, W_D_QK, 0, 1, 0, 2, 3 * DM, 1);
    add(15, 0, 1024, 1536, 1024, 256, W_D_QK + 524288, 0, 0, 0, 2, 3 * DM, 1);
    add(15, 0, 1024, 1536, 1280, 256, W_D_V, 0, 0, 0, 2, 3 * DM, 1);
    add(17, 0, 1024, 1024, 0, 1024, W_D_OUT, 0, 0, 0, 0, 0, 2);
    for (int l = 0; l < 2; ++l) add(18, (unsigned long long)l * 1024 * 7168, 1024, 7168, 0, 7168, W_F_GU + (unsigned long long)l * 7168 * 1024, 1, 0, 0, 3, 2 * l * DM, DENSE_F8(l) ? 1 : 0);
    for (int l = 0; l < 2; ++l) add(19, (unsigned long long)l * 3584 * 1024, 3584, 1024, 0, 1024, W_F_D + (unsigned long long)l * 3584 * 1024, 0, 0, 0, 0, 0, DENSE_F8(l) ? 2 : 0);
    for (int l = 0; l < 16; ++l) add(21, (unsigned long long)l * 1024 * 7168, 1024, 7168, 0, 7168, W_M_GU + (unsigned long long)l * 7168 * 512, 1, 0, 0, 0, 0, 1);
    for (int l = 0; l < 16; ++l) add(22, (unsigned long long)l * 3584 * 1024, 3584, 1024, 0, 1024, W_M_D + (unsigned long long)l * 3584 * 512, 0, 0, 0, 0, 0, 2);
    t.nitems = it;
    return t;
}
__constant__ JobTab g_jobs = make_jobs();
static_assert(make_jobs().j[NJOBS - 1].K == 3584, "job count");

struct Args { const float* in[23]; float* out; unsigned char* ws; int ph_lo, ph_hi; };

struct Frame {
    LAS unsigned char* lds;
    int G, c, vcu;
    __device__ __forceinline__ int tid_() const { return (int)threadIdx.x; }
    __device__ __forceinline__ int lane_() const { return (int)threadIdx.x & 63; }
    __device__ __forceinline__ int wave_() const { return __builtin_amdgcn_readfirstlane((int)threadIdx.x >> 6); }
};

__device__ __forceinline__ void conv_item(const Job& jb, const float* __restrict__ src, bf16_t* __restrict__ dst, const float* __restrict__ cs, const float* __restrict__ rsv, LAS unsigned* scr, unsigned item, int lane) {
    const bool f8 = jb.pad != 0; const float f8s = jb.pad == 1 ? 256.f : 128.f;
    const int ntn = jb.ncols >> 6; const int kb = (int)item / ntn, nb = (int)item % ntn, k0 = kb * (f8 ? 128 : 64), n0 = nb * 64;
    int drow = n0;
    if (jb.mode == 1) { int n = n0; const bool up = n >= DFF; if (up) n -= DFF; drow = (n >> 7) * 256 + (n & 127) + (up ? 128 : 0); }
    const int a = lane & 15, b = lane >> 4;
    const float sc = (jb.sk == 1) ? QSCALE : 1.0f;
    f32x4 csv = (f32x4){sc, sc, sc, sc};
    if (jb.sk == 2) csv = *(const f32x4*)(cs + jb.sidx + n0 + 4 * a);
    const float* sp = src + (size_t)(k0 + 2 * b) * jb.ld + jb.col0 + n0 + 4 * a;
    const int c = lane & 7;
    if (f8) {
        f32x4 v0[16], v1[16];
#pragma unroll
        for (int i = 0; i < 16; ++i) { v0[i] = __builtin_nontemporal_load((const f32x4*)(sp + (size_t)(8 * i) * jb.ld)); v1[i] = __builtin_nontemporal_load((const f32x4*)(sp + (size_t)(8 * i + 1) * jb.ld)); }
#pragma unroll
        for (int i = 0; i < 16; ++i) { float g0 = f8s, g1 = f8s; if (rsv) { g0 *= rsv[k0 + 8 * i + 2 * b]; g1 *= rsv[k0 + 8 * i + 2 * b + 1]; }
            const f32x4 x0 = v0[i] * csv * g0, x1 = v1[i] * csv * g1; const int kp = 4 * i + b;
#pragma unroll
            for (int j = 0; j < 4; ++j) ((LAS unsigned short*)scr)[(4 * a + j) * 66 + kp] = (unsigned short)__builtin_amdgcn_cvt_pk_fp8_f32(x0[j], x1[j], 0, false); }
        LDS_WAIT();
#pragma unroll
        for (int jj = 0; jj < 8; ++jj) { const int n = (lane >> 3) + 8 * jj; const LAS unsigned* s = scr + n * 33 + 4 * c;
            u32x4 o; o.x = s[0]; o.y = s[1]; o.z = s[2]; o.w = s[3];
            __builtin_nontemporal_store(o, (u32x4*)((unsigned char*)dst + (size_t)(drow + n) * jb.K + k0 + 16 * c)); }
        LDS_WAIT();
        return;
    }
    f32x4 v0[8], v1[8];
#pragma unroll
    for (int i = 0; i < 8; ++i) { v0[i] = __builtin_nontemporal_load((const f32x4*)(sp + (size_t)(8 * i) * jb.ld)); v1[i] = __builtin_nontemporal_load((const f32x4*)(sp + (size_t)(8 * i + 1) * jb.ld)); }
#pragma unroll
    for (int i = 0; i < 8; ++i) { float g0 = 1.0f, g1 = 1.0f; if (rsv) { g0 = rsv[k0 + 8 * i + 2 * b]; g1 = rsv[k0 + 8 * i + 2 * b + 1]; }
        const f32x4 x0 = v0[i] * csv * g0, x1 = v1[i] * csv * g1; const int kp = 4 * i + b;
#pragma unroll
        for (int j = 0; j < 4; ++j) scr[(4 * a + j) * 33 + kp] = cvt_pk_bf16(x0[j], x1[j]); }
    LDS_WAIT();
#pragma unroll
    for (int jj = 0; jj < 8; ++jj) { const int n = (lane >> 3) + 8 * jj; const LAS unsigned* s = scr + n * 33 + 4 * c;
        u32x4 o; o.x = s[0]; o.y = s[1]; o.z = s[2]; o.w = s[3];
        __builtin_nontemporal_store(o, (u32x4*)(dst + (size_t)(drow + n) * jb.K + k0 + 8 * c)); }
    LDS_WAIT();
}

__device__ __forceinline__ int rel_bucket(int rel) {
    const int n = rel < 0 ? -rel : rel;
    int big = 8 + (int)(logf((float)(n < 1 ? 1 : n) / 8.0f) / 4.852030263919617f * 8.0f);
    big = big < 15 ? big : 15;
    return (rel > 0 ? 16 : 0) + (n < 8 ? n : big);
}

__device__ __forceinline__ void load_row(const float* xrow, int lane, f32x4 (&v)[4]) {
    const f32x4* xr = (const f32x4*)xrow + lane;
#pragma unroll
    for (int j = 0; j < 4; ++j) v[j] = xr[64 * j];
}
__device__ __forceinline__ void load_row(const bf16_t* xrow, int lane, f32x4 (&v)[4]) {
    const u32x2* xr = (const u32x2*)xrow + lane;
#pragma unroll
    for (int j = 0; j < 4; ++j) { const u32x2 w = xr[64 * j]; v[j] = (f32x4){bf_lo(w.x), bf_hi(w.x), bf_lo(w.y), bf_hi(w.y)}; }
}
__device__ __forceinline__ float row_rstd(const f32x4 (&v)[4]) {
    float s = 0.f;
#pragma unroll
    for (int j = 0; j < 4; ++j) s += (v[j].x * v[j].x + v[j].y * v[j].y) + (v[j].z * v[j].z + v[j].w * v[j].w);
    return 1.0f / sqrtf(wave_sum(s) * (1.0f / DM) + RMS_EPS);
}
__device__ __forceinline__ void store_row_fp8(unsigned char* orow, int lane, const f32x4 (&v)[4]) {
#pragma unroll
    for (int j = 0; j < 4; ++j) *(unsigned*)(orow + 4 * lane + 256 * j) = pg8::pack_fp8x4(v[j].x, v[j].y, v[j].z, v[j].w, 1.0f);
}
__device__ __forceinline__ void store_row_bf16(bf16_t* orow, int lane, const f32x4 (&v)[4]) {
    u32x2* o8 = (u32x2*)orow + lane;
#pragma unroll
    for (int j = 0; j < 4; ++j) { u32x2 w; w.x = cvt_pk_bf16(v[j].x, v[j].y); w.y = cvt_pk_bf16(v[j].z, v[j].w); o8[64 * j] = w; }
}
template <class XT> __device__ __forceinline__ void rms_phase(const Frame& F, const XT* x, const float* gain, bf16_t* hn) {
    const int gw = F.c * NWAVES + F.wave_(), NGW = F.G * NWAVES;
    f32x4 g[4]; load_row(gain, F.lane_(), g);
    for (int m = gw; m < MTOK; m += 2 * NGW) {
        const int m2 = m + NGW; const bool two = m2 < MTOK;
        f32x4 v[4], w[4]; load_row(x + (size_t)m * DM, F.lane_(), v); load_row(x + (size_t)(two ? m2 : m) * DM, F.lane_(), w);
        const float rv = row_rstd(v), rw = row_rstd(w);
#pragma unroll
        for (int j = 0; j < 4; ++j) { v[j] = v[j] * rv * g[j]; w[j] = w[j] * rw * g[j]; }
        store_row_bf16(hn + (size_t)m * DM, F.lane_(), v);
        if (two) store_row_bf16(hn + (size_t)m2 * DM, F.lane_(), w);
    }
}

__device__ __forceinline__ int keyperm(int rho) { return (rho & 0x13) | ((rho & 4) << 1) | ((rho & 8) >> 1); }
template <int NVB> struct AttnAcc { f32x16 o[NVB]; float m, l; };
template <int NVB>
__device__ __forceinline__ void attn_tile(AttnAcc<NVB>& st, const bf16x8 (&qf)[4], const char* kptr, const char* vptr, const size_t vblk, const LAS float* bt) {
    bf16x8 kf[4], vf[NVB][2];
#pragma unroll
    for (int t = 0; t < 4; ++t) kf[t] = *(const bf16x8*)(kptr + t * 32);
#pragma unroll
    for (int b = 0; b < NVB; ++b)
#pragma unroll
        for (int t = 0; t < 2; ++t) vf[b][t] = *(const bf16x8*)(vptr + b * vblk + t * 32);
    f32x16 s;
#pragma unroll
    for (int r = 0; r < 16; ++r) s[r] = bt[(r >> 3) * 16 + (r & 7)];
#pragma unroll
    for (int t = 0; t < 4; ++t) s = __builtin_amdgcn_mfma_f32_32x32x16_bf16(kf[t], qf[t], s, 0, 0, 0);
    float mx = s[0];
#pragma unroll
    for (int r = 1; r < 16; ++r) mx = fmaxf(mx, s[r]);
    mx = fmaxf(mx, __shfl_xor(mx, 32));
    const float mn = fmaxf(st.m, mx), alpha = __builtin_amdgcn_exp2f(st.m - mn); st.m = mn;
    float ps = 0.f;
#pragma unroll
    for (int r = 0; r < 16; ++r) { s[r] = __builtin_amdgcn_exp2f(s[r] - mn); ps += s[r]; }
    st.l = st.l * alpha + ps;
#pragma unroll
    for (int b = 0; b < NVB; ++b) st.o[b] = st.o[b] * alpha;
    u32x4 p0, p1;
    p0.x = cvt_pk_bf16(s[0], s[1]); p0.y = cvt_pk_bf16(s[2], s[3]); p0.z = cvt_pk_bf16(s[4], s[5]); p0.w = cvt_pk_bf16(s[6], s[7]);
    p1.x = cvt_pk_bf16(s[8], s[9]); p1.y = cvt_pk_bf16(s[10], s[11]); p1.z = cvt_pk_bf16(s[12], s[13]); p1.w = cvt_pk_bf16(s[14], s[15]);
    const bf16x8 pf0 = __builtin_bit_cast(bf16x8, p0), pf1 = __builtin_bit_cast(bf16x8, p1);
#pragma unroll
    for (int b = 0; b < NVB; ++b) { st.o[b] = __builtin_amdgcn_mfma_f32_32x32x16_bf16(vf[b][0], pf0, st.o[b], 0, 0, 0); st.o[b] = __builtin_amdgcn_mfma_f32_32x32x16_bf16(vf[b][1], pf1, st.o[b], 0, 0, 0); }
}

template <int HALF>
__device__ __forceinline__ void band_item(const bf16_t* Qp, const bf16_t* Kp, const int ldqk, const size_t tok0, const int dil, const int L, const int q0,
                                          const bf16_t* Vt, const size_t vn0, const float* gtab_h, LAS float* tbl, const float m_init, const float l_init,
                                          bf16_t* out_row0  , const int ldo, float* lse_out  , const int lane) {
    const int ql = lane & 31, hf = lane >> 5;
    for (int i = lane; i < 2 * HALF + 63; i += 64) { const int j = i - HALF - 31; tbl[i] = (j >= -HALF && j <= HALF) ? gtab_h[j * dil + 2048] : NEG_BIG; }
    LDS_WAIT();
    const size_t qtok = tok0 + (size_t)(q0 + ql) * dil;
    bf16x8 qf[4];
#pragma unroll
    for (int t = 0; t < 4; ++t) qf[t] = *(const bf16x8*)(Qp + qtok * ldqk + 16 * t + 8 * hf);
    AttnAcc<2> st;
    st.o[0] = (f32x16){}; st.o[1] = (f32x16){}; st.m = m_init; st.l = (hf == 0) ? l_init : 0.f;
    const int kr = keyperm(ql);
    for (int kt = q0 - HALF; kt <= q0 + HALF; kt += 32) {
        if (kt < 0 || kt >= L) continue;
        const char* kptr = (const char*)(Kp + (tok0 + (size_t)(kt + kr) * dil) * ldqk + 8 * hf);
        const char* vptr = (const char*)(Vt + (size_t)ql * MTOK + vn0 + kt + 8 * hf);
        const LAS float* bt = tbl + (kt - q0 + HALF) + 8 * hf - ql + 31;
        attn_tile<2>(st, qf, kptr, vptr, (size_t)32 * MTOK * 2, bt);
    }
    const float lt = st.l + __shfl_xor(st.l, 32), inv = 1.0f / lt;
    bf16_t* orow = out_row0 + qtok * ldo;
#pragma unroll
    for (int b = 0; b < 2; ++b)
#pragma unroll
        for (int i = 0; i < 4; ++i) { u32x2 w; w.x = cvt_pk_bf16(st.o[b][4 * i] * inv, st.o[b][4 * i + 1] * inv); w.y = cvt_pk_bf16(st.o[b][4 * i + 2] * inv, st.o[b][4 * i + 3] * inv);
            *(u32x2*)(orow + 32 * b + 8 * i + 4 * hf) = w; }
    if (lse_out && hf == 0) lse_out[qtok * 16] = st.m + __builtin_amdgcn_logf(lt);
}


template <int HALF, bool OUT8 = false>
__device__ __forceinline__ void band_item64(const bf16_t* Qp, const bf16_t* Kp, const int ldqk, const size_t tok0, const int dil, const int L, const int q0,
                                            const bf16_t* Vt, const size_t vn0, const float* gtab_h, LAS float* tbl, LAS unsigned char* stg, const float m_init, const float l_init,
                                            bf16_t* out0, const int ldo, float* lse_out, const int lane) {
    const int ql = lane & 31, hf = lane >> 5, kp = keyperm(ql);
    for (int i = lane; i < 2 * HALF + 63; i += 64) { const int j = i - HALF - 31; tbl[i] = (j >= -HALF && j <= HALF) ? gtab_h[j * dil + 2048] : NEG_BIG; }
    unsigned ka[4], va[2];
#pragma unroll
    for (int t = 0; t < 4; ++t) ka[t] = (unsigned)(kp * 128 + (((2 * t + hf) ^ ((kp >> 1) & 7)) << 4));
#pragma unroll
    for (int t = 0; t < 2; ++t) va[t] = (unsigned)(ql * 64 + (((2 * t + hf) ^ ((ql >> 2) & 3)) << 4));
    const size_t krow = (size_t)dil * ldqk * 2;
    const char* kg = (const char*)Kp + (tok0 + (size_t)(lane >> 3) * dil) * ldqk * 2;
    const unsigned kcE = (unsigned)(((lane & 7) ^ (lane >> 4)) << 4), kcO = (unsigned)(((lane & 7) ^ (4 + (lane >> 4))) << 4);
    const char* vg = (const char*)(Vt + (size_t)(lane >> 2) * MTOK + vn0) + ((((lane & 3) ^ (lane >> 4))) << 4);
#define BI_GLDS(g, l) __builtin_amdgcn_global_load_lds((const unsigned*)(g), (LAS unsigned*)(l), 16, 0, 0)
#define BI_ISSUE(kt_, s_) do { LAS unsigned char* sb_ = stg + (s_) * 8192; const char* k_ = kg + (size_t)(kt_) * krow; const char* v_ = vg + (size_t)(kt_) * 2; \
        BI_GLDS(k_ + kcE, sb_); BI_GLDS(k_ + 8 * krow + kcO, sb_ + 1024); BI_GLDS(k_ + 16 * krow + kcE, sb_ + 2048); BI_GLDS(k_ + 24 * krow + kcO, sb_ + 3072); \
        BI_GLDS(v_, sb_ + 4096); BI_GLDS(v_ + (size_t)16 * MTOK * 2, sb_ + 5120); BI_GLDS(v_ + (size_t)32 * MTOK * 2, sb_ + 6144); BI_GLDS(v_ + (size_t)48 * MTOK * 2, sb_ + 7168); } while (0)
    bf16x8 qf[2][4];
#pragma unroll
    for (int g = 0; g < 2; ++g)
#pragma unroll
        for (int t = 0; t < 4; ++t) qf[g][t] = *(const bf16x8*)(Qp + (tok0 + (size_t)(q0 + 32 * g + ql) * dil) * ldqk + 16 * t + 8 * hf);
    f32x16 o[2][2]; float mr[2], lr[2];
#pragma unroll
    for (int g = 0; g < 2; ++g) { o[g][0] = (f32x16){}; o[g][1] = (f32x16){}; mr[g] = m_init; lr[g] = (hf == 0) ? l_init : 0.f; }
    const int kt_lo = (q0 - HALF) < 0 ? 0 : q0 - HALF, kt_hi = (q0 + 32 + HALF) > (L - 32) ? (L - 32) : q0 + 32 + HALF;
    asm volatile("s_waitcnt lgkmcnt(0)" ::: "memory");
    BI_ISSUE(kt_lo, 0);
    int s = 0;
    for (int kt = kt_lo; kt <= kt_hi; kt += 32) {
        if (kt + 32 <= kt_hi) { BI_ISSUE(kt + 32, s ^ 1); asm volatile("s_waitcnt vmcnt(8)" ::: "memory"); }
        else asm volatile("s_waitcnt vmcnt(0)" ::: "memory");
        const LAS unsigned char* Kt = stg + s * 8192; const LAS unsigned char* Vs = Kt + 4096;
        bf16x8 kf[4], vf[2][2];
#pragma unroll
        for (int t = 0; t < 4; ++t) kf[t] = *(const LAS bf16x8*)(Kt + ka[t]);
#pragma unroll
        for (int b = 0; b < 2; ++b)
#pragma unroll
            for (int t = 0; t < 2; ++t) vf[b][t] = *(const LAS bf16x8*)(Vs + b * 2048 + va[t]);
#pragma unroll
        for (int g = 0; g < 2; ++g) {
            const int qg = q0 + 32 * g;
            if (kt >= qg - HALF && kt <= qg + HALF) {
                const LAS float* bt = tbl + (kt - qg + HALF) + 8 * hf - ql + 31;
                f32x16 sc;
#pragma unroll
                for (int r = 0; r < 16; ++r) sc[r] = bt[(r >> 3) * 16 + (r & 7)];
#pragma unroll
                for (int t = 0; t < 4; ++t) sc = __builtin_amdgcn_mfma_f32_32x32x16_bf16(kf[t], qf[g][t], sc, 0, 0, 0);
                float mx = sc[0];
#pragma unroll
                for (int r = 1; r < 16; ++r) mx = fmaxf(mx, sc[r]);
                mx = fmaxf(mx, __shfl_xor(mx, 32));
                const float mn = fmaxf(mr[g], mx), alpha = __builtin_amdgcn_exp2f(mr[g] - mn); mr[g] = mn;
                float ps = 0.f;
#pragma unroll
                for (int r = 0; r < 16; ++r) { sc[r] = __builtin_amdgcn_exp2f(sc[r] - mn); ps += sc[r]; }
                lr[g] = lr[g] * alpha + ps;
                o[g][0] = o[g][0] * alpha; o[g][1] = o[g][1] * alpha;
                u32x4 p0, p1;
                p0.x = cvt_pk_bf16(sc[0], sc[1]); p0.y = cvt_pk_bf16(sc[2], sc[3]); p0.z = cvt_pk_bf16(sc[4], sc[5]); p0.w = cvt_pk_bf16(sc[6], sc[7]);
                p1.x = cvt_pk_bf16(sc[8], sc[9]); p1.y = cvt_pk_bf16(sc[10], sc[11]); p1.z = cvt_pk_bf16(sc[12], sc[13]); p1.w = cvt_pk_bf16(sc[14], sc[15]);
                const bf16x8 pf0 = __builtin_bit_cast(bf16x8, p0), pf1 = __builtin_bit_cast(bf16x8, p1);
#pragma unroll
                for (int b = 0; b < 2; ++b) { o[g][b] = __builtin_amdgcn_mfma_f32_32x32x16_bf16(vf[b][0], pf0, o[g][b], 0, 0, 0); o[g][b] = __builtin_amdgcn_mfma_f32_32x32x16_bf16(vf[b][1], pf1, o[g][b], 0, 0, 0); }
            }
        }
        s ^= 1;
    }
#pragma unroll
    for (int g = 0; g < 2; ++g) {
        const float lt = lr[g] + __shfl_xor(lr[g], 32), inv = 1.0f / lt;
        const size_t qtok = tok0 + (size_t)(q0 + 32 * g + ql) * dil;
        bf16_t* orow = out0 + qtok * ldo;
#pragma unroll
        for (int b = 0; b < 2; ++b)
#pragma unroll
            for (int i = 0; i < 4; ++i) {
                if constexpr (OUT8) { *(unsigned*)((unsigned char*)out0 + qtok * ldo + 32 * b + 8 * i + 4 * hf) = pg8::pack_fp8x4(o[g][b][4 * i], o[g][b][4 * i + 1], o[g][b][4 * i + 2], o[g][b][4 * i + 3], inv * ACT8_SCALE); }
                else { u32x2 w; w.x = cvt_pk_bf16(o[g][b][4 * i] * inv, o[g][b][4 * i + 1] * inv); w.y = cvt_pk_bf16(o[g][b][4 * i + 2] * inv, o[g][b][4 * i + 3] * inv);
                    *(u32x2*)(orow + 32 * b + 8 * i + 4 * hf) = w; } }
        if (lse_out && hf == 0) lse_out[qtok * 16] = mr[g] + __builtin_amdgcn_logf(lt);
    }
#undef BI_GLDS
#undef BI_ISSUE
}

template <int HALF, bool OUT8 = false>
__device__ __forceinline__ void band_item64q(const unsigned char* Qp, const unsigned char* Kp, const int ldqk, const size_t tok0, const int dil, const int L, const int q0,
                                            const unsigned char* Vt, const size_t vn0, const float* gtab_h, LAS float* tbl, LAS unsigned char* stg, const float m_init, const float l_init,
                                            bf16_t* out0, const int ldo, float* lse_out, const int lane) {
    const int ql = lane & 31, hf = lane >> 5, kp = keyperm(ql);
    for (int i = lane; i < 2 * HALF + 63; i += 64) { const int j = i - HALF - 31; tbl[i] = (j >= -HALF && j <= HALF) ? gtab_h[j * dil + 2048] : NEG_BIG; }
    unsigned ka[4], va[2];
#pragma unroll
    for (int t = 0; t < 4; ++t) ka[t] = (unsigned)(kp * 64 + ((t ^ ((kp >> 2) & 3)) << 4) + 8 * hf);
#pragma unroll
    for (int t = 0; t < 2; ++t) va[t] = (unsigned)(ql * 32 + 16 * t + 8 * hf);
    const size_t krow = (size_t)dil * ldqk;
    const char* kg = (const char*)Kp + (tok0 + (size_t)(lane >> 2) * dil) * ldqk + ((((lane & 3) ^ (lane >> 4))) << 4);
    const char* vg = (const char*)Vt + (size_t)(lane >> 1) * MTOK + vn0 + 16 * (lane & 1);
#define BQ_PK8(a_, b_, c_, d_) ((unsigned)__builtin_amdgcn_cvt_pk_fp8_f32((c_), (d_), __builtin_amdgcn_cvt_pk_fp8_f32((a_), (b_), 0, false), true))
#define BI_GLDS(g, l) __builtin_amdgcn_global_load_lds((const unsigned*)(g), (LAS unsigned*)(l), 16, 0, 0)
#define BI_ISSUE(kt_, s_) do { LAS unsigned char* sb_ = stg + (s_) * 8192; const char* k_ = kg + (size_t)(kt_) * krow; const char* v_ = vg + (size_t)(kt_); \
        BI_GLDS(k_, sb_); BI_GLDS(k_ + 16 * krow, sb_ + 1024); BI_GLDS(v_, sb_ + 2048); BI_GLDS(v_ + (size_t)32 * MTOK, sb_ + 3072); } while (0)
    long qf[2][4];
#pragma unroll
    for (int g = 0; g < 2; ++g)
#pragma unroll
        for (int t = 0; t < 4; ++t) qf[g][t] = *(const long*)(Qp + (tok0 + (size_t)(q0 + 32 * g + ql) * dil) * ldqk + 16 * t + 8 * hf);
    f32x16 o[2][2]; float mr[2], lr[2];
#pragma unroll
    for (int g = 0; g < 2; ++g) { o[g][0] = (f32x16){}; o[g][1] = (f32x16){}; mr[g] = m_init; lr[g] = (hf == 0) ? l_init * 16.0f : 0.f; }
    const int kt_lo = (q0 - HALF) < 0 ? 0 : q0 - HALF, kt_hi = (q0 + 32 + HALF) > (L - 32) ? (L - 32) : q0 + 32 + HALF;
    asm volatile("s_waitcnt lgkmcnt(0)" ::: "memory");
    BI_ISSUE(kt_lo, 0);
    int s = 0;
    for (int kt = kt_lo; kt <= kt_hi; kt += 32) {
        if (kt + 32 <= kt_hi) { BI_ISSUE(kt + 32, s ^ 1); asm volatile("s_waitcnt vmcnt(4)" ::: "memory"); }
        else asm volatile("s_waitcnt vmcnt(0)" ::: "memory");
        const LAS unsigned char* Kt = stg + s * 8192; const LAS unsigned char* Vs = Kt + 2048;
        long kf[4], vf[2][2];
#pragma unroll
        for (int t = 0; t < 4; ++t) kf[t] = *(const LAS long*)(Kt + ka[t]);
#pragma unroll
        for (int b = 0; b < 2; ++b)
#pragma unroll
            for (int t = 0; t < 2; ++t) vf[b][t] = *(const LAS long*)(Vs + b * 1024 + va[t]);
#pragma unroll
        for (int g = 0; g < 2; ++g) {
            const int qg = q0 + 32 * g;
            if (kt >= qg - HALF && kt <= qg + HALF) {
                const LAS float* bt = tbl + (kt - qg + HALF) + 8 * hf - ql + 31;
                f32x16 sc;
#pragma unroll
                for (int r = 0; r < 16; ++r) sc[r] = bt[(r >> 3) * 16 + (r & 7)];
#pragma unroll
                for (int t = 0; t < 4; ++t) sc = __builtin_amdgcn_mfma_f32_32x32x16_fp8_fp8(kf[t], qf[g][t], sc, 0, 0, 0);
                float mx = sc[0];
#pragma unroll
                for (int r = 1; r < 16; ++r) mx = fmaxf(mx, sc[r]);
                mx = fmaxf(mx, __shfl_xor(mx, 32));
                const float mn = fmaxf(mr[g], mx), alpha = __builtin_amdgcn_exp2f(mr[g] - mn); mr[g] = mn;
                float ps = 0.f;
                const float mn4 = mn - 4.0f;
#pragma unroll
                for (int r = 0; r < 16; ++r) { sc[r] = __builtin_amdgcn_exp2f(sc[r] - mn4); ps += sc[r]; }
                lr[g] = lr[g] * alpha + ps;
                o[g][0] = o[g][0] * alpha; o[g][1] = o[g][1] * alpha;
                u32x2 p0, p1;
                p0.x = BQ_PK8(sc[0], sc[1], sc[2], sc[3]); p0.y = BQ_PK8(sc[4], sc[5], sc[6], sc[7]); p1.x = BQ_PK8(sc[8], sc[9], sc[10], sc[11]); p1.y = BQ_PK8(sc[12], sc[13], sc[14], sc[15]);
                const long pf0 = __builtin_bit_cast(long, p0), pf1 = __builtin_bit_cast(long, p1);
#pragma unroll
                for (int b = 0; b < 2; ++b) { o[g][b] = __builtin_amdgcn_mfma_f32_32x32x16_fp8_fp8(vf[b][0], pf0, o[g][b], 0, 0, 0); o[g][b] = __builtin_amdgcn_mfma_f32_32x32x16_fp8_fp8(vf[b][1], pf1, o[g][b], 0, 0, 0); }
            }
        }
        s ^= 1;
    }
#pragma unroll
    for (int g = 0; g < 2; ++g) {
        const float lt = lr[g] + __shfl_xor(lr[g], 32), inv = (1.0f / ACT8_SCALE) / lt;
        const size_t qtok = tok0 + (size_t)(q0 + 32 * g + ql) * dil;
        bf16_t* orow = out0 + qtok * ldo;
#pragma unroll
        for (int b = 0; b < 2; ++b)
#pragma unroll
            for (int i = 0; i < 4; ++i) {
                if constexpr (OUT8) { *(unsigned*)((unsigned char*)out0 + qtok * ldo + 32 * b + 8 * i + 4 * hf) = pg8::pack_fp8x4(o[g][b][4 * i], o[g][b][4 * i + 1], o[g][b][4 * i + 2], o[g][b][4 * i + 3], inv * ACT8_SCALE); }
                else { u32x2 w; w.x = cvt_pk_bf16(o[g][b][4 * i] * inv, o[g][b][4 * i + 1] * inv); w.y = cvt_pk_bf16(o[g][b][4 * i + 2] * inv, o[g][b][4 * i + 3] * inv);
                    *(u32x2*)(orow + 32 * b + 8 * i + 4 * hf) = w; } }
        if (lse_out && hf == 0) lse_out[qtok * 16] = mr[g] + __builtin_amdgcn_logf(lt) - 4.0f;
    }
#undef BI_GLDS
#undef BI_ISSUE
#undef BQ_PK8
}

struct PlainSched {
    const char* A; const char* B; unsigned lda, ldb; int nM, nN, G, c; size_t co_m, co_n;
    __device__ __forceinline__ bool next(int i, pg8::Unit& u) const {
        const long L = (long)i * G + c; if (L >= (long)nM * nN) return false;
        int pm, pn; pg8::tile_order(nM, nN, (int)L, pm, pn);
        u.A = A + (size_t)pm * 256 * lda; u.B = B + (size_t)pn * 256 * ldb; u.ldb = ldb; u.hsb = 128u * ldb; u.co = (size_t)pm * co_m + (size_t)pn * co_n; u.tag = 0; return true;
    }
};
struct QkvSched {
    const char* hn; const char* Wqk; const char* Wv; int nNqk, nvp, nMv, dshift, G, c; int ldqk; unsigned rs = 2048u;
    __device__ __forceinline__ bool next(int i, pg8::Unit& u) const {
        long L = (long)i * G + c; const int n0 = 64 * nNqk, nv = nMv * 64;
        if (L < n0) { int pm, pn; pg8::tile_order(64, nNqk, (int)L, pm, pn);
            u.A = hn + (size_t)pm * 256 * rs; u.B = Wqk + (size_t)pn * 256 * rs; u.ldb = rs; u.hsb = 128u * rs; u.co = (size_t)pm * 256 * ldqk + (size_t)pn * 256; u.tag = 0; return true; }
        L -= n0; if (L >= (long)nvp * nv) return false;
        const int g = (int)(L / nv); int pm, pn; pg8::tile_order(nMv, 64, (int)(L % nv), pm, pn);
        const int d = 1 << (dshift * g), b = pn >> 3, nn = (pn & 7) * 256;
        size_t tok; unsigned ldb, hsb;
        if (d == 1) { tok = (size_t)b * SEQ + nn; ldb = rs; hsb = 128u * rs; }
        else if (d == 4) { tok = (size_t)b * SEQ + (size_t)(nn & 511) * 4 + (nn >> 9); ldb = 4u * rs; hsb = 128u * 4u * rs; }
        else { tok = (size_t)b * SEQ + (nn >> 7); ldb = 16u * rs; hsb = rs; }
        u.A = Wv + (size_t)(g * nMv + pm) * 256 * rs; u.B = hn + tok * rs; u.ldb = ldb; u.hsb = hsb;
        u.co = (size_t)(g * nMv + pm) * 256 * MTOK + (size_t)pn * 256; u.tag = 1; return true;
    }
};
struct MoeSched {
    const char* A; const char* B; unsigned lda, ldb; const int* panel; size_t estride; int nN, G, c; size_t co_m, co_n; int use_limit; const int* rows;
    __device__ __forceinline__ bool next(int i, pg8::Unit& u) const {
        const int nM = __builtin_amdgcn_readfirstlane(panel[0]); const long L = (long)i * G + c; const long lim = (use_limit && __builtin_amdgcn_readfirstlane(panel[3]) > 1) ? (long)__builtin_amdgcn_readfirstlane(panel[1]) : (long)nM * nN; if (L >= lim) return false;
        int pm, pn; pg8::tile_order(nM, nN, (int)L, pm, pn); const int e = __builtin_amdgcn_readfirstlane(panel[4 + pm]);
        u.A = rows ? A : A + (size_t)pm * 256 * lda; u.ridx = rows ? rows + pm * 256 : nullptr; u.B = B + (size_t)e * estride + (size_t)pn * 256 * ldb; u.ldb = ldb; u.hsb = 128u * ldb; u.co = (size_t)pm * co_m + (size_t)pn * co_n; u.tag = 0; return true;
    }
};
struct MoeDown8Sched {
    const char* A; const char* B; const int* panel; int G, c;
    __device__ __forceinline__ bool next(int i, pg8::Unit& u) const {
        const int nM = __builtin_amdgcn_readfirstlane(panel[0]); const long L = (long)i * G + c; const long lim = __builtin_amdgcn_readfirstlane(panel[3]) > 1 ? (long)__builtin_amdgcn_readfirstlane(panel[1]) : (long)nM * 4; if (L >= lim) return false;
        int pm, pn; pg8::tile_order(nM, 4, (int)L, pm, pn); const int e = __builtin_amdgcn_readfirstlane(panel[4 + pm]);
        u.A = A + (size_t)pm * 256 * 3584; u.ridx = nullptr; u.B = B + (size_t)e * (3584 * 1024) + (size_t)pn * 256 * 3584; u.ldb = 3584u; u.hsb = 128u * 3584u; u.co = (size_t)pm * 256 * DM + (size_t)pn * 256; u.tag = 0; return true;
    }
};
struct MoeSplitSched {
    const char* A; const char* B; const int* panel; size_t estride; int c;
    __device__ __forceinline__ bool next(int i, pg8::Unit& u) const {
        const int S = __builtin_amdgcn_readfirstlane(panel[3]), rem = __builtin_amdgcn_readfirstlane(panel[2]); if (i > 0 || S <= 1 || c >= rem * S) return false;
        const int q = c / S, ks = c - q * S, ksub = DFF / S;
        int pm, pn; pg8::tile_order(__builtin_amdgcn_readfirstlane(panel[0]), 4, __builtin_amdgcn_readfirstlane(panel[1]) + q, pm, pn); const int e = __builtin_amdgcn_readfirstlane(panel[4 + pm]);
        u.A = A + (size_t)pm * 256 * 3584 + (size_t)ks * ksub; u.B = B + (size_t)e * estride + (size_t)pn * 256 * 3584 + (size_t)ks * ksub; u.ldb = 3584u; u.hsb = 128u * 3584u; u.co = (size_t)c * 65536; u.tag = 0; return true;
    }
};

__device__ __forceinline__ void moe_route(const Frame& F, const bf16_t* x, const float* gain, const float* router, bf16_t* hn, int* e12, float* g1o, float* g2o, int* cnt_wg) {
    LAS int* cnt = (LAS int*)(F.lds + 32768);
    f32x4 R[4][8];
#pragma unroll
    for (int j = 0; j < 4; ++j) { const f32x4* rp = (const f32x4*)(router + (size_t)(4 * F.lane_() + 256 * j) * NE);
#pragma unroll
        for (int q = 0; q < 8; ++q) R[j][q] = rp[q]; }
    f32x4 g[4]; load_row(gain, F.lane_(), g);
    for (int ch = F.c; ch < MTOK / 64; ch += F.G) {
        if (F.tid_() < 8) cnt[F.tid_()] = 0;
        const int m0 = ch * 64 + F.wave_() * 8;
        u32x2 raw[4][4];
#pragma unroll
        for (int i = 0; i < 4; ++i) { const u32x2* xr = (const u32x2*)(x + (size_t)(m0 + i) * DM) + F.lane_();
#pragma unroll
            for (int j = 0; j < 4; ++j) raw[i][j] = xr[64 * j]; }
        __syncthreads();
        int my_e = 0; float my_ga = 0.f, my_gb = 0.f;
#pragma unroll
        for (int i = 0; i < 8; ++i) {
            const int m = m0 + i;
            f32x4 v[4];
#pragma unroll
            for (int j = 0; j < 4; ++j) v[j] = (f32x4){bf_lo(raw[i & 3][j].x), bf_hi(raw[i & 3][j].x), bf_lo(raw[i & 3][j].y), bf_hi(raw[i & 3][j].y)};
            if (i < 4) { const u32x2* xr = (const u32x2*)(x + (size_t)(m + 4) * DM) + F.lane_();
#pragma unroll
                for (int j = 0; j < 4; ++j) raw[i & 3][j] = xr[64 * j]; }
            const float rstd = row_rstd(v);
#pragma unroll
            for (int j = 0; j < 4; ++j) v[j] = v[j] * rstd * g[j];
            { unsigned char* hr = (unsigned char*)hn + (size_t)m * DM + 4 * F.lane_();
#pragma unroll
              for (int j = 0; j < 4; ++j) *(unsigned*)(hr + 256 * j) = pg8::pack_fp8x4(v[j].x, v[j].y, v[j].z, v[j].w, 1.0f); }
            f32x4 l0 = (f32x4){0.f, 0.f, 0.f, 0.f}, l1 = l0;
#pragma unroll
            for (int j = 0; j < 4; ++j)
#pragma unroll
                for (int z = 0; z < 4; ++z) { l0 += R[j][2 * z] * v[j][z]; l1 += R[j][2 * z + 1] * v[j][z]; }
            float lg[8] = {l0.x, l0.y, l0.z, l0.w, l1.x, l1.y, l1.z, l1.w};
            { const int ln = F.lane_(); const bool h5 = (ln & 32) != 0, h4 = (ln & 16) != 0, h3 = (ln & 8) != 0;
              float a4[4];
#pragma unroll
              for (int k = 0; k < 4; ++k) { const float keep = h5 ? lg[4 + k] : lg[k], give = h5 ? lg[k] : lg[4 + k]; a4[k] = keep + __shfl_xor(give, 32); }
              float a2[2];
#pragma unroll
              for (int k = 0; k < 2; ++k) { const float keep = h4 ? a4[2 + k] : a4[k], give = h4 ? a4[k] : a4[2 + k]; a2[k] = keep + __shfl_xor(give, 16); }
              float a1; { const float keep = h3 ? a2[1] : a2[0], give = h3 ? a2[0] : a2[1]; a1 = keep + __shfl_xor(give, 8); }
              a1 += __shfl_xor(a1, 4); a1 += __shfl_xor(a1, 2); a1 += __shfl_xor(a1, 1);
#pragma unroll
              for (int e = 0; e < 8; ++e) lg[e] = __shfl(a1, 8 * e); }
            int e1 = 0; float v1 = lg[0];
#pragma unroll
            for (int e = 1; e < 8; ++e) if (lg[e] > v1) { v1 = lg[e]; e1 = e; }
            int e2 = -1; float v2 = -3.4e38f;
#pragma unroll
            for (int e = 0; e < 8; ++e) if (e != e1 && lg[e] > v2) { v2 = lg[e]; e2 = e; }
            const float ex = __expf(v2 - v1), ga = 1.0f / (1.0f + ex), gb = ex * ga;
            const bool mine = F.lane_() == i;
            my_e = mine ? (e1 | (e2 << 8)) : my_e; my_ga = mine ? ga : my_ga; my_gb = mine ? gb : my_gb;
            if (i & 1) __builtin_amdgcn_sched_barrier(0);
        }
        if (F.lane_() < 8) { const int m = m0 + F.lane_(); e12[m] = my_e; g1o[m] = my_ga; g2o[m] = my_gb; atomicAdd((int*)&cnt[my_e & 255], 1); atomicAdd((int*)&cnt[my_e >> 8], 1); }
        __syncthreads();
        if (F.tid_() < 8) cnt_wg[ch * 8 + F.tid_()] = cnt[F.tid_()];
        __syncthreads();
    }
}
__device__ __forceinline__ void moe_assign(const Frame& F, const int* e12, const int* cnt_wg, int* p1o, int* p2o, int* panel, int* rowtok) {
    LAS int* psum = (LAS int*)F.lds;
    LAS int* tot = psum + 512; LAS int* base = tot + 8; LAS int* off = base + 8;
    LAS int* plist = off + 16;
    for (int ch = F.c; ch < MTOK / 64; ch += F.G) {
        { const int e = F.tid_() & 7, part = F.tid_() >> 3; int s = 0;
#pragma unroll
          for (int q = 0; q < 4; ++q) s += cnt_wg[(4 * part + q) * 8 + e];
          psum[part * 8 + e] = s; }
        __syncthreads();
        if (F.tid_() < 8) { const int e = F.tid_(); int t = 0, b = 0; for (int p = 0; p < 64; ++p) { const int s = psum[p * 8 + e]; if (p < (ch >> 2)) b += s; t += s; }
            for (int q = 0; q < (ch & 3); ++q) b += cnt_wg[(4 * (ch >> 2) + q) * 8 + e];
            tot[e] = t; base[e] = b; }
        __syncthreads();
        if (F.tid_() == 0) { int o = 0; for (int e = 0; e < 8; ++e) { off[e] = o; o += (tot[e] + 255) & ~255; } off[8] = o; }
        __syncthreads();
        if (F.wave_() == 0) {
            const int m = ch * 64 + F.lane_(); const int ee = e12[m]; const int e1 = ee & 255, e2 = ee >> 8; int p1 = 0, p2 = 0;
#pragma unroll
            for (int e = 0; e < 8; ++e) { const unsigned long long mk = __ballot(e1 == e || e2 == e); const int rk = __popcll(mk & ((1ull << F.lane_()) - 1ull));
                if (e1 == e) p1 = off[e] + base[e] + rk; if (e2 == e) p2 = off[e] + base[e] + rk; }
            p1o[m] = p1; p2o[m] = p2; rowtok[p1] = m; rowtok[p2] = m;
        }
        __syncthreads();
        if (ch < 8) { const int e = ch; for (int r = off[e] + tot[e] + F.tid_(); r < off[e + 1]; r += NWAVES * 64) rowtok[r] = 0; }
        if (ch == 0) { const int P_ = off[8] >> 8, U_ = 4 * P_, full_ = (U_ / F.G) * F.G, rem_ = U_ - full_;
            const int S_ = (!MOE_SPLIT || rem_ == 0) ? 1 : (rem_ * 7 <= F.G ? 7 : (rem_ * 4 <= F.G ? 4 : 1));
            if (F.tid_() == 0) { panel[0] = P_; panel[1] = full_; panel[2] = rem_; panel[3] = S_; }
            for (int L = F.tid_(); L < U_; L += NWAVES * 64) { int pm, pn; pg8::tile_order(P_, 4, L, pm, pn); panel[160 + pm * 4 + pn] = (S_ > 1 && L >= full_) ? L - full_ : -1; }
            if (F.tid_() < NPANEL_MAX) { const int r = F.tid_() * 256; int e = 0;
#pragma unroll
                for (int q = 1; q < 8; ++q) if (r >= off[q]) e = q;
                panel[4 + F.tid_()] = e; } }
        __syncthreads();
    }
}
__device__ __forceinline__ void moe_add_row(const Frame& F, f32x4 (&v)[4], const bf16_t* ys, const int pos, const float gt) {
    const u32x2* ya = (const u32x2*)(ys + (size_t)pos * DM) + F.lane_();
#pragma unroll
    for (int j = 0; j < 4; ++j) { const u32x2 a = ya[64 * j]; v[j].x += gt * bf_lo(a.x); v[j].y += gt * bf_hi(a.x); v[j].z += gt * bf_lo(a.y); v[j].w += gt * bf_hi(a.y); }
}
__device__ __forceinline__ void moe_reduce_parts(const Frame& F, const float* part, const int* panel, bf16_t* ys) {
    const int S = panel[3], rem = panel[2]; if (S <= 1) return;
    const int gw = F.c * NWAVES + F.wave_(), NGW = F.G * NWAVES;
    for (int it = gw; it < rem * 64; it += NGW) {
        const int q = it >> 6, r0 = (it & 63) * 4; int pm, pn; pg8::tile_order(panel[0], 4, panel[1] + q, pm, pn);
#pragma unroll
        for (int rr = 0; rr < 4; ++rr) {
            const float* pp = part + (size_t)q * S * 65536 + (size_t)(r0 + rr) * 256 + 4 * F.lane_(); f32x4 t[7];
#pragma unroll
            for (int ks = 0; ks < 7; ++ks) t[ks] = (ks < S) ? *(const f32x4*)(pp + (size_t)ks * 65536) : (f32x4){0.f, 0.f, 0.f, 0.f};
            const f32x4 s = ((t[0] + t[1]) + (t[2] + t[3])) + ((t[4] + t[5]) + t[6]);
            u32x2 w; w.x = cvt_pk_bf16(s.x, s.y); w.y = cvt_pk_bf16(s.z, s.w);
            *(u32x2*)(ys + (size_t)(pm * 256 + r0 + rr) * DM + pn * 256 + 4 * F.lane_()) = w;
        }
    }
}
__device__ __forceinline__ void moe_combine(const Frame& F, const bf16_t* x, const bf16_t* ys, const float* part, const int* panel, const int* p1, const int* p2, const float* g1, const float* g2, const float* gain, bf16_t* xo, bf16_t* hn, float* outf) {
    const int gw = F.c * NWAVES + F.wave_(), NGW = F.G * NWAVES, lane = F.lane_();
    f32x4 g[4]; load_row(gain, lane, g);
    for (int m0 = gw; m0 < MTOK; m0 += 2 * NGW) {
        const int m1 = (m0 + NGW < MTOK) ? m0 + NGW : m0; const bool two = m1 != m0;
        const int pa0 = p1[m0], pb0 = p2[m0], pa1 = p1[m1], pb1 = p2[m1]; const float ga0 = g1[m0], gb0 = g2[m0], ga1 = g1[m1], gb1 = g2[m1];
        f32x4 v[4], w[4]; load_row(x + (size_t)m0 * DM, lane, v); load_row(x + (size_t)m1 * DM, lane, w);
        u32x2 ya[4], yb[4], yc[4], yd[4];
        { const u32x2* a = (const u32x2*)(ys + (size_t)pa0 * DM) + lane; const u32x2* b = (const u32x2*)(ys + (size_t)pb0 * DM) + lane;
          const u32x2* c = (const u32x2*)(ys + (size_t)pa1 * DM) + lane; const u32x2* d = (const u32x2*)(ys + (size_t)pb1 * DM) + lane;
#pragma unroll
          for (int j = 0; j < 4; ++j) { ya[j] = a[64 * j]; yb[j] = b[64 * j]; yc[j] = c[64 * j]; yd[j] = d[64 * j]; } }
#pragma unroll
        for (int j = 0; j < 4; ++j) {
            v[j].x += ga0 * bf_lo(ya[j].x) + gb0 * bf_lo(yb[j].x); v[j].y += ga0 * bf_hi(ya[j].x) + gb0 * bf_hi(yb[j].x); v[j].z += ga0 * bf_lo(ya[j].y) + gb0 * bf_lo(yb[j].y); v[j].w += ga0 * bf_hi(ya[j].y) + gb0 * bf_hi(yb[j].y);
            w[j].x += ga1 * bf_lo(yc[j].x) + gb1 * bf_lo(yd[j].x); w[j].y += ga1 * bf_hi(yc[j].x) + gb1 * bf_hi(yd[j].x); w[j].z += ga1 * bf_lo(yc[j].y) + gb1 * bf_lo(yd[j].y); w[j].w += ga1 * bf_hi(yc[j].y) + gb1 * bf_hi(yd[j].y); }
        if (xo) { store_row_bf16(xo + (size_t)m0 * DM, lane, v); if (two) store_row_bf16(xo + (size_t)m1 * DM, lane, w); }
        const float rv = row_rstd(v), rw = row_rstd(w);
#pragma unroll
        for (int j = 0; j < 4; ++j) { v[j] = v[j] * rv * g[j]; w[j] = w[j] * rw * g[j]; }
        if (outf) { f32x4* o = (f32x4*)(outf + (size_t)m0 * DM) + lane; f32x4* o2 = (f32x4*)(outf + (size_t)m1 * DM) + lane;
#pragma unroll
            for (int j = 0; j < 4; ++j) { o[64 * j] = v[j]; if (two) o2[64 * j] = w[j]; } }
        else { store_row_fp8((unsigned char*)hn + (size_t)m0 * DM, lane, v); if (two) store_row_fp8((unsigned char*)hn + (size_t)m1 * DM, lane, w); }
    }
}


__global__ void __launch_bounds__(NWAVES * 64, 2) enc_fwd(Args args) {
    extern __shared__ __attribute__((aligned(16))) unsigned char lds_raw[];
    Frame F;
    F.lds = (LAS unsigned char*)lds_raw;
    F.G = gridDim.x; F.c = blockIdx.x; F.vcu = (F.G % 8 == 0) ? (F.c % 8) * (F.G / 8) + F.c / 8 : F.c;
    unsigned char* ws = args.ws;
    volatile LAS unsigned* MISC = (volatile LAS unsigned*)(F.lds + MISC_OFF);
    for (int u = F.tid_(); u < (LDS_BYTES - LDSCTL_OFF) / 4; u += NWAVES * 64) ((LAS unsigned*)(F.lds + LDSCTL_OFF))[u] = 0u;
    __syncthreads();
#if MK_MULTI
    #define GRID_BAR() do { } while (0)
#else
    XcdBarrier bar = xcd_barrier_post((unsigned*)(ws + WS_CTL) + CW_BAR, MISC + 8);
    #define GRID_BAR() xcd_barrier(bar)
#endif
    const int lo = args.ph_lo, hi = args.ph_hi;
#define IN(k) (lo <= (k) && (k) < hi)
#define SEAM(k) do { if (IN((k) + 1)) GRID_BAR(); } while (0)
#define PREP(k) ((((unsigned long long)(PROBE_MASK) >> (k)) & 1ull) ? PROBE_N : 1)
#define PH_BEGIN(k) if (IN(k)) { const unsigned long long t0_ = ((((unsigned long long)(SLOW_MASK)) >> (k)) & 1ull) ? wall_clock64() : 0ull; for (int rep_ = 0; rep_ < PREP(k); ++rep_) {
#define PH_END(k) } SEAM(k); if (((((unsigned long long)(SLOW_MASK)) >> (k)) & 1ull) ) { const unsigned long long t1_ = wall_clock64(), te_ = t1_ + 8ull * (t1_ - t0_); while (wall_clock64() < te_) __builtin_amdgcn_s_sleep(32); } }

    const float* x_in = args.in[0]; const float* rel_bias = args.in[1]; const float* norm_mix = args.in[2]; const float* norm_ffn = args.in[3]; const float* norm_final = args.in[4];
    bf16_t* Wb = (bf16_t*)(ws + WS_W);
    float* gtab = (float*)(ws + WS_TAB); float* misc = (float*)(ws + WS_MISC);
    int* r_e12 = (int*)(ws + WS_ROUTE); float* r_g1 = (float*)(ws + WS_ROUTE + 65536); float* r_g2 = (float*)(ws + WS_ROUTE + 2 * 65536);
    int* r_p1 = (int*)(ws + WS_ROUTE + 3 * 65536); int* r_p2 = (int*)(ws + WS_ROUTE + 4 * 65536);
    int* cnt_wg = (int*)(ws + WS_CNT); int* panel = (int*)(ws + WS_PANEL);
    bf16_t* XA = (bf16_t*)(ws + WS_XA); bf16_t* XB = (bf16_t*)(ws + WS_XB);
    bf16_t* HN = (bf16_t*)(ws + WS_HN); bf16_t* BUFA = (bf16_t*)(ws + WS_BUFA); bf16_t* BUFB = (bf16_t*)(ws + WS_BUFB); bf16_t* BUFC = (bf16_t*)(ws + WS_BUFC);
    bf16_t* BIG = (bf16_t*)(ws + WS_BIG); bf16_t* VT = (bf16_t*)(ws + WS_VT); bf16_t* OG = (bf16_t*)(ws + WS_OG); float* LSE = (float*)(ws + WS_LSE);
    int* rowtok = (int*)(ws + WS_ROUTE + 512 * 1024);
    bf16_t* YS = OG; float* PART = (float*)(ws + WS_PART); float* PS = (float*)(ws + WS_PS);
    LAS float* RTAB = (LAS float*)(F.lds + RING_BYTES + 1024);
    LAS unsigned char* ring = F.lds;
    unsigned char* X8 = (unsigned char*)HN;

#define PLAIN_GEMM(EPI, Aptr, Bptr, K_, lda_, ldb_, nM_, nN_, com_, con_) do { \
        PlainSched S_{(const char*)(Aptr), (const char*)(Bptr), (unsigned)(lda_), (unsigned)(ldb_), (nM_), (nN_), F.G, F.c, (size_t)(com_), (size_t)(con_)}; \
        pg8::gemm_phase(ring, (K_), (unsigned)(lda_), S_, EPI); } while (0)

#define DENSE_FFN(p, l, xr, xo) \
    PH_BEGIN(p) pg8::EpiSwigluT<true> E_{BIG, DFF, PS, (const char*)(xr), RTAB}; PLAIN_GEMM(E_, (xr), Wb + W_F_GU + (size_t)(l) * 7168 * 1024, 1024, 2048, 2048, 64, 28, 256 * DFF, 128); PH_END(p) \
    PH_BEGIN((p) + 1) pg8::EpiResidT<false, true, 1> E_{(xr), (xo), PS, X8}; PLAIN_GEMM(E_, BIG, Wb + W_F_D + (size_t)(l) * 3584 * 1024, 3584, 7168, 7168, 64, 4, 256 * DM, 256); PH_END((p) + 1)
#define DENSE_FFN8(p, l, xr, xo) \
    PH_BEGIN(p) pg8::EpiSwiglu8T<true> E_{(unsigned char*)BIG, DFF, PS, (const char*)X8, RTAB}; PlainSched S_{(const char*)X8, (const char*)(Wb + W_F_GU + (size_t)(l) * 7168 * 1024), 1024u, 1024u, 64, 28, F.G, F.c, (size_t)256 * DFF, (size_t)128}; \
        pg8::gemm_phase<false, F8_GU>(ring, 512, 1024u, S_, E_); PH_END(p) \
    PH_BEGIN((p) + 1) pg8::EpiResidT<false, true, 3> E_{(xr), (xo), PS, X8}; PlainSched S_{(const char*)BIG, (const char*)(Wb + W_F_D + (size_t)(l) * 3584 * 1024), 3584u, 3584u, 64, 4, F.G, F.c, (size_t)256 * DM, (size_t)256}; \
        pg8::gemm_phase<false, F8_DN>(ring, 1792, 3584u, S_, E_); PH_END((p) + 1)

#define MOE_FFN(p, l, xr, gain) \
    PH_BEGIN(p) moe_route(F, (xr), (gain), args.in[20] + (size_t)(l) * DM * NE, HN, r_e12, r_g1, r_g2, cnt_wg); PH_END(p) \
    PH_BEGIN((p) + 1) moe_assign(F, r_e12, cnt_wg, r_p1, r_p2, panel, rowtok); PH_END((p) + 1) \
    PH_BEGIN((p) + 2) pg8::EpiSwiglu8 E_{(unsigned char*)BIG, DFF, nullptr, nullptr, nullptr}; MoeSched S_{(const char*)HN, (const char*)(Wb + W_M_GU) + (size_t)(l) * 8 * 7168 * 1024, 1024u, 1024u, panel, (size_t)7168 * 1024, 28, F.G, F.c, (size_t)256 * DFF, (size_t)128, 0, rowtok}; \
        pg8::gemm_phase<true, F8_GU>(ring, 512, 1024u, S_, E_); PH_END((p) + 2) \
    PH_BEGIN((p) + 3) pg8::EpiYs8 E_{YS}; MoeDown8Sched S_{(const char*)BIG, (const char*)(Wb + W_M_D) + (size_t)(l) * 8 * 3584 * 1024, panel, F.G, F.c}; \
        pg8::gemm_phase<false, F8_DN>(ring, 1792, 3584u, S_, E_); \
        { pg8::EpiPart E2_{PART, F8_DN_UNSCALE}; MoeSplitSched S2_{(const char*)BIG, (const char*)(Wb + W_M_D) + (size_t)(l) * 8 * 3584 * 1024, panel, (size_t)3584 * 1024, F.c}; \
          const int sp_ = panel[3] > 1 ? panel[3] : 1; pg8::gemm_phase<false, F8_DN>(ring, DFF / sp_ / 2, 3584u, S2_, E2_); } PH_END((p) + 3)

    PH_BEGIN(0)
        LAS unsigned* scr = (LAS unsigned*)(F.lds + F.wave_() * 8448);
        const unsigned gw = (unsigned)(F.c * NWAVES + F.wave_()), NGW = (unsigned)(F.G * NWAVES);
        int jn = 0;
        for (unsigned it = gw; it < g_jobs.nitems; it += NGW) {
            while (jn + 1 < NJOBS && g_jobs.j[jn + 1].item0 <= it) ++jn;
            const Job& jb = g_jobs.j[jn];
            conv_item(jb, args.in[jb.in] + jb.src, Wb + jb.dst, args.in[7], jb.rk ? args.in[jb.rk] + jb.ridx : nullptr, scr, it - jb.item0, F.lane_());
        }
        for (int i = F.c * NWAVES * 64 + F.tid_(); i < 16 * 4096; i += F.G * NWAVES * 64) { const int h = i >> 12, idx = i & 4095; gtab[i] = rel_bias[rel_bucket(idx - 2048) * 16 + h] * LOG2E; }
        if (F.c == 1) for (int i = F.tid_(); i < 4096; i += NWAVES * 64) ((unsigned char*)(ws + WS_BID))[i] = (unsigned char)rel_bucket(i - 2048);
        if (F.c == 0 && F.tid_() == 0) { const float* lv = args.in[12]; float s0 = 0.f, s1 = 0.f; for (int i = 0; i < 64; ++i) { s0 += lv[i] * lv[64 + i]; s1 += lv[128 + i] * lv[192 + i]; }
            const float lam_init = 0.8f - 0.6f * expf(-0.3f * 2.0f); misc[0] = expf(s0) - expf(s1) + lam_init; misc[1] = lam_init; }
        rms_phase(F, x_in, norm_mix, HN);
        PH_END(0)
#if EXTRA_BARS
    for (int xb_ = 0; xb_ < EXTRA_BARS; ++xb_) GRID_BAR();
#endif
    PH_BEGIN(1) pg8::EpiBf16 E_{BUFA, DM, BUFA, DM, nullptr, nullptr, nullptr}; PLAIN_GEMM(E_, HN, Wb + W_A_IN, 1024, 2048, 2048, 64, 4, 256 * DM, 256); PH_END(1)
    PH_BEGIN(2)
        for (int it = F.c * NWAVES * 64 + F.tid_(); it < MTOK * 128; it += F.G * NWAVES * 64) {
            const int g = __builtin_amdgcn_readfirstlane((it >> 6) & 3), cc = g * 32 + (it & 31), t = ((it >> 8) << 1) + ((it >> 5) & 1), s = t & (SEQ - 1);
            const bf16_t* base = BUFA + (size_t)(t - s) * DM + cc * 8;
            float a[8] = {0, 0, 0, 0, 0, 0, 0, 0};
#define POOL_WIN(HW) do { u32x4 w_[2 * (HW)]; \
                _Pragma("unroll") for (int i = 0; i < 2 * (HW); ++i) { int r = s - (HW) + i; r = r < 0 ? 0 : (r > SEQ - 1 ? SEQ - 1 : r); w_[i] = *(const u32x4*)(base + (size_t)r * DM); } \
                _Pragma("unroll") for (int i = 0; i < 2 * (HW); ++i) { const int r = s - (HW) + i; const float k_ = (r >= 0 && r < SEQ) ? 1.0f : 0.0f; \
                    a[0] += k_ * bf_lo(w_[i].x); a[1] += k_ * bf_hi(w_[i].x); a[2] += k_ * bf_lo(w_[i].y); a[3] += k_ * bf_hi(w_[i].y); \
                    a[4] += k_ * bf_lo(w_[i].z); a[5] += k_ * bf_hi(w_[i].z); a[6] += k_ * bf_lo(w_[i].w); a[7] += k_ * bf_hi(w_[i].w); } } while (0)
            if (g == 0) POOL_WIN(1); else if (g == 1) POOL_WIN(2); else if (g == 2) POOL_WIN(4); else POOL_WIN(8);
#undef POOL_WIN
            const int hw = 1 << g, lo_ = (s - hw) < 0 ? 0 : s - hw, hi_ = (s + hw) > SEQ ? SEQ : s + hw;
            const float ic = 1.0f / (float)(hi_ - lo_); const u32x4 w = *(const u32x4*)(base + (size_t)s * DM);
            u32x4 o; o.x = cvt_pk_bf16(a[0] * ic - bf_lo(w.x), a[1] * ic - bf_hi(w.x)); o.y = cvt_pk_bf16(a[2] * ic - bf_lo(w.y), a[3] * ic - bf_hi(w.y));
            o.z = cvt_pk_bf16(a[4] * ic - bf_lo(w.z), a[5] * ic - bf_hi(w.z)); o.w = cvt_pk_bf16(a[6] * ic - bf_lo(w.w), a[7] * ic - bf_hi(w.w));
            *(u32x4*)(BUFB + (size_t)t * DM + cc * 8) = o;
        }
        PH_END(2)
    PH_BEGIN(3)
        struct GrpSched { const char* A; const char* B; int G, c;
            __device__ __forceinline__ bool next(int i, pg8::Unit& u) const { const int L = i * G + c; if (L >= 256) return false; int pm, pn; pg8::tile_order(64, 4, L, pm, pn);
                u.A = A + (size_t)pm * 256 * 2048 + pn * 512; u.B = B + (size_t)pn * 65536 * 2; u.ldb = 512u; u.hsb = 128u * 512u; u.co = (size_t)pm * 256 * DM + pn * 256; u.tag = 0; return true; } };
        GrpSched S_{(const char*)BUFB, (const char*)(Wb + W_A_GRP), F.G, F.c}; pg8::EpiBf16 E_{BUFC, DM, BUFC, DM, nullptr, nullptr, nullptr};
        pg8::gemm_phase(ring, 256, 2048u, S_, E_); PH_END(3)
    PH_BEGIN(4) pg8::EpiResidT<true, true> E_{x_in, XA, PS}; PLAIN_GEMM(E_, BUFC, Wb + W_A_OUT, 1024, 2048, 2048, 64, 4, 256 * DM, 256); PH_END(4)
    DENSE_FFN(6, 0, XA, XB)
    PH_BEGIN(9)
        { QkvSched S_{(const char*)X8, (const char*)(Wb + W_B_QK), nullptr, 24, 0, 4, 2, F.G, F.c, 6144, 1024u};
          pg8::EpiBf16T<true, 10, 2> E_{BIG, 6144, VT, MTOK, PS, (const char*)X8, RTAB, F8_GU_UNSCALE}; pg8::gemm_phase<false, 1u>(ring, 512, 1024u, S_, E_); }
        { QkvSched S_{(const char*)XB, nullptr, (const char*)(Wb + W_B_V), 0, 3, 4, 2, F.G, F.c, 6144};
          pg8::EpiBf16T<true, 11, 2> E_{BIG, 6144, VT, MTOK, PS, (const char*)XB, RTAB}; pg8::gemm_phase(ring, 1024, 2048u, S_, E_); }
        PH_END(9)
    PH_BEGIN(10)
        LAS float* tbl = (LAS float*)(F.lds + BI_TAB + F.wave_() * 1280); LAS unsigned char* stgw = F.lds + F.wave_() * 16384;
        int lane10 = F.lane_(); asm volatile("" : "+v"(lane10));
        const int b10 = F.vcu >> 5, h10 = (F.vcu >> 1) & 15, half10 = F.vcu & 1;
        for (int i = 0; i < 6; ++i) {
            const int it = F.wave_() + 8 * i, g = it >> 4, k = it & 15;
            const int dil = (g == 0) ? 1 : (g == 1 ? 4 : 16), L = SEQ / dil;
            const int r = (g == 0) ? 0 : (g == 1 ? (k >> 2) : k), qb = (g == 0) ? 16 * half10 + k : (g == 1 ? 4 * half10 + (k & 3) : half10);
            band_item64q<64>((const unsigned char*)BIG + g * 1024 + h10 * 64, (const unsigned char*)BIG + 3072 + g * 1024 + h10 * 64, 6144, (size_t)b10 * SEQ + r, dil, L, qb * 64,
                            (const unsigned char*)VT + (size_t)(g * 1024 + h10 * 64) * MTOK, (size_t)b10 * SEQ + (size_t)r * L, gtab + h10 * 4096, tbl, stgw, NEG_BIG, 0.f,
                            OG + (size_t)g * MTOK * DM + h10 * 64, DM, LSE + (size_t)g * MTOK * 16 + h10, lane10);
        }
        asm volatile("s_waitcnt vmcnt(0)" ::: "memory"); __syncthreads();
        { const size_t tokb = (size_t)b10 * SEQ + (size_t)half10 * 1024;
        for (int rnd = 0; rnd < 4; ++rnd) {
            u32x4 a[4], b[4], c[4]; float l0[4], l1[4], l2[4]; size_t of[4];
#pragma unroll
            for (int q = 0; q < 4; ++q) { const int it = rnd * 2048 + q * 512 + F.tid_(); const size_t t = tokb + (size_t)(it >> 3); const int cc = it & 7;
                l0[q] = LSE[t * 16 + h10]; l1[q] = LSE[((size_t)MTOK + t) * 16 + h10]; l2[q] = LSE[((size_t)2 * MTOK + t) * 16 + h10];
                of[q] = t * DM + h10 * 64 + cc * 8;
                a[q] = *(const u32x4*)(OG + of[q]); b[q] = *(const u32x4*)(OG + (size_t)MTOK * DM + of[q]); c[q] = *(const u32x4*)(OG + 2 * (size_t)MTOK * DM + of[q]); }
#pragma unroll
            for (int q = 0; q < 4; ++q) {
                const float mx = fmaxf(l0[q], fmaxf(l1[q], l2[q])); float w0 = __builtin_amdgcn_exp2f(l0[q] - mx), w1 = __builtin_amdgcn_exp2f(l1[q] - mx), w2 = __builtin_amdgcn_exp2f(l2[q] - mx);
                const float inv = 1.0f / (w0 + w1 + w2); w0 *= inv; w1 *= inv; w2 *= inv;
                u32x4 r;
                r.x = cvt_pk_bf16(w0 * bf_lo(a[q].x) + w1 * bf_lo(b[q].x) + w2 * bf_lo(c[q].x), w0 * bf_hi(a[q].x) + w1 * bf_hi(b[q].x) + w2 * bf_hi(c[q].x));
                r.y = cvt_pk_bf16(w0 * bf_lo(a[q].y) + w1 * bf_lo(b[q].y) + w2 * bf_lo(c[q].y), w0 * bf_hi(a[q].y) + w1 * bf_hi(b[q].y) + w2 * bf_hi(c[q].y));
                r.z = cvt_pk_bf16(w0 * bf_lo(a[q].z) + w1 * bf_lo(b[q].z) + w2 * bf_lo(c[q].z), w0 * bf_hi(a[q].z) + w1 * bf_hi(b[q].z) + w2 * bf_hi(c[q].z));
                r.w = cvt_pk_bf16(w0 * bf_lo(a[q].w) + w1 * bf_lo(b[q].w) + w2 * bf_lo(c[q].w), w0 * bf_hi(a[q].w) + w1 * bf_hi(b[q].w) + w2 * bf_hi(c[q].w));
                *(u32x4*)(BUFA + of[q]) = r; }
        } }
        PH_END(10)
    PH_BEGIN(12) pg8::EpiResid E_{XB, XA, nullptr}; PLAIN_GEMM(E_, BUFA, Wb + W_B_OUT, 1024, 2048, 2048, 64, 4, 256 * DM, 256); PH_END(12)
    MOE_FFN(13, 0, XA, norm_ffn + DM)
    PH_BEGIN(17) moe_reduce_parts(F, PART, panel, YS); GRID_BAR(); moe_combine(F, XA, YS, PART, panel, r_p1, r_p2, r_g1, r_g2, norm_mix + 2 * DM, XB, HN, nullptr); PH_END(17)
    PH_BEGIN(18)
        QkvSched S_{(const char*)HN, (const char*)(Wb + W_C_QK), (const char*)(Wb + W_C_V), 8, 1, 4, 0, F.G, F.c, 2048, 1024u};
        pg8::EpiBf16T<false, 11, 1> E_{BIG, 2048, VT, MTOK, nullptr, nullptr, nullptr, F8_GU_UNSCALE}; pg8::gemm_phase<false, 1u>(ring, 512, 1024u, S_, E_); PH_END(18)
    PH_BEGIN(19)
        int tid = F.tid_(); asm volatile("" : "+v"(tid)); const int lane = tid & 63, wv = F.wave_();
        const int j = wv & 1, sub = wv >> 1, ql = lane & 31, hf = lane >> 5, kp = keyperm(ql), half1 = wv >> 2;
        LAS float* tabL = (LAS float*)(F.lds + DA_TAB);
        LAS unsigned char* bidL = F.lds + DA_BID;
        LAS float* xch = (LAS float*)(F.lds + DA_XCH);
        const float lam = misc[0], post = 1.0f - misc[1];
        i32x8 ones8; { int o1_ = 0x38383838; asm volatile("" : "+v"(o1_));
#pragma unroll
            for (int q = 0; q < 8; ++q) ones8[q] = o1_; }
        for (int q = tid; q < 1024; q += NWAVES * 64) ((LAS unsigned*)bidL)[q] = ((const unsigned*)(ws + WS_BID))[q];
        unsigned ka[2], va[2];
#pragma unroll
        for (int t = 0; t < 2; ++t) { ka[t] = (unsigned)(kp * 64 + (((2 * hf + t) ^ ((kp >> 2) & 3)) << 4)); va[t] = (unsigned)(ql * 64 + (((2 * hf + t) ^ ((ql >> 2) & 3)) << 4)); }
        const int kr = 16 * (wv & 3) + (lane >> 2), kc = (lane & 3) ^ ((kr >> 2) & 3);
        const int vr = 16 * wv + (lane >> 2), vc = (lane & 3) ^ ((vr >> 2) & 3);
        const unsigned koff = (unsigned)((wv >> 2) * 64 + kr * 2048 + kc * 16), voff = (unsigned)vr * (unsigned)MTOK + (unsigned)(vc * 16);
#define pk8(a_, b_, c_, d_) ((unsigned)__builtin_amdgcn_cvt_pk_fp8_f32((c_), (d_), __builtin_amdgcn_cvt_pk_fp8_f32((a_), (b_), 0, false), true))
#define DA_GLDS(g, l) __builtin_amdgcn_global_load_lds((const unsigned*)(g), (LAS unsigned*)(l), 16, 0, 0)
#define DA_ISSUE(tile, stage) do { LAS unsigned char* sb_ = F.lds + DA_STG + (stage) * 32768 + wv * 1024; const size_t kt_ = (size_t)(tile) * 64; \
            DA_GLDS(K0g + kt_ * 2048 + koff, sb_); DA_GLDS(Vg + kt_ + voff, sb_ + 16384); } while (0)
#define DA_BAR() do { __builtin_amdgcn_s_barrier(); asm volatile("" ::: "memory"); } while (0)
#define DA_WAIT_TILE(more) do { if (more) asm volatile("s_waitcnt vmcnt(2) lgkmcnt(0)" ::: "memory"); else asm volatile("s_waitcnt vmcnt(0) lgkmcnt(0)" ::: "memory"); } while (0)
#define DA_WAIT_LDS() asm volatile("s_waitcnt lgkmcnt(0)" ::: "memory")
#define DA_SEG_A(t_, sg_) do { \
            const LAS unsigned char* Kt = F.lds + DA_STG + (sg_) * 32768 + j * 4096; \
            const int kt = (t_) * 64, rel_lo = kt - q0 - 31, rel_hi = kt + 63 - q0; \
            const i32x8 kfa = __builtin_shufflevector(*(const LAS i32x4*)(Kt + ka[0]), *(const LAS i32x4*)(Kt + ka[1]), 0, 1, 2, 3, 4, 5, 6, 7); \
            const i32x8 kfb = __builtin_shufflevector(*(const LAS i32x4*)(Kt + 2048 + ka[0]), *(const LAS i32x4*)(Kt + 2048 + ka[1]), 0, 1, 2, 3, 4, 5, 6, 7); \
            const bool cst = (rel_lo > 0 || rel_hi < 0) && (__builtin_amdgcn_readfirstlane((int)bidL[rel_lo + 2048]) == __builtin_amdgcn_readfirstlane((int)bidL[rel_hi + 2048])); \
            if (cst) { const float cu = tabL[j * 4096 + rel_lo + 2048]; \
                { const float c = cu - mhat; \
                  if (__any(c != c_last)) { c_last = c; \
                    _Pragma("unroll") for (int r = 0; r < 16; ++r) ci[r] = c; } } \
                asm volatile("s_waitcnt lgkmcnt(0)" ::: "memory"); \
                s0 = __builtin_amdgcn_mfma_scale_f32_32x32x64_f8f6f4(kfa, qf, ci, 0, 0, 0, 0, 0, 0); s1 = __builtin_amdgcn_mfma_scale_f32_32x32x64_f8f6f4(kfb, qf, ci, 0, 0, 0, 0, 0, 0); } \
            else { const LAS float* bt = tabL + j * 4096 + kt + 8 * hf - (q0 + ql) + 2048; \
                _Pragma("unroll") for (int r = 0; r < 16; ++r) { s0[r] = bt[(r >> 3) * 16 + (r & 7)] - mhat; s1[r] = bt[32 + (r >> 3) * 16 + (r & 7)] - mhat; } \
                asm volatile("s_waitcnt lgkmcnt(0)" ::: "memory"); \
                s0 = __builtin_amdgcn_mfma_scale_f32_32x32x64_f8f6f4(kfa, qf, s0, 0, 0, 0, 0, 0, 0); s1 = __builtin_amdgcn_mfma_scale_f32_32x32x64_f8f6f4(kfb, qf, s1, 0, 0, 0, 0, 0, 0); } \
            float mx = __builtin_fmaxf(s0[0], s1[0]), mx2 = __builtin_fmaxf(s0[1], s1[1]); \
            _Pragma("unroll") for (int r = 2; r < 16; r += 2) { mx = __builtin_fmaxf(__builtin_fmaxf(mx, s0[r]), s1[r]); mx2 = __builtin_fmaxf(__builtin_fmaxf(mx2, s0[r + 1]), s1[r + 1]); } \
            mx = __builtin_fmaxf(mx, mx2); \
            { const unsigned mu = __float_as_uint(mx); auto rr2 = __builtin_amdgcn_permlane32_swap(mu, mu, false, false); mx = fmaxf(__uint_as_float(rr2[0]), __uint_as_float(rr2[1])); } \
            if ((t_) == 0) { const float d0 = mx - 4.0f; mhat = d0; \
                _Pragma("unroll") for (int r = 0; r < 16; ++r) { s0[r] -= d0; s1[r] -= d0; } } \
            else if (__any(mx > 8.0f)) { const float dl = fmaxf(mx - 4.0f, 0.f), f = __builtin_amdgcn_exp2f(-dl); mhat += dl; o5 = o5 * f; \
                _Pragma("unroll") for (int r = 0; r < 16; ++r) { s0[r] -= dl; s1[r] -= dl; } \
                _Pragma("unroll") for (int bb = 0; bb < 4; ++bb) o[bb] = o[bb] * f; } \
        } while (0)
#define DA_SEG_B(sg_) do { \
            const LAS unsigned char* Vt_ = F.lds + DA_STG + (sg_) * 32768 + 16384; i32x8 vf8[4]; \
            _Pragma("unroll") for (int bb = 0; bb < 4; ++bb) { const i32x4 lo_ = *(const LAS i32x4*)(Vt_ + bb * 2048 + va[0]), hi_ = *(const LAS i32x4*)(Vt_ + bb * 2048 + va[1]); \
                vf8[bb] = __builtin_shufflevector(lo_, hi_, 0, 1, 2, 3, 4, 5, 6, 7); } \
            asm volatile("" ::: "memory"); \
            _Pragma("unroll") for (int r = 0; r < 16; ++r) { s0[r] = __builtin_amdgcn_exp2f(s0[r]); s1[r] = __builtin_amdgcn_exp2f(s1[r]); } \
            i32x8 p8; p8[0] = (int)pk8(s0[0], s0[1], s0[2], s0[3]); p8[1] = (int)pk8(s0[4], s0[5], s0[6], s0[7]); p8[2] = (int)pk8(s0[8], s0[9], s0[10], s0[11]); p8[3] = (int)pk8(s0[12], s0[13], s0[14], s0[15]); \
            p8[4] = (int)pk8(s1[0], s1[1], s1[2], s1[3]); p8[5] = (int)pk8(s1[4], s1[5], s1[6], s1[7]); p8[6] = (int)pk8(s1[8], s1[9], s1[10], s1[11]); p8[7] = (int)pk8(s1[12], s1[13], s1[14], s1[15]); \
            __builtin_amdgcn_s_setprio(1); \
            _Pragma("unroll") for (int bb = 0; bb < 4; ++bb) o[bb] = __builtin_amdgcn_mfma_scale_f32_32x32x64_f8f6f4(vf8[bb], p8, o[bb], 0, 0, 0, 0, 0, 0); \
            o5 = __builtin_amdgcn_mfma_scale_f32_32x32x64_f8f6f4(ones8, p8, o5, 0, 0, 0, 0, 0, 0);         \
            __builtin_amdgcn_s_setprio(0); \
        } while (0)
        int last_h = -1;
        for (int i = 0; i < 4; ++i) {
            const int u = i * F.G + F.vcu; if (u >= 1024) break;
            const int b = u >> 7, h = (u >> 4) & 7, qblk = u & 15;
            __syncthreads();
            if (h != last_h) { for (int q = tid; q < 2 * 4096; q += NWAVES * 64) tabL[q] = gtab[(2 * h) * 4096 + q]; last_h = h; }
            const size_t tok0 = (size_t)b * SEQ; const int q0 = qblk * 128 + sub * 32;
            const char* K0g = (const char*)BIG + tok0 * 2048 + 1024 + (2 * h) * 64;
            const char* Vg = (const char*)VT + (size_t)(h * 128) * MTOK + tok0;
            const size_t qtok = tok0 + q0 + ql;
            i32x8 qf; { const i32x4* qp_ = (const i32x4*)((const char*)BIG + qtok * 2048 + (2 * h + j) * 64 + 32 * hf); qf = __builtin_shufflevector(qp_[0], qp_[1], 0, 1, 2, 3, 4, 5, 6, 7); }
            DA_ISSUE(0, 0); DA_ISSUE(1, 1);
            f32x16 o[4];
#pragma unroll
            for (int bb = 0; bb < 4; ++bb) o[bb] = (f32x16){};
            float mhat = 0.f, c_last = __builtin_nanf("");
            f32x16 o5 = (f32x16){}, ci = (f32x16){};
            f32x16 s0, s1;
            DA_WAIT_TILE(true); DA_BAR();
            if (half1 == 0) {
                int sg = 0;
                for (int t = 0; t < 32; ++t) {
                    DA_SEG_A(t, sg); DA_WAIT_LDS(); DA_BAR();
                    if (t + 2 < 32) { const int s2 = (sg >= 1) ? sg - 1 : 2; DA_ISSUE(t + 2, s2); }
                    DA_SEG_B(sg); DA_WAIT_TILE(t + 2 < 32); DA_BAR();
                    sg = (sg == 2) ? 0 : sg + 1;
                }
                DA_BAR();
            } else {
                DA_BAR();
                int sg = 0;
                for (int t = 0; t < 32; ++t) {
                    if (t + 2 < 32) { const int s2 = (sg >= 1) ? sg - 1 : 2; DA_ISSUE(t + 2, s2); }
                    DA_SEG_A(t, sg); DA_WAIT_TILE(t + 2 < 32); DA_BAR();
                    DA_SEG_B(sg); DA_WAIT_LDS(); DA_BAR();
                    sg = (sg == 2) ? 0 : sg + 1;
                }
            }
            const float lt = o5[0], inv = (1.0f / ACT8_SCALE) / lt;
            __syncthreads();
            if (j == 1) {
#pragma unroll
                for (int bb = 0; bb < 4; ++bb)
#pragma unroll
                    for (int r = 0; r < 16; ++r) xch[(sub * 64 + bb * 16 + r) * 64 + lane] = o[bb][r] * inv;
            }
            __syncthreads();
            if (j == 0) {
                float ss = 0.f;
#pragma unroll
                for (int bb = 0; bb < 4; ++bb)
#pragma unroll
                    for (int r = 0; r < 16; ++r) { const float v = o[bb][r] * inv - lam * xch[(sub * 64 + bb * 16 + r) * 64 + lane]; o[bb][r] = v; ss += v * v; }
                ss += __shfl_xor(ss, 32);
                const float rstd = post / sqrtf(ss * (1.0f / 128.0f) + RMS_EPS);
                const float* sg_ = args.in[13];
                unsigned char* orow = (unsigned char*)BUFA + qtok * DM + h * 128;
                const float rs8 = rstd * ACT8_SCALE;
#pragma unroll
                for (int bb = 0; bb < 4; ++bb)
#pragma unroll
                    for (int i4 = 0; i4 < 4; ++i4) { const int d = 32 * bb + 8 * i4 + 4 * hf; const f32x4 gg = *(const f32x4*)(sg_ + d);
                        *(unsigned*)(orow + d) = pg8::pack_fp8x4(o[bb][4 * i4] * gg.x, o[bb][4 * i4 + 1] * gg.y, o[bb][4 * i4 + 2] * gg.z, o[bb][4 * i4 + 3] * gg.w, rs8); }
            }
        }
#undef DA_GLDS
#undef DA_ISSUE
#undef DA_BAR
#undef DA_WAIT_TILE
#undef DA_WAIT_LDS
#undef DA_SEG_A
#undef DA_SEG_B
        PH_END(19)
    PH_BEGIN(20) pg8::EpiResidT<false, true, 3> E_{XB, XA, PS, X8}; PlainSched S_{(const char*)BUFA, (const char*)(Wb + W_C_OUT), 1024u, 1024u, 64, 4, F.G, F.c, (size_t)256 * DM, (size_t)256}; pg8::gemm_phase<false, 1u>(ring, 512, 1024u, S_, E_); PH_END(20)
    DENSE_FFN8(22, 1, XA, XB)
    PH_BEGIN(25)
        QkvSched S_{(const char*)X8, (const char*)(Wb + W_D_QK), (const char*)(Wb + W_D_V), 5, 1, 1, 0, F.G, F.c, 1280, 1024u};
        pg8::EpiBf16T<true, 10, 2> E_{BIG, 1280, VT, MTOK, PS, (const char*)X8, RTAB, F8_GU_UNSCALE}; pg8::gemm_phase<false, 1u>(ring, 512, 1024u, S_, E_); PH_END(25)
    PH_BEGIN(26)
        LAS float* tbl = (LAS float*)(F.lds + BI_TAB + F.wave_() * 1280); LAS unsigned char* stgw = F.lds + F.wave_() * 16384;
        const float* sink = args.in[16];
        int lane26 = F.lane_(); asm volatile("" : "+v"(lane26));
        for (int i = 0; i < 2; ++i) {
            const int w = (i * F.G + F.vcu) * NWAVES + F.wave_(); if (w >= 4096) break;
            const int b = w >> 9, kvh = (w >> 7) & 3, qb = (w >> 2) & 31, qh = kvh * 4 + (w & 3);
            band_item64q<128, true>((const unsigned char*)BIG + qh * 64, (const unsigned char*)BIG + 1024 + kvh * 64, 1280, (size_t)b * SEQ, 1, SEQ, qb * 64,
                             (const unsigned char*)VT + (size_t)(kvh * 64) * MTOK, (size_t)b * SEQ, gtab + qh * 4096, tbl, stgw, sink[qh] * LOG2E, 1.0f,
                             (bf16_t*)((unsigned char*)BUFA + qh * 64), DM, nullptr, lane26);
        }
        PH_END(26)
    PH_BEGIN(27) pg8::EpiResidT<false, false, 2> E_{XB, XA, nullptr, nullptr}; PlainSched S_{(const char*)BUFA, (const char*)(Wb + W_D_OUT), 1024u, 1024u, 64, 4, F.G, F.c, (size_t)256 * DM, (size_t)256}; pg8::gemm_phase<false, 1u>(ring, 512, 1024u, S_, E_); PH_END(27)
    MOE_FFN(28, 1, XA, norm_ffn + 3 * DM)
    PH_BEGIN(32) moe_reduce_parts(F, PART, panel, YS); GRID_BAR(); moe_combine(F, XA, YS, PART, panel, r_p1, r_p2, r_g1, r_g2, norm_final, nullptr, nullptr, args.out); } }
#undef IN
#undef SEAM
}
constexpr int N_PHASES = 33;

extern "C" void kernel_launch(void* const* d_in, const int* in_sizes, int n_in, void* d_out, int out_size, void* d_ws, size_t ws_size, hipStream_t stream) {
    static int grid = 0;
    if (grid == 0) {
        if (n_in != 23 || out_size != MTOK * DM || ws_size < WS_END) { fprintf(stderr, "kernel_launch: unexpected problem (n_in %d, out %d, ws %zu, need %zu)\n", n_in, out_size, ws_size, (size_t)WS_END); grid = -1; return; }
        int dev = 0, cus = 0, per_cu = 0;
        if (hipGetDevice(&dev) != hipSuccess || hipDeviceGetAttribute(&cus, hipDeviceAttributeMultiprocessorCount, dev) != hipSuccess) { grid = -1; return; }
        if (hipFuncSetAttribute((const void*)enc_fwd, hipFuncAttributeMaxDynamicSharedMemorySize, LDS_BYTES) != hipSuccess) { fprintf(stderr, "kernel_launch: hipFuncSetAttribute failed\n"); grid = -1; return; }
        if (hipOccupancyMaxActiveBlocksPerMultiprocessor(&per_cu, (const void*)enc_fwd, NWAVES * 64, LDS_BYTES) != hipSuccess || per_cu < 1)
            fprintf(stderr, "kernel_launch: occupancy query reports %d workgroups per CU\n", per_cu);
        (void)hipGetLastError();
        grid = cus;
    }
    if (grid < 0) return;
    if (hipMemsetAsync((char*)d_ws + WS_CTL, 0, CTL_ZERO_BYTES, stream) != hipSuccess) return;
    Args a{};
    for (int i = 0; i < 23; ++i) a.in[i] = (const float*)d_in[i];
    a.out = (float*)d_out; a.ws = (unsigned char*)d_ws;
#if MK_MULTI
    for (int p = 0; p < N_PHASES; ++p) { a.ph_lo = p; a.ph_hi = p + 1; hipLaunchKernelGGL(enc_fwd, dim3(grid), dim3(NWAVES * 64), LDS_BYTES, stream, a); }
#else
    a.ph_lo = 0; a.ph_hi = N_PHASES;
    hipLaunchKernelGGL(enc_fwd, dim3(grid), dim3(NWAVES * 64), LDS_BYTES, stream, a);
#endif
}
```

```cpp
#include <hip/hip_runtime.h>
#include <cstdio>
#include <cstdint>

#ifndef PROBE_MASK
#define PROBE_MASK 0ull
#endif
#ifndef PROBE_N
#define PROBE_N 2
#endif
#ifndef SLOW_MASK
#define SLOW_MASK 0ull
#endif
#ifndef MOE_SPLIT
#define MOE_SPLIT 1
#endif
#ifndef EXTRA_BARS
#define EXTRA_BARS 0
#endif
#ifndef EPI_TWICE
#define EPI_TWICE 0
#endif
#ifndef GEMM_STAGGER
#define GEMM_STAGGER 0
#endif
#ifndef MK_MULTI
#define MK_MULTI 0
#endif

#define LAS __attribute__((address_space(3)))
#define GAS __attribute__((address_space(1)))
typedef unsigned short bf16_t;
typedef short bf16x8 __attribute__((ext_vector_type(8)));
typedef float f32x4 __attribute__((ext_vector_type(4)));
typedef float f32x16 __attribute__((ext_vector_type(16)));
typedef unsigned u32x4 __attribute__((ext_vector_type(4)));
typedef unsigned u32x2 __attribute__((ext_vector_type(2)));
typedef int i32x4 __attribute__((ext_vector_type(4)));
typedef int i32x8 __attribute__((ext_vector_type(8)));

constexpr int NB = 8, SEQ = 2048, DM = 1024, MTOK = NB * SEQ, DFF = 3584, NE = 8;
constexpr int MP_MAX = 2 * MTOK + NE * 256;
constexpr int NPANEL_MAX = MP_MAX / 256;
constexpr float RMS_EPS = 1e-6f;
constexpr float LOG2E = 1.4426950408889634f;
#define DENSE_F8(l) ((l) == 1)
constexpr float ACT8_SCALE = 8.0f;
constexpr unsigned F8_GU = 1u, F8_DN = 1u;
constexpr float F8_GU_UNSCALE = 1.0f / 256.0f, F8_DN_UNSCALE = 1.0f / 1024.0f;
constexpr float QSCALE = 0.125f * LOG2E;
constexpr float NEG_BIG = -1e30f;
constexpr int NWAVES = 8;

constexpr size_t MiB = 1ull << 20;
constexpr size_t WS_CTL = 0, CTL_ZERO_BYTES = 1 * MiB;
constexpr size_t WS_TAB = 1 * MiB;
constexpr size_t WS_MISC = WS_TAB + 256 * 1024;
constexpr size_t WS_BID = WS_MISC + 4096;
constexpr size_t WS_ROUTE = 2 * MiB;
constexpr size_t WS_PS = WS_ROUTE + 1 * MiB;
constexpr size_t WS_CNT = WS_ROUTE + 384 * 1024;
constexpr size_t WS_PANEL = WS_ROUTE + 448 * 1024;
constexpr size_t WS_W = 4 * MiB;
constexpr size_t W_A_IN = 0, W_A_GRP = W_A_IN + 1048576, W_A_OUT = W_A_GRP + 262144, W_B_QK = W_A_OUT + 1048576, W_B_V = W_B_QK + 6144 * 1024,
                 W_B_OUT = W_B_V + 3072 * 1024, W_C_QK = W_B_OUT + 1048576, W_C_V = W_C_QK + 2048 * 1024, W_C_OUT = W_C_V + 1048576,
                 W_D_QK = W_C_OUT + 1048576, W_D_V = W_D_QK + 1280 * 1024, W_D_OUT = W_D_V + 256 * 1024, W_F_GU = W_D_OUT + 1048576,
                 W_F_D = W_F_GU + 2 * 7168 * 1024, W_M_GU = W_F_D + 2 * 3584 * 1024, W_M_D = W_M_GU + 16ull * 7168 * 1024, W_END = W_M_D + 16ull * 3584 * 1024;
constexpr size_t WS_XA = WS_W + ((W_END * 2 + MiB - 1) / MiB) * MiB;
constexpr size_t WS_XB = WS_XA + 64 * MiB;
constexpr size_t WS_HN = WS_XB + 64 * MiB;
constexpr size_t WS_BUFA = WS_HN + 32 * MiB;
constexpr size_t WS_BUFB = WS_BUFA + 32 * MiB;
constexpr size_t WS_BUFC = WS_BUFB + 32 * MiB;
constexpr size_t WS_BIG = WS_BUFC + 32 * MiB;
constexpr size_t WS_VT = WS_BIG + 240 * MiB;
constexpr size_t WS_OG = WS_VT + 96 * MiB;
constexpr size_t WS_LSE = WS_OG + 96 * MiB;
constexpr size_t WS_PART = WS_LSE + 4 * MiB;
constexpr size_t WS_END = WS_PART + 64 * MiB;
constexpr int CW_BAR = 4096;
constexpr int RING_BYTES = 131072, LDSCTL_OFF = RING_BYTES, MISC_OFF = LDSCTL_OFF + 320, LDS_BYTES = 147456;
constexpr int BI_TAB = RING_BYTES + 1024;
constexpr int DA_TAB = 0, DA_STG = 32768, DA_XCH = 32768, DA_BID = RING_BYTES + 1024;

__device__ __forceinline__ unsigned cvt_pk_bf16(float lo, float hi) { unsigned r; asm volatile("v_cvt_pk_bf16_f32 %0, %1, %2" : "=v"(r) : "v"(lo), "v"(hi)); return r; }
__device__ __forceinline__ float bf_lo(unsigned w) { return __uint_as_float(w << 16); }
__device__ __forceinline__ float bf_hi(unsigned w) { return __uint_as_float(w & 0xffff0000u); }
__device__ __forceinline__ float wave_sum(float v) {
#pragma unroll
    for (int o = 1; o < 64; o <<= 1) v += __shfl_xor(v, o);
    return v;
}
#define LDS_WAIT() asm volatile("s_waitcnt lgkmcnt(0)" ::: "memory")
#define VM_WAIT() asm volatile("s_waitcnt vmcnt(0)" ::: "memory")

namespace pg8 {
constexpr int BM = 256, BK = 64, HALF = 128, HTB = HALF * BK * 2, STAGE_BYTES = 8 * HTB, NXCD = 8, WGM = 8;
__host__ __device__ __forceinline__ int lds_byte(int r, int c) { const int st = (r >> 4) * 2 + (c >> 5), rr = r & 15, cc = c & 31, ob = rr * 64 + cc * 2; return st * 1024 + (ob ^ (((ob >> 9) & 1) << 5)); }
__host__ __device__ __forceinline__ void stage_rc(int b, int& R, int& C) { const int st = b / 1024, sb = b % 1024, swz = sb ^ (((sb >> 9) & 1) << 5); R = (st >> 1) * 16 + swz / 64; C = (st & 1) * 32 + (swz % 64) / 2; }
__host__ __device__ __forceinline__ int perm32(int rho) { const int n = rho >> 4, i = rho & 15; return 8 * (i >> 2) + 4 * n + (i & 3); }

struct Unit { const char* A; const char* B; unsigned ldb, hsb; size_t co; int tag; const int* ridx; int par; };

__device__ __forceinline__ void tile_order(int nM, int nN, int L, int& pm, int& pn) {
    const int nwg = nM * nN; int wgid = L;
    { const int q = nwg / NXCD, r = nwg % NXCD, xcd = wgid % NXCD, off = wgid / NXCD; wgid = (xcd < r ? xcd * (q + 1) : r * (q + 1) + (xcd - r) * q) + off; }
    const int nig = WGM * nN, gid = wgid / nig, fm = gid * WGM, gsz = (nM - fm) < WGM ? (nM - fm) : WGM;
    pm = fm + ((wgid % nig) % gsz); pn = (wgid % nig) / gsz;
}

__device__ __forceinline__ i32x8 cat8(bf16x8 a, bf16x8 b) { const i32x4 x = __builtin_bit_cast(i32x4, a), y = __builtin_bit_cast(i32x4, b); return __builtin_shufflevector(x, y, 0, 1, 2, 3, 4, 5, 6, 7); }
__device__ __forceinline__ void mfma_f8(f32x4& c, const i32x8 a, const i32x8 b) { asm volatile("v_mfma_f32_16x16x128_f8f6f4 %0, %1, %2, %0" : "+v"(c) : "v"(a), "v"(b)); }
__device__ __forceinline__ unsigned pack_fp8x4(float a, float b, float c, float d, float sc) {
    const float ta = __builtin_amdgcn_fmed3f(a * sc, -448.f, 448.f), tb = __builtin_amdgcn_fmed3f(b * sc, -448.f, 448.f);
    const float tc = __builtin_amdgcn_fmed3f(c * sc, -448.f, 448.f), td = __builtin_amdgcn_fmed3f(d * sc, -448.f, 448.f);
    int w = __builtin_amdgcn_cvt_pk_fp8_f32(ta, tb, 0, false); w = __builtin_amdgcn_cvt_pk_fp8_f32(tc, td, w, true); return (unsigned)w;
}
__device__ __forceinline__ void zero_acc(f32x4 (&acc)[2][2][4][2]) {
#pragma unroll
    for (int a = 0; a < 2; ++a)
#pragma unroll
        for (int b = 0; b < 2; ++b)
#pragma unroll
            for (int m = 0; m < 4; ++m)
#pragma unroll
                for (int n = 0; n < 2; ++n) acc[a][b][m][n] = (f32x4){0.f, 0.f, 0.f, 0.f};
}
__device__ __forceinline__ float rstd_of(const float* ps16, size_t token) {
    const f32x4* p = (const f32x4*)(ps16 + token * 16); const f32x4 a = p[0], b = p[1], c = p[2], d = p[3];
    const float s = (((a.x + a.y) + (a.z + a.w)) + ((b.x + b.y) + (b.z + b.w))) + (((c.x + c.y) + (c.z + c.w)) + ((d.x + d.y) + (d.z + d.w)));
    return __builtin_amdgcn_rsqf(s * (1.0f / DM) + RMS_EPS);
}
template <bool RS, int XSH = 11, int O8 = 0> struct EpiBf16T {
    static constexpr bool PERM = true; static constexpr bool VPERM = (O8 == 1);
    bf16_t* out0; int ld0; bf16_t* out1; int ld1; const float* __restrict__ ps; const char* xbase; LAS float* rtab; float osc = 1.0f;
    __device__ __forceinline__ void unit_begin(Unit& u, size_t& key, int& par) const {
        if constexpr (RS) { const size_t k = u.tag ? ((size_t)u.B ^ ((size_t)u.ldb << 44) ^ 1u) : (size_t)u.A;
            if (k != key) { key = k; par ^= 1; const int t = threadIdx.x; if (t < 256) { size_t tok;
                if (u.tag) tok = ((size_t)(u.B - xbase) >> XSH) + (size_t)(t >> 7) * (u.hsb >> XSH) + (size_t)(t & 127) * (u.ldb >> XSH); else tok = ((size_t)(u.A - xbase) >> XSH) + t;
                rtab[par * 256 + t] = rstd_of(ps, tok) * osc; } }
            u.par = par; }
    }
    __device__ __forceinline__ void init(f32x4 (&acc)[2][2][4][2], const Unit&, int, int, int, int) const { zero_acc(acc); }
    __device__ __forceinline__ void operator()(const f32x4 (&acc)[2][2][4][2], const Unit& u, int wr, int wc, int fr, int fq) const {
        bf16_t* base = (u.tag ? out1 : out0) + u.co; const int ldc = u.tag ? ld1 : ld0;
        int r0 = wr * 64 + fr; asm volatile("" : "+v"(r0));
        const LAS float* tb = rtab + u.par * 256;
#pragma unroll
        for (int ai = 0; ai < 2; ++ai)
#pragma unroll
            for (int m = 0; m < 4; ++m) { bf16_t* rowp = base + (unsigned)((ai * HALF + m * 16 + r0) * ldc + wc * 32 + 8 * fq);
#pragma unroll
                for (int bj = 0; bj < 2; ++bj) { f32x4 v0 = acc[ai][bj][m][0], v1 = acc[ai][bj][m][1];
                    if constexpr (!RS) { v0 = v0 * osc; v1 = v1 * osc; }
                    if constexpr (RS) { if (u.tag) { const f32x4 c0 = *(const LAS f32x4*)(tb + bj * HALF + wc * 32 + 8 * fq), c1 = *(const LAS f32x4*)(tb + bj * HALF + wc * 32 + 8 * fq + 4); v0 = v0 * c0; v1 = v1 * c1; }
                                        else { const float rs = tb[ai * HALF + m * 16 + r0]; v0 = v0 * rs; v1 = v1 * rs; } }
                    if constexpr (O8 != 0) { unsigned char* bp = (unsigned char*)(u.tag ? out1 : out0) + u.co + (unsigned)((ai * HALF + m * 16 + r0) * (u.tag ? ld1 : ld0) + wc * 32 + 8 * fq) + bj * HALF; const float sc8 = u.tag ? ACT8_SCALE : 1.0f;
                        u32x2 q; q.x = pack_fp8x4(v0[0], v0[1], v0[2], v0[3], sc8); q.y = pack_fp8x4(v1[0], v1[1], v1[2], v1[3], sc8); *(u32x2*)bp = q; continue; }
                    u32x4 w; w.x = cvt_pk_bf16(v0[0], v0[1]); w.y = cvt_pk_bf16(v0[2], v0[3]); w.z = cvt_pk_bf16(v1[0], v1[1]); w.w = cvt_pk_bf16(v1[2], v1[3]);
                    *(u32x4*)(rowp + bj * HALF) = w; } }
    }
};
typedef EpiBf16T<false> EpiBf16;
struct EpiYs8 {
    static constexpr bool PERM = true; static constexpr bool VPERM = false;
    bf16_t* out;
    __device__ __forceinline__ void unit_begin(Unit&, size_t&, int&) const {}
    __device__ __forceinline__ void init(f32x4 (&acc)[2][2][4][2], const Unit&, int, int, int, int) const { zero_acc(acc); }
    __device__ __forceinline__ void operator()(const f32x4 (&acc)[2][2][4][2], const Unit& u, int wr, int wc, int fr, int fq) const {
        bf16_t* base = out + u.co;
        int r0 = wr * 64 + fr; asm volatile("" : "+v"(r0));
#pragma unroll
        for (int ai = 0; ai < 2; ++ai)
#pragma unroll
            for (int m = 0; m < 4; ++m) { bf16_t* rowp = base + (unsigned)((ai * HALF + m * 16 + r0) * DM + wc * 32 + 8 * fq);
#pragma unroll
                for (int bj = 0; bj < 2; ++bj) { const f32x4 v0 = acc[ai][bj][m][0] * F8_DN_UNSCALE, v1 = acc[ai][bj][m][1] * F8_DN_UNSCALE;
                    u32x4 w; w.x = cvt_pk_bf16(v0[0], v0[1]); w.y = cvt_pk_bf16(v0[2], v0[3]); w.z = cvt_pk_bf16(v1[0], v1[1]); w.w = cvt_pk_bf16(v1[2], v1[3]);
                    *(u32x4*)(rowp + bj * HALF) = w; } }
    }
};
template <bool RS> struct EpiSwigluT {
    static constexpr bool PERM = true; static constexpr bool VPERM = false;
    bf16_t* out; int ldc; const float* __restrict__ ps; const char* xbase; LAS float* rtab;
    __device__ __forceinline__ void unit_begin(Unit& u, size_t& key, int& par) const {
        if constexpr (RS) { const size_t k = (size_t)u.A;
            if (k != key) { key = k; par ^= 1; const int t = threadIdx.x; if (t < 256) rtab[par * 256 + t] = rstd_of(ps, ((size_t)(u.A - xbase) >> 11) + t); }
            u.par = par; }
    }
    __device__ __forceinline__ void init(f32x4 (&acc)[2][2][4][2], const Unit&, int, int, int, int) const { zero_acc(acc); }
    __device__ __forceinline__ void operator()(const f32x4 (&acc)[2][2][4][2], const Unit& u, int wr, int wc, int fr, int fq) const {
        bf16_t* base = out + u.co;
        int r0 = wr * 64 + fr; asm volatile("" : "+v"(r0));
#pragma unroll
        for (int ai = 0; ai < 2; ++ai)
#pragma unroll
            for (int m = 0; m < 4; ++m) { bf16_t* rowp = base + (unsigned)((ai * HALF + m * 16 + r0) * ldc + wc * 32 + 8 * fq);
                float rs = 1.0f; if constexpr (RS) rs = rtab[u.par * 256 + ai * HALF + m * 16 + r0];
                float r[8];
                const float c2 = -rs * LOG2E, iK = RS ? __builtin_amdgcn_rcpf(rs * rs) : 1.0f;
#pragma unroll
                for (int n = 0; n < 2; ++n)
#pragma unroll
                    for (int j = 0; j < 4; ++j) { const float G = acc[ai][0][m][n][j], U = acc[ai][1][m][n][j];
                        r[n * 4 + j] = (G * U) * __builtin_amdgcn_rcpf(__builtin_fmaf(__builtin_amdgcn_exp2f(G * c2), iK, iK)); }
                u32x4 w; w.x = cvt_pk_bf16(r[0], r[1]); w.y = cvt_pk_bf16(r[2], r[3]); w.z = cvt_pk_bf16(r[4], r[5]); w.w = cvt_pk_bf16(r[6], r[7]);
                *(u32x4*)rowp = w; }
    }
};
typedef EpiSwigluT<false> EpiSwiglu;
template <bool RS, int XSH = 10, bool BF16GEMM = false> struct EpiSwiglu8T {
    static constexpr bool PERM = true; static constexpr bool VPERM = false;
    static constexpr float GSC = BF16GEMM ? 1.0f : F8_GU_UNSCALE;
    unsigned char* out; int ldc; const float* __restrict__ ps; const char* xbase; LAS float* rtab;
    __device__ __forceinline__ void unit_begin(Unit& u, size_t& key, int& par) const {
        if constexpr (RS) { const size_t k = (size_t)u.A;
            if (k != key) { key = k; par ^= 1; const int t = threadIdx.x; if (t < 256) rtab[par * 256 + t] = rstd_of(ps, ((size_t)(u.A - xbase) >> XSH) + t); }
            u.par = par; }
    }
    __device__ __forceinline__ void init(f32x4 (&acc)[2][2][4][2], const Unit&, int, int, int, int) const { zero_acc(acc); }
    __device__ __forceinline__ void operator()(const f32x4 (&acc)[2][2][4][2], const Unit& u, int wr, int wc, int fr, int fq) const {
        unsigned char* base = out + u.co;
        int r0 = wr * 64 + fr; asm volatile("" : "+v"(r0));
#pragma unroll
        for (int ai = 0; ai < 2; ++ai)
#pragma unroll
            for (int m = 0; m < 4; ++m) { unsigned char* rowp = base + (unsigned)((ai * HALF + m * 16 + r0) * ldc + wc * 32 + 8 * fq);
                float rs = GSC; if constexpr (RS) rs *= rtab[u.par * 256 + ai * HALF + m * 16 + r0];
                const float c2 = -rs * LOG2E, iK = RS ? __builtin_amdgcn_rcpf(ACT8_SCALE * rs * rs) : 1.0f / (ACT8_SCALE * GSC * GSC);
                float r[8];
#pragma unroll
                for (int n = 0; n < 2; ++n)
#pragma unroll
                    for (int j = 0; j < 4; ++j) { const float G = acc[ai][0][m][n][j], U = acc[ai][1][m][n][j];
                        r[n * 4 + j] = (G * U) * __builtin_amdgcn_rcpf(__builtin_fmaf(__builtin_amdgcn_exp2f(G * c2), iK, iK)); }
                u32x2 w; w.x = pack_fp8x4(r[0], r[1], r[2], r[3], 1.0f); w.y = pack_fp8x4(r[4], r[5], r[6], r[7], 1.0f);
                *(u32x2*)rowp = w; }
    }
};
typedef EpiSwiglu8T<false> EpiSwiglu8;
template <bool F32IN, bool NORM = false, int MODE = 0> struct EpiResidT {
    static constexpr bool PERM = true; static constexpr bool VPERM = false;
    const void* __restrict__ resid; bf16_t* __restrict__ out; float* __restrict__ ps; unsigned char* __restrict__ x8;
    __device__ __forceinline__ void unit_begin(Unit&, size_t&, int&) const {}
    __device__ __forceinline__ void init(f32x4 (&acc)[2][2][4][2], const Unit& u, int wr, int wc, int fr, int fq) const {
        int r0 = wr * 64 + fr; asm volatile("" : "+v"(r0));
#pragma unroll
        for (int ai = 0; ai < 2; ++ai)
#pragma unroll
            for (int m = 0; m < 4; ++m) { const size_t off = u.co + (unsigned)((ai * HALF + m * 16 + r0) * DM + wc * 32 + 8 * fq);
#pragma unroll
                for (int bj = 0; bj < 2; ++bj) {
                    if constexpr (F32IN) { const float* p = (const float*)resid + off + bj * HALF; acc[ai][bj][m][0] = *(const f32x4*)p; acc[ai][bj][m][1] = *(const f32x4*)(p + 4); }
                    else { const u32x4 w = *(const u32x4*)((const bf16_t*)resid + off + bj * HALF);
                        acc[ai][bj][m][0] = (f32x4){bf_lo(w.x), bf_hi(w.x), bf_lo(w.y), bf_hi(w.y)}; acc[ai][bj][m][1] = (f32x4){bf_lo(w.z), bf_hi(w.z), bf_lo(w.w), bf_hi(w.w)}; }
                    if constexpr ((MODE & 2) != 0) { acc[ai][bj][m][0] = acc[ai][bj][m][0] * (1.0f / F8_DN_UNSCALE); acc[ai][bj][m][1] = acc[ai][bj][m][1] * (1.0f / F8_DN_UNSCALE); } } }
    }
    __device__ __forceinline__ void operator()(const f32x4 (&acc)[2][2][4][2], const Unit& u, int wr, int wc, int fr, int fq) const {
        int r0 = wr * 64 + fr; asm volatile("" : "+v"(r0));
#pragma unroll
        for (int ai = 0; ai < 2; ++ai)
#pragma unroll
            for (int m = 0; m < 4; ++m) { const size_t off = u.co + (unsigned)((ai * HALF + m * 16 + r0) * DM + wc * 32 + 8 * fq);
                float ss = 0.f;
#pragma unroll
                for (int bj = 0; bj < 2; ++bj) { f32x4 v0 = acc[ai][bj][m][0], v1 = acc[ai][bj][m][1];
                    if constexpr ((MODE & 2) != 0) { v0 = v0 * F8_DN_UNSCALE; v1 = v1 * F8_DN_UNSCALE; }
                    u32x4 w; w.x = cvt_pk_bf16(v0[0], v0[1]); w.y = cvt_pk_bf16(v0[2], v0[3]); w.z = cvt_pk_bf16(v1[0], v1[1]); w.w = cvt_pk_bf16(v1[2], v1[3]);
                    *(u32x4*)(out + off + bj * HALF) = w;
                    if constexpr ((MODE & 1) != 0) { u32x2 q; q.x = pack_fp8x4(v0[0], v0[1], v0[2], v0[3], 1.0f); q.y = pack_fp8x4(v1[0], v1[1], v1[2], v1[3], 1.0f); *(u32x2*)(x8 + off + bj * HALF) = q; }
                    if constexpr (NORM) ss += ((v0[0] * v0[0] + v0[1] * v0[1]) + (v0[2] * v0[2] + v0[3] * v0[3])) + ((v1[0] * v1[0] + v1[1] * v1[1]) + (v1[2] * v1[2] + v1[3] * v1[3])); }
                if constexpr (NORM) { ss += __shfl_xor(ss, 16); ss += __shfl_xor(ss, 32); if (fq == 0) ps[(off >> 10) * 16 + ((u.co >> 8) & 3) * 4 + wc] = ss; } }
    }
};
typedef EpiResidT<false> EpiResid;

struct EpiPart {
    static constexpr bool PERM = false; static constexpr bool VPERM = false;
    float* out; float sc;
    __device__ __forceinline__ void unit_begin(Unit&, size_t&, int&) const {}
    __device__ __forceinline__ void init(f32x4 (&acc)[2][2][4][2], const Unit&, int, int, int, int) const { zero_acc(acc); }
    __device__ __forceinline__ void operator()(const f32x4 (&acc)[2][2][4][2], const Unit& u, int wr, int wc, int fr, int fq) const {
        int r0 = wr * 64 + fr; asm volatile("" : "+v"(r0));
#pragma unroll
        for (int ai = 0; ai < 2; ++ai)
#pragma unroll
            for (int m = 0; m < 4; ++m) { const size_t off = u.co + (unsigned)((ai * HALF + m * 16 + r0) * 256 + wc * 32 + 4 * fq);
#pragma unroll
                for (int bj = 0; bj < 2; ++bj)
#pragma unroll
                    for (int n = 0; n < 2; ++n) *(f32x4*)(out + off + bj * HALF + n * 16) = acc[ai][bj][m][n] * sc; }
    }
};

__device__ __forceinline__ int vperm64(int p) { return ((p >> 4) & 1) * 32 + ((p >> 3) & 1) * 16 + (p & 7) + ((p >> 5) & 1) * 8; }
template <bool GATHER = false, unsigned F8S = 0u, class Epi, class Sched>
__device__ __forceinline__ void gemm_phase(LAS unsigned char* lds, const int K, const unsigned lda, const Sched& S, const Epi& E) {
    const int tid = threadIdx.x, wid = __builtin_amdgcn_readfirstlane(tid >> 6), lane = tid & 63, wr = wid >> 2, wc = wid & 3, fr = lane & 15, fq = lane >> 4;
    int nt = K / BK; asm volatile("" : "+s"(nt));
    unsigned voffA[2], voffB[2], voffA1[2], nvA0[2], nvA1[2];
#pragma unroll
    for (int i = 0; i < 2; ++i) { int R, C; stage_rc(tid * 16 + i * 8192, R, C); const int Rb = Epi::PERM ? ((R & ~31) + perm32(R & 31)) : R;
        voffA[i] = (unsigned)R * lda + (unsigned)C * 2u; voffA1[i] = 0u; nvA0[i] = 0u; nvA1[i] = 0u; (void)Rb; }
    const size_t kstep = (size_t)(BK * 2);
    const size_t hstepA = GATHER ? (size_t)0 : (size_t)HALF * lda;
#define PG8_VA1 (GATHER ? voffA1 : voffA)
#define PG8_GIDX(u, d0, d1) do { _Pragma("unroll") for (int _i = 0; _i < 2; ++_i) { int R_, C_; stage_rc((int)(threadIdx.x) * 16 + _i * 8192, R_, C_); \
        d0[_i] = (unsigned)(u).ridx[R_] * lda + (unsigned)C_ * 2u; d1[_i] = (unsigned)(u).ridx[HALF + R_] * lda + (unsigned)C_ * 2u; } } while (0)
    const unsigned ldsw = (unsigned)wid * 1024u;
    const int aoff = lds_byte(wr * 64 + fr, fq * 8), boff = lds_byte(wc * 32 + fr, fq * 8);
#define PG8_SA(b, h) (((b) * 2 + (h)) * HTB)
#define PG8_SB(b, h) ((4 + (b) * 2 + (h)) * HTB)
#define PG8_STAGE(bufoff, gbase, voff) do { const char* g_ = (const char*)(gbase); asm volatile("" : "+s"(g_)); _Pragma("unroll") for (int _i = 0; _i < 2; ++_i) { unsigned vo_ = (voff)[_i]; asm volatile("" : "+v"(vo_)); \
        __builtin_amdgcn_global_load_lds((const unsigned*)(g_ + vo_), (LAS unsigned*)(lds + (bufoff) + ldsw + _i * 8192), 16, 0, 0); } } while (0)
#define PG8_LDA(dst, b, h) do { _Pragma("unroll") for (int m = 0; m < 4; ++m) _Pragma("unroll") for (int k = 0; k < 2; ++k) dst[m][k] = *(const LAS bf16x8*)(lds + PG8_SA(b, h) + aoff + m * 2048 + k * 1024); } while (0)
#define PG8_LDB(dst, b, h) do { _Pragma("unroll") for (int n = 0; n < 2; ++n) _Pragma("unroll") for (int k = 0; k < 2; ++k) dst[n][k] = *(const LAS bf16x8*)(lds + PG8_SB(b, h) + boff + n * 2048 + k * 1024); } while (0)
#define PG8_MMA(ai, bj, At, Bt) do { __builtin_amdgcn_s_setprio(1); \
        if constexpr (F8S != 0u) { _Pragma("unroll") for (int m = 0; m < 4; ++m) _Pragma("unroll") for (int n = 0; n < 2; ++n) \
            mfma_f8(acc[ai][bj][m][n], cat8(Bt[n][0], Bt[n][1]), cat8(At[m][0], At[m][1])); } \
        else { _Pragma("unroll") for (int m = 0; m < 4; ++m) _Pragma("unroll") for (int n = 0; n < 2; ++n) _Pragma("unroll") for (int k = 0; k < 2; ++k) \
            acc[ai][bj][m][n] = __builtin_amdgcn_mfma_f32_16x16x32_bf16(Bt[n][k], At[m][k], acc[ai][bj][m][n], 0, 0, 0); } __builtin_amdgcn_s_setprio(0); } while (0)
#define PG8_WAIT_V(n) asm volatile("s_waitcnt vmcnt(" #n ")" ::: "memory")
#define PG8_WAIT_L(n) asm volatile("s_waitcnt lgkmcnt(" #n ")" ::: "memory")
#define PG8_BAR __builtin_amdgcn_s_barrier()
#define PG8_SCHED __builtin_amdgcn_sched_barrier(0)
#define PG8_SETB(u) do { _Pragma("unroll") for (int _i = 0; _i < 2; ++_i) { int R_, C_; stage_rc((int)(threadIdx.x) * 16 + _i * 8192, R_, C_); const int Rp_ = Epi::PERM ? ((R_ & ~31) + perm32(R_ & 31)) : R_; \
        const int Rb_ = (Epi::VPERM && (u).tag) ? ((Rp_ & ~63) + vperm64(Rp_ & 63)) : Rp_; \
        voffB[_i] = (unsigned)Rb_ * (u).ldb + (unsigned)C_ * 2u; } hsB = (size_t)(u).hsb; } while (0)
    Unit cur, nxt; int ui = 0;
    if (!S.next(0, cur)) return;
#if GEMM_STAGGER
    { const unsigned long long te_ = wall_clock64() + (unsigned long long)(((blockIdx.x >> 3) & 3) * GEMM_STAGGER); while (wall_clock64() < te_) __builtin_amdgcn_s_sleep(8); }
#endif
    size_t rkey = ~(size_t)0; int rpar = 0; cur.par = 0; E.unit_begin(cur, rkey, rpar);
    f32x4 acc[2][2][4][2];
    bf16x8 At[4][2], B0[2][2], B1[2][2];
    const char* cA = cur.A; const char* cB = cur.B; size_t hsB;
    PG8_SETB(cur);
    if constexpr (GATHER) PG8_GIDX(cur, voffA, voffA1);
    PG8_STAGE(PG8_SB(0, 0), cB, voffB); PG8_STAGE(PG8_SB(0, 1), cB + hsB, voffB); PG8_STAGE(PG8_SA(0, 0), cA, voffA); PG8_STAGE(PG8_SA(0, 1), cA + hstepA, PG8_VA1);
    E.init(acc, cur, wr, wc, fr, fq);
    if (wr == 1) PG8_BAR;
    PG8_WAIT_V(2); PG8_BAR;
    PG8_STAGE(PG8_SB(1, 0), cB + kstep, voffB); PG8_STAGE(PG8_SA(1, 0), cA + kstep, voffA); PG8_STAGE(PG8_SB(1, 1), cB + hsB + kstep, voffB);
    PG8_WAIT_V(6); PG8_BAR;
    for (;;) {
        const bool has_next = S.next(ui + 1, nxt);
        const char* nA = has_next ? nxt.A : cA; const char* nB = has_next ? nxt.B : cB;
        if constexpr (GATHER) { if (has_next) PG8_GIDX(nxt, nvA0, nvA1); }
        for (int t = 0; t < nt; t += 2) {
            const bool last = (t == nt - 2);
            const char* a1 = cA + (size_t)(t + 1) * kstep;
            const char* a2 = last ? nA : cA + (size_t)(t + 2) * kstep; const char* b2 = last ? nB : cB + (size_t)(t + 2) * kstep;
            const char* a3 = a2 + kstep; const char* b3 = b2 + kstep;
            if (last && has_next) { PG8_SETB(nxt); if constexpr (GATHER) { voffA[0] = nvA0[0]; voffA[1] = nvA0[1]; } }
            PG8_LDB(B0, 0, 0); PG8_LDB(B1, 0, 1); PG8_SCHED; PG8_LDA(At, 0, 0); PG8_STAGE(PG8_SA(1, 1), a1 + hstepA, PG8_VA1);
            if constexpr (GATHER) { if (last && has_next) { voffA1[0] = nvA1[0]; voffA1[1] = nvA1[1]; } }
            PG8_WAIT_V(8); PG8_WAIT_L(0); PG8_BAR; PG8_MMA(0, 0, At, B0); PG8_MMA(0, 1, At, B1); PG8_BAR; PG8_SCHED;
            PG8_LDA(At, 0, 1); PG8_STAGE(PG8_SB(0, 0), b2, voffB); PG8_STAGE(PG8_SB(0, 1), b2 + hsB, voffB); PG8_STAGE(PG8_SA(0, 0), a2, voffA);
            PG8_WAIT_V(8); PG8_WAIT_L(0); PG8_BAR; PG8_MMA(1, 0, At, B0); PG8_MMA(1, 1, At, B1); PG8_BAR; PG8_SCHED;
            PG8_LDB(B0, 1, 0); PG8_LDB(B1, 1, 1); PG8_SCHED; PG8_LDA(At, 1, 0); PG8_STAGE(PG8_SA(0, 1), a2 + hstepA, PG8_VA1);
            PG8_WAIT_V(8); PG8_WAIT_L(0); PG8_BAR; PG8_MMA(0, 0, At, B0); PG8_MMA(0, 1, At, B1); PG8_BAR; PG8_SCHED;
            PG8_LDA(At, 1, 1); PG8_STAGE(PG8_SB(1, 0), b3, voffB); PG8_STAGE(PG8_SB(1, 1), b3 + hsB, voffB); PG8_STAGE(PG8_SA(1, 0), a3, voffA);
            PG8_WAIT_V(8); PG8_WAIT_L(0); PG8_BAR; PG8_MMA(1, 0, At, B0); PG8_MMA(1, 1, At, B1); PG8_BAR; PG8_SCHED;
        }
        if (wr == 0) PG8_BAR;
        if constexpr (F8S != 0u) asm volatile("s_nop 15\n\ts_nop 15" ::: "memory");
        E(acc, cur, wr, wc, fr, fq);
#if EPI_TWICE
        asm volatile("" ::: "memory"); E(acc, cur, wr, wc, fr, fq);
#endif
        if (!has_next) break;
        nxt.par = 0; E.unit_begin(nxt, rkey, rpar);
        E.init(acc, nxt, wr, wc, fr, fq);
        cur = nxt; cA = nA; cB = nB; ++ui;
        if (wr == 1) PG8_BAR;
    }
    PG8_WAIT_V(0);
    PG8_BAR;
#undef PG8_SA
#undef PG8_SB
#undef PG8_STAGE
#undef PG8_LDA
#undef PG8_LDB
#undef PG8_MMA
#undef PG8_WAIT_V
#undef PG8_WAIT_L
#undef PG8_BAR
#undef PG8_SCHED
#undef PG8_SETB
#undef PG8_VA1
#undef PG8_GIDX
}
}

#define XB_TMO      128
#define XB_XCNT(j)  (256  + 64 * (j))
#define XB_XSUB(j)  (1280 + 64 * (j))
#define XB_XGEN(j)  (2304 + 64 * (j))
#define XB_TOP      3328
#define XB_TOPGEN   3392
#define XCD_BAR_WORDS 3456
#define XB_SPIN_CAP (1u << 18)
__device__ __forceinline__ unsigned xb_ld(unsigned* p)              { return __hip_atomic_load(p, __ATOMIC_RELAXED, __HIP_MEMORY_SCOPE_AGENT); }
__device__ __forceinline__ unsigned xb_add(unsigned* p, unsigned v) { return __hip_atomic_fetch_add(p, v, __ATOMIC_RELAXED, __HIP_MEMORY_SCOPE_AGENT); }
__device__ __forceinline__ unsigned xb_xcc_id() { return (unsigned)__builtin_amdgcn_s_getreg((3 << 11) | 20) & 0xFu; }
#define XB_SPIN(cond, bar) do { unsigned _sp = 0; while (cond) { __builtin_amdgcn_s_sleep(1); \
    if ((++_sp & 255u) == 0u) { if (xb_ld(&(bar)[XB_TMO])) break; if (_sp > XB_SPIN_CAP) { atomicAdd(&(bar)[XB_TMO], 1u); break; } } } } while (0)
struct XcdBarrier { unsigned* bar; unsigned x; volatile LAS unsigned* st; };
__device__ __forceinline__ XcdBarrier xcd_barrier_post(unsigned* bar, volatile LAS unsigned* st) {
    XcdBarrier b; b.bar = bar; b.x = xb_xcc_id(); b.st = st;
    if (threadIdx.x == 0) (void)xb_add(&bar[XB_XCNT(b.x)], 1u);
    return b;
}
__device__ __forceinline__ void xcd_barrier_complete(unsigned* bar, unsigned x, unsigned& nloc, unsigned& nx) {
    const unsigned G = gridDim.x * gridDim.y * gridDim.z;
    unsigned sum, cnt, mine, sp = 0u;
    for (;;) {
        sum = 0u; cnt = 0u; mine = 0u;
#pragma unroll
        for (unsigned j = 0; j < 16; ++j) { const unsigned c = xb_ld(&bar[XB_XCNT(j)]); sum += c; cnt += (c > 0u) ? 1u : 0u; mine = (j == x) ? c : mine; }
        if (sum == G) break;
        __builtin_amdgcn_s_sleep(1);
        if ((++sp & 255u) == 0u) { if (xb_ld(&bar[XB_TMO])) break; if (sp > XB_SPIN_CAP) { atomicAdd(&bar[XB_TMO], 1u); break; } }
    }
    nloc = mine > 0u ? mine : 1u; nx = cnt > 0u ? cnt : 1u;
}
__device__ __forceinline__ void xcd_barrier(const XcdBarrier& b) {
    asm volatile("s_waitcnt vmcnt(0)" ::: "memory");
    __syncthreads();
    if (threadIdx.x == 0) {
        unsigned* bar = b.bar;
        __builtin_amdgcn_s_waitcnt(0);
        unsigned nloc = b.st[0], nx = b.st[1];
        if (nloc == 0u) { xcd_barrier_complete(bar, b.x, nloc, nx); b.st[0] = nloc; b.st[1] = nx; }
        const unsigned old = xb_add(&bar[XB_XSUB(b.x)], 1u);
        const unsigned gen = old / nloc;
        if (old + 1u == (gen + 1u) * nloc) {
            __builtin_amdgcn_fence(__ATOMIC_RELEASE, "agent");
            asm volatile("s_waitcnt vmcnt(0)" ::: "memory");
            const unsigned og = xb_add(&bar[XB_TOP], 1u);
            const unsigned tg = og / nx;
            if (og + 1u == (tg + 1u) * nx) xb_add(&bar[XB_TOPGEN], 1u);
            else XB_SPIN(xb_ld(&bar[XB_TOPGEN]) == tg, bar);
            __builtin_amdgcn_fence(__ATOMIC_ACQUIRE, "agent");
            xb_add(&bar[XB_XGEN(b.x)], 1u);
            asm volatile("s_waitcnt vmcnt(0)" ::: "memory");
        } else {
            XB_SPIN(xb_ld(&bar[XB_XGEN(b.x)]) == gen, bar);
            __builtin_amdgcn_fence(__ATOMIC_ACQUIRE, "agent");
            asm volatile("s_waitcnt vmcnt(0)" ::: "memory");
        }
    }
    __syncthreads();
}

struct Job { int in, K, ld, col0, ncols, mode, sk, sidx; unsigned long long src, dst; unsigned item0; int rk; int ridx; int pad; };
constexpr int NJOBS = 60;
struct JobTab { Job j[NJOBS]; unsigned nitems; unsigned pad[3]; };
constexpr JobTab make_jobs() {
    JobTab t{}; int n = 0; unsigned it = 0;
    auto add = [&](int in, unsigned long long src, int K, int ld, int col0, int ncols, unsigned long long dst_elem, int mode, int sk, int sidx, int rk = 0, int ridx = 0, int f8 = 0) {
        Job& q = t.j[n++]; q.in = in; q.K = K; q.ld = ld; q.col0 = col0; q.ncols = ncols; q.mode = mode; q.sk = sk; q.sidx = sidx; q.src = src; q.dst = dst_elem; q.item0 = it; q.rk = rk; q.ridx = ridx; q.pad = f8;
        it += (unsigned)((K / (f8 ? 128 : 64)) * (ncols / 64)); };
    add(5, 0, 1024, 1024, 0, 1024, W_A_IN, 0, 0, 0);
    for (int g = 0; g < 4; ++g) add(6, (unsigned long long)g * 65536, 256, 256, 0, 256, W_A_GRP + (unsigned long long)g * 65536, 0, 2, g * 256);
    add(8, 0, 1024, 1024, 0, 1024, W_A_OUT, 0, 0, 0);
    for (int g = 0; g < 3; ++g) {
        add(9, 0, 1024, 9216, g * 3072, 1024, W_B_QK + (unsigned long long)g * 524288, 0, 1, 0, 2, 1 * DM, 1);
        add(9, 0, 1024, 9216, g * 3072 + 1024, 1024, W_B_QK + (unsigned long long)(3 + g) * 524288, 0, 0, 0, 2, 1 * DM, 1);
        add(9, 0, 1024, 9216, g * 3072 + 2048, 1024, W_B_V + (unsigned long long)g * 1048576, 0, 0, 0, 2, 1 * DM);
    }
    add(10, 0, 1024, 1024, 0, 1024, W_B_OUT, 0, 0, 0);
    add(11, 0, 1024, 3072, 0, 1024, W_C_QK, 0, 1, 0, 0, 0, 1);
    add(11, 0, 1024, 3072, 1024, 1024, W_C_QK + 524288, 0, 0, 0, 0, 0, 1);
    add(11, 0, 1024, 3072, 2048, 1024, W_C_V, 0, 0, 0, 0, 0, 1);
    add(14, 0, 1024, 1024, 0, 1024, W_C_OUT, 0, 0, 0, 0, 0, 2);
    add(15, 0, 1024, 1536, 0, 1024, W_D_QK, 0, 1, 0, 2, 3 * DM, 1);
    add(15, 0, 1024, 1536, 1024, 256, W_D_QK + 524288, 0, 0, 0, 2, 3 * DM, 1);
    add(15, 0, 1024, 1536, 1280, 256, W_D_V, 0, 0, 0, 2, 3 * DM, 1);
    add(17, 0, 1024, 1024, 0, 1024, W_D_OUT, 0, 0, 0, 0, 0, 2);
    for (int l = 0; l < 2; ++l) add(18, (unsigned long long)l * 1024 * 7168, 1024, 7168, 0, 7168, W_F_GU + (unsigned long long)l * 7168 * 1024, 1, 0, 0, 3, 2 * l * DM, DENSE_F8(l) ? 1 : 0);
    for (int l = 0; l < 2; ++l) add(19, (unsigned long long)l * 3584 * 1024, 3584, 1024, 0, 1024, W_F_D + (unsigned long long)l * 3584 * 1024, 0, 0, 0, 0, 0, 2);
    for (int l = 0; l < 16; ++l) add(21, (unsigned long long)l * 1024 * 7168, 1024, 7168, 0, 7168, W_M_GU + (unsigned long long)l * 7168 * 512, 1, 0, 0, 0, 0, 1);
    for (int l = 0; l < 16; ++l) add(22, (unsigned long long)l * 3584 * 1024, 3584, 1024, 0, 1024, W_M_D + (unsigned long long)l * 3584 * 512, 0, 0, 0, 0, 0, 2);
    t.nitems = it;
    return t;
}
__constant__ JobTab g_jobs = make_jobs();
static_assert(make_jobs().j[NJOBS - 1].K == 3584, "job count");

struct Args { const float* in[23]; float* out; unsigned char* ws; int ph_lo, ph_hi; };

struct Frame {
    LAS unsigned char* lds;
    int G, c, vcu;
    __device__ __forceinline__ int tid_() const { return (int)threadIdx.x; }
    __device__ __forceinline__ int lane_() const { return (int)threadIdx.x & 63; }
    __device__ __forceinline__ int wave_() const { return __builtin_amdgcn_readfirstlane((int)threadIdx.x >> 6); }
};

__device__ __forceinline__ void conv_item(const Job& jb, const float* __restrict__ src, bf16_t* __restrict__ dst, const float* __restrict__ cs, const float* __restrict__ rsv, LAS unsigned* scr, unsigned item, int lane) {
    const bool f8 = jb.pad != 0; const float f8s = jb.pad == 1 ? 256.f : 128.f;
    const int ntn = jb.ncols >> 6; const int kb = (int)item / ntn, nb = (int)item % ntn, k0 = kb * (f8 ? 128 : 64), n0 = nb * 64;
    int drow = n0;
    if (jb.mode == 1) { int n = n0; const bool up = n >= DFF; if (up) n -= DFF; drow = (n >> 7) * 256 + (n & 127) + (up ? 128 : 0); }
    const int a = lane & 15, b = lane >> 4;
    const float sc = (jb.sk == 1) ? QSCALE : 1.0f;
    f32x4 csv = (f32x4){sc, sc, sc, sc};
    if (jb.sk == 2) csv = *(const f32x4*)(cs + jb.sidx + n0 + 4 * a);
    const float* sp = src + (size_t)(k0 + 2 * b) * jb.ld + jb.col0 + n0 + 4 * a;
    const int c = lane & 7;
    if (f8) {
        f32x4 v0[16], v1[16];
#pragma unroll
        for (int i = 0; i < 16; ++i) { v0[i] = __builtin_nontemporal_load((const f32x4*)(sp + (size_t)(8 * i) * jb.ld)); v1[i] = __builtin_nontemporal_load((const f32x4*)(sp + (size_t)(8 * i + 1) * jb.ld)); }
#pragma unroll
        for (int i = 0; i < 16; ++i) { float g0 = f8s, g1 = f8s; if (rsv) { g0 *= rsv[k0 + 8 * i + 2 * b]; g1 *= rsv[k0 + 8 * i + 2 * b + 1]; }
            const f32x4 x0 = v0[i] * csv * g0, x1 = v1[i] * csv * g1; const int kp = 4 * i + b;
#pragma unroll
            for (int j = 0; j < 4; ++j) ((LAS unsigned short*)scr)[(4 * a + j) * 66 + kp] = (unsigned short)__builtin_amdgcn_cvt_pk_fp8_f32(x0[j], x1[j], 0, false); }
        LDS_WAIT();
#pragma unroll
        for (int jj = 0; jj < 8; ++jj) { const int n = (lane >> 3) + 8 * jj; const LAS unsigned* s = scr + n * 33 + 4 * c;
            u32x4 o; o.x = s[0]; o.y = s[1]; o.z = s[2]; o.w = s[3];
            __builtin_nontemporal_store(o, (u32x4*)((unsigned char*)dst + (size_t)(drow + n) * jb.K + k0 + 16 * c)); }
        LDS_WAIT();
        return;
    }
    f32x4 v0[8], v1[8];
#pragma unroll
    for (int i = 0; i < 8; ++i) { v0[i] = __builtin_nontemporal_load((const f32x4*)(sp + (size_t)(8 * i) * jb.ld)); v1[i] = __builtin_nontemporal_load((const f32x4*)(sp + (size_t)(8 * i + 1) * jb.ld)); }
#pragma unroll
    for (int i = 0; i < 8; ++i) { float g0 = 1.0f, g1 = 1.0f; if (rsv) { g0 = rsv[k0 + 8 * i + 2 * b]; g1 = rsv[k0 + 8 * i + 2 * b + 1]; }
        const f32x4 x0 = v0[i] * csv * g0, x1 = v1[i] * csv * g1; const int kp = 4 * i + b;
#pragma unroll
        for (int j = 0; j < 4; ++j) scr[(4 * a + j) * 33 + kp] = cvt_pk_bf16(x0[j], x1[j]); }
    LDS_WAIT();
#pragma unroll
    for (int jj = 0; jj < 8; ++jj) { const int n = (lane >> 3) + 8 * jj; const LAS unsigned* s = scr + n * 33 + 4 * c;
        u32x4 o; o.x = s[0]; o.y = s[1]; o.z = s[2]; o.w = s[3];
        __builtin_nontemporal_store(o, (u32x4*)(dst + (size_t)(drow + n) * jb.K + k0 + 8 * c)); }
    LDS_WAIT();
}

__device__ __forceinline__ int rel_bucket(int rel) {
    const int n = rel < 0 ? -rel : rel;
    int big = 8 + (int)(logf((float)(n < 1 ? 1 : n) / 8.0f) / 4.852030263919617f * 8.0f);
    big = big < 15 ? big : 15;
    return (rel > 0 ? 16 : 0) + (n < 8 ? n : big);
}

__device__ __forceinline__ void load_row(const float* xrow, int lane, f32x4 (&v)[4]) {
    const f32x4* xr = (const f32x4*)xrow + lane;
#pragma unroll
    for (int j = 0; j < 4; ++j) v[j] = xr[64 * j];
}
__device__ __forceinline__ void load_row(const bf16_t* xrow, int lane, f32x4 (&v)[4]) {
    const u32x2* xr = (const u32x2*)xrow + lane;
#pragma unroll
    for (int j = 0; j < 4; ++j) { const u32x2 w = xr[64 * j]; v[j] = (f32x4){bf_lo(w.x), bf_hi(w.x), bf_lo(w.y), bf_hi(w.y)}; }
}
__device__ __forceinline__ float row_rstd(const f32x4 (&v)[4]) {
    float s = 0.f;
#pragma unroll
    for (int j = 0; j < 4; ++j) s += (v[j].x * v[j].x + v[j].y * v[j].y) + (v[j].z * v[j].z + v[j].w * v[j].w);
    return 1.0f / sqrtf(wave_sum(s) * (1.0f / DM) + RMS_EPS);
}
__device__ __forceinline__ void store_row_fp8(unsigned char* orow, int lane, const f32x4 (&v)[4]) {
#pragma unroll
    for (int j = 0; j < 4; ++j) *(unsigned*)(orow + 4 * lane + 256 * j) = pg8::pack_fp8x4(v[j].x, v[j].y, v[j].z, v[j].w, 1.0f);
}
__device__ __forceinline__ void store_row_bf16(bf16_t* orow, int lane, const f32x4 (&v)[4]) {
    u32x2* o8 = (u32x2*)orow + lane;
#pragma unroll
    for (int j = 0; j < 4; ++j) { u32x2 w; w.x = cvt_pk_bf16(v[j].x, v[j].y); w.y = cvt_pk_bf16(v[j].z, v[j].w); o8[64 * j] = w; }
}
template <class XT> __device__ __forceinline__ void rms_phase(const Frame& F, const XT* x, const float* gain, bf16_t* hn) {
    const int gw = F.c * NWAVES + F.wave_(), NGW = F.G * NWAVES;
    f32x4 g[4]; load_row(gain, F.lane_(), g);
    for (int m = gw; m < MTOK; m += 2 * NGW) {
        const int m2 = m + NGW; const bool two = m2 < MTOK;
        f32x4 v[4], w[4]; load_row(x + (size_t)m * DM, F.lane_(), v); load_row(x + (size_t)(two ? m2 : m) * DM, F.lane_(), w);
        const float rv = row_rstd(v), rw = row_rstd(w);
#pragma unroll
        for (int j = 0; j < 4; ++j) { v[j] = v[j] * rv * g[j]; w[j] = w[j] * rw * g[j]; }
        store_row_bf16(hn + (size_t)m * DM, F.lane_(), v);
        if (two) store_row_bf16(hn + (size_t)m2 * DM, F.lane_(), w);
    }
}

__device__ __forceinline__ int keyperm(int rho) { return (rho & 0x13) | ((rho & 4) << 1) | ((rho & 8) >> 1); }
template <int NVB> struct AttnAcc { f32x16 o[NVB]; float m, l; };
template <int NVB>
__device__ __forceinline__ void attn_tile(AttnAcc<NVB>& st, const bf16x8 (&qf)[4], const char* kptr, const char* vptr, const size_t vblk, const LAS float* bt) {
    bf16x8 kf[4], vf[NVB][2];
#pragma unroll
    for (int t = 0; t < 4; ++t) kf[t] = *(const bf16x8*)(kptr + t * 32);
#pragma unroll
    for (int b = 0; b < NVB; ++b)
#pragma unroll
        for (int t = 0; t < 2; ++t) vf[b][t] = *(const bf16x8*)(vptr + b * vblk + t * 32);
    f32x16 s;
#pragma unroll
    for (int r = 0; r < 16; ++r) s[r] = bt[(r >> 3) * 16 + (r & 7)];
#pragma unroll
    for (int t = 0; t < 4; ++t) s = __builtin_amdgcn_mfma_f32_32x32x16_bf16(kf[t], qf[t], s, 0, 0, 0);
    float mx = s[0];
#pragma unroll
    for (int r = 1; r < 16; ++r) mx = fmaxf(mx, s[r]);
    mx = fmaxf(mx, __shfl_xor(mx, 32));
    const float mn = fmaxf(st.m, mx), alpha = __builtin_amdgcn_exp2f(st.m - mn); st.m = mn;
    float ps = 0.f;
#pragma unroll
    for (int r = 0; r < 16; ++r) { s[r] = __builtin_amdgcn_exp2f(s[r] - mn); ps += s[r]; }
    st.l = st.l * alpha + ps;
#pragma unroll
    for (int b = 0; b < NVB; ++b) st.o[b] = st.o[b] * alpha;
    u32x4 p0, p1;
    p0.x = cvt_pk_bf16(s[0], s[1]); p0.y = cvt_pk_bf16(s[2], s[3]); p0.z = cvt_pk_bf16(s[4], s[5]); p0.w = cvt_pk_bf16(s[6], s[7]);
    p1.x = cvt_pk_bf16(s[8], s[9]); p1.y = cvt_pk_bf16(s[10], s[11]); p1.z = cvt_pk_bf16(s[12], s[13]); p1.w = cvt_pk_bf16(s[14], s[15]);
    const bf16x8 pf0 = __builtin_bit_cast(bf16x8, p0), pf1 = __builtin_bit_cast(bf16x8, p1);
#pragma unroll
    for (int b = 0; b < NVB; ++b) { st.o[b] = __builtin_amdgcn_mfma_f32_32x32x16_bf16(vf[b][0], pf0, st.o[b], 0, 0, 0); st.o[b] = __builtin_amdgcn_mfma_f32_32x32x16_bf16(vf[b][1], pf1, st.o[b], 0, 0, 0); }
}

template <int HALF>
__device__ __forceinline__ void band_item(const bf16_t* Qp, const bf16_t* Kp, const int ldqk, const size_t tok0, const int dil, const int L, const int q0,
                                          const bf16_t* Vt, const size_t vn0, const float* gtab_h, LAS float* tbl, const float m_init, const float l_init,
                                          bf16_t* out_row0  , const int ldo, float* lse_out  , const int lane) {
    const int ql = lane & 31, hf = lane >> 5;
    for (int i = lane; i < 2 * HALF + 63; i += 64) { const int j = i - HALF - 31; tbl[i] = (j >= -HALF && j <= HALF) ? gtab_h[j * dil + 2048] : NEG_BIG; }
    LDS_WAIT();
    const size_t qtok = tok0 + (size_t)(q0 + ql) * dil;
    bf16x8 qf[4];
#pragma unroll
    for (int t = 0; t < 4; ++t) qf[t] = *(const bf16x8*)(Qp + qtok * ldqk + 16 * t + 8 * hf);
    AttnAcc<2> st;
    st.o[0] = (f32x16){}; st.o[1] = (f32x16){}; st.m = m_init; st.l = (hf == 0) ? l_init : 0.f;
    const int kr = keyperm(ql);
    for (int kt = q0 - HALF; kt <= q0 + HALF; kt += 32) {
        if (kt < 0 || kt >= L) continue;
        const char* kptr = (const char*)(Kp + (tok0 + (size_t)(kt + kr) * dil) * ldqk + 8 * hf);
        const char* vptr = (const char*)(Vt + (size_t)ql * MTOK + vn0 + kt + 8 * hf);
        const LAS float* bt = tbl + (kt - q0 + HALF) + 8 * hf - ql + 31;
        attn_tile<2>(st, qf, kptr, vptr, (size_t)32 * MTOK * 2, bt);
    }
    const float lt = st.l + __shfl_xor(st.l, 32), inv = 1.0f / lt;
    bf16_t* orow = out_row0 + qtok * ldo;
#pragma unroll
    for (int b = 0; b < 2; ++b)
#pragma unroll
        for (int i = 0; i < 4; ++i) { u32x2 w; w.x = cvt_pk_bf16(st.o[b][4 * i] * inv, st.o[b][4 * i + 1] * inv); w.y = cvt_pk_bf16(st.o[b][4 * i + 2] * inv, st.o[b][4 * i + 3] * inv);
            *(u32x2*)(orow + 32 * b + 8 * i + 4 * hf) = w; }
    if (lse_out && hf == 0) lse_out[qtok * 16] = st.m + __builtin_amdgcn_logf(lt);
}


template <int HALF, bool OUT8 = false>
__device__ __forceinline__ void band_item64(const bf16_t* Qp, const bf16_t* Kp, const int ldqk, const size_t tok0, const int dil, const int L, const int q0,
                                            const bf16_t* Vt, const size_t vn0, const float* gtab_h, LAS float* tbl, LAS unsigned char* stg, const float m_init, const float l_init,
                                            bf16_t* out0, const int ldo, float* lse_out, const int lane) {
    const int ql = lane & 31, hf = lane >> 5, kp = keyperm(ql);
    for (int i = lane; i < 2 * HALF + 63; i += 64) { const int j = i - HALF - 31; tbl[i] = (j >= -HALF && j <= HALF) ? gtab_h[j * dil + 2048] : NEG_BIG; }
    unsigned ka[4], va[2];
#pragma unroll
    for (int t = 0; t < 4; ++t) ka[t] = (unsigned)(kp * 128 + (((2 * t + hf) ^ ((kp >> 1) & 7)) << 4));
#pragma unroll
    for (int t = 0; t < 2; ++t) va[t] = (unsigned)(ql * 64 + (((2 * t + hf) ^ ((ql >> 2) & 3)) << 4));
    const size_t krow = (size_t)dil * ldqk * 2;
    const char* kg = (const char*)Kp + (tok0 + (size_t)(lane >> 3) * dil) * ldqk * 2;
    const unsigned kcE = (unsigned)(((lane & 7) ^ (lane >> 4)) << 4), kcO = (unsigned)(((lane & 7) ^ (4 + (lane >> 4))) << 4);
    const char* vg = (const char*)(Vt + (size_t)(lane >> 2) * MTOK + vn0) + ((((lane & 3) ^ (lane >> 4))) << 4);
#define BI_GLDS(g, l) __builtin_amdgcn_global_load_lds((const unsigned*)(g), (LAS unsigned*)(l), 16, 0, 0)
#define BI_ISSUE(kt_, s_) do { LAS unsigned char* sb_ = stg + (s_) * 8192; const char* k_ = kg + (size_t)(kt_) * krow; const char* v_ = vg + (size_t)(kt_) * 2; \
        BI_GLDS(k_ + kcE, sb_); BI_GLDS(k_ + 8 * krow + kcO, sb_ + 1024); BI_GLDS(k_ + 16 * krow + kcE, sb_ + 2048); BI_GLDS(k_ + 24 * krow + kcO, sb_ + 3072); \
        BI_GLDS(v_, sb_ + 4096); BI_GLDS(v_ + (size_t)16 * MTOK * 2, sb_ + 5120); BI_GLDS(v_ + (size_t)32 * MTOK * 2, sb_ + 6144); BI_GLDS(v_ + (size_t)48 * MTOK * 2, sb_ + 7168); } while (0)
    bf16x8 qf[2][4];
#pragma unroll
    for (int g = 0; g < 2; ++g)
#pragma unroll
        for (int t = 0; t < 4; ++t) qf[g][t] = *(const bf16x8*)(Qp + (tok0 + (size_t)(q0 + 32 * g + ql) * dil) * ldqk + 16 * t + 8 * hf);
    f32x16 o[2][2]; float mr[2], lr[2];
#pragma unroll
    for (int g = 0; g < 2; ++g) { o[g][0] = (f32x16){}; o[g][1] = (f32x16){}; mr[g] = m_init; lr[g] = (hf == 0) ? l_init : 0.f; }
    const int kt_lo = (q0 - HALF) < 0 ? 0 : q0 - HALF, kt_hi = (q0 + 32 + HALF) > (L - 32) ? (L - 32) : q0 + 32 + HALF;
    asm volatile("s_waitcnt lgkmcnt(0)" ::: "memory");
    BI_ISSUE(kt_lo, 0);
    int s = 0;
    for (int kt = kt_lo; kt <= kt_hi; kt += 32) {
        if (kt + 32 <= kt_hi) { BI_ISSUE(kt + 32, s ^ 1); asm volatile("s_waitcnt vmcnt(8)" ::: "memory"); }
        else asm volatile("s_waitcnt vmcnt(0)" ::: "memory");
        const LAS unsigned char* Kt = stg + s * 8192; const LAS unsigned char* Vs = Kt + 4096;
        bf16x8 kf[4], vf[2][2];
#pragma unroll
        for (int t = 0; t < 4; ++t) kf[t] = *(const LAS bf16x8*)(Kt + ka[t]);
#pragma unroll
        for (int b = 0; b < 2; ++b)
#pragma unroll
            for (int t = 0; t < 2; ++t) vf[b][t] = *(const LAS bf16x8*)(Vs + b * 2048 + va[t]);
#pragma unroll
        for (int g = 0; g < 2; ++g) {
            const int qg = q0 + 32 * g;
            if (kt >= qg - HALF && kt <= qg + HALF) {
                const LAS float* bt = tbl + (kt - qg + HALF) + 8 * hf - ql + 31;
                f32x16 sc;
#pragma unroll
                for (int r = 0; r < 16; ++r) sc[r] = bt[(r >> 3) * 16 + (r & 7)];
#pragma unroll
                for (int t = 0; t < 4; ++t) sc = __builtin_amdgcn_mfma_f32_32x32x16_bf16(kf[t], qf[g][t], sc, 0, 0, 0);
                float mx = sc[0];
#pragma unroll
                for (int r = 1; r < 16; ++r) mx = fmaxf(mx, sc[r]);
                mx = fmaxf(mx, __shfl_xor(mx, 32));
                const float mn = fmaxf(mr[g], mx), alpha = __builtin_amdgcn_exp2f(mr[g] - mn); mr[g] = mn;
                float ps = 0.f;
#pragma unroll
                for (int r = 0; r < 16; ++r) { sc[r] = __builtin_amdgcn_exp2f(sc[r] - mn); ps += sc[r]; }
                lr[g] = lr[g] * alpha + ps;
                o[g][0] = o[g][0] * alpha; o[g][1] = o[g][1] * alpha;
                u32x4 p0, p1;
                p0.x = cvt_pk_bf16(sc[0], sc[1]); p0.y = cvt_pk_bf16(sc[2], sc[3]); p0.z = cvt_pk_bf16(sc[4], sc[5]); p0.w = cvt_pk_bf16(sc[6], sc[7]);
                p1.x = cvt_pk_bf16(sc[8], sc[9]); p1.y = cvt_pk_bf16(sc[10], sc[11]); p1.z = cvt_pk_bf16(sc[12], sc[13]); p1.w = cvt_pk_bf16(sc[14], sc[15]);
                const bf16x8 pf0 = __builtin_bit_cast(bf16x8, p0), pf1 = __builtin_bit_cast(bf16x8, p1);
#pragma unroll
                for (int b = 0; b < 2; ++b) { o[g][b] = __builtin_amdgcn_mfma_f32_32x32x16_bf16(vf[b][0], pf0, o[g][b], 0, 0, 0); o[g][b] = __builtin_amdgcn_mfma_f32_32x32x16_bf16(vf[b][1], pf1, o[g][b], 0, 0, 0); }
            }
        }
        s ^= 1;
    }
#pragma unroll
    for (int g = 0; g < 2; ++g) {
        const float lt = lr[g] + __shfl_xor(lr[g], 32), inv = 1.0f / lt;
        const size_t qtok = tok0 + (size_t)(q0 + 32 * g + ql) * dil;
        bf16_t* orow = out0 + qtok * ldo;
#pragma unroll
        for (int b = 0; b < 2; ++b)
#pragma unroll
            for (int i = 0; i < 4; ++i) {
                if constexpr (OUT8) { *(unsigned*)((unsigned char*)out0 + qtok * ldo + 32 * b + 8 * i + 4 * hf) = pg8::pack_fp8x4(o[g][b][4 * i], o[g][b][4 * i + 1], o[g][b][4 * i + 2], o[g][b][4 * i + 3], inv * ACT8_SCALE); }
                else { u32x2 w; w.x = cvt_pk_bf16(o[g][b][4 * i] * inv, o[g][b][4 * i + 1] * inv); w.y = cvt_pk_bf16(o[g][b][4 * i + 2] * inv, o[g][b][4 * i + 3] * inv);
                    *(u32x2*)(orow + 32 * b + 8 * i + 4 * hf) = w; } }
        if (lse_out && hf == 0) lse_out[qtok * 16] = mr[g] + __builtin_amdgcn_logf(lt);
    }
#undef BI_GLDS
#undef BI_ISSUE
}

template <int HALF, bool OUT8 = false>
__device__ __forceinline__ void band_item64q(const unsigned char* Qp, const unsigned char* Kp, const int ldqk, const size_t tok0, const int dil, const int L, const int q0,
                                            const unsigned char* Vt, const size_t vn0, const float* gtab_h, LAS float* tbl, LAS unsigned char* stg, const float m_init, const float l_init,
                                            bf16_t* out0, const int ldo, float* lse_out, const int lane) {
    const int ql = lane & 31, hf = lane >> 5, kp = keyperm(ql);
    for (int i = lane; i < 2 * HALF + 63; i += 64) { const int j = i - HALF - 31; tbl[i] = (j >= -HALF && j <= HALF) ? gtab_h[j * dil + 2048] : NEG_BIG; }
    unsigned ka[4], va[2];
#pragma unroll
    for (int t = 0; t < 4; ++t) ka[t] = (unsigned)(kp * 64 + ((t ^ ((kp >> 2) & 3)) << 4) + 8 * hf);
#pragma unroll
    for (int t = 0; t < 2; ++t) va[t] = (unsigned)(ql * 32 + 16 * t + 8 * hf);
    const size_t krow = (size_t)dil * ldqk;
    const char* kg = (const char*)Kp + (tok0 + (size_t)(lane >> 2) * dil) * ldqk + ((((lane & 3) ^ (lane >> 4))) << 4);
    const char* vg = (const char*)Vt + (size_t)(lane >> 1) * MTOK + vn0 + 16 * (lane & 1);
#define BQ_PK8(a_, b_, c_, d_) ((unsigned)__builtin_amdgcn_cvt_pk_fp8_f32((c_), (d_), __builtin_amdgcn_cvt_pk_fp8_f32((a_), (b_), 0, false), true))
#define BI_GLDS(g, l) __builtin_amdgcn_global_load_lds((const unsigned*)(g), (LAS unsigned*)(l), 16, 0, 0)
#define BI_ISSUE(kt_, s_) do { LAS unsigned char* sb_ = stg + (s_) * 8192; const char* k_ = kg + (size_t)(kt_) * krow; const char* v_ = vg + (size_t)(kt_); \
        BI_GLDS(k_, sb_); BI_GLDS(k_ + 16 * krow, sb_ + 1024); BI_GLDS(v_, sb_ + 2048); BI_GLDS(v_ + (size_t)32 * MTOK, sb_ + 3072); } while (0)
    long qf[2][4];
#pragma unroll
    for (int g = 0; g < 2; ++g)
#pragma unroll
        for (int t = 0; t < 4; ++t) qf[g][t] = *(const long*)(Qp + (tok0 + (size_t)(q0 + 32 * g + ql) * dil) * ldqk + 16 * t + 8 * hf);
    f32x16 o[2][2]; float mr[2], lr[2];
#pragma unroll
    for (int g = 0; g < 2; ++g) { o[g][0] = (f32x16){}; o[g][1] = (f32x16){}; mr[g] = m_init; lr[g] = (hf == 0) ? l_init * 16.0f : 0.f; }
    const int kt_lo = (q0 - HALF) < 0 ? 0 : q0 - HALF, kt_hi = (q0 + 32 + HALF) > (L - 32) ? (L - 32) : q0 + 32 + HALF;
    asm volatile("s_waitcnt lgkmcnt(0)" ::: "memory");
    BI_ISSUE(kt_lo, 0);
    int s = 0;
    for (int kt = kt_lo; kt <= kt_hi; kt += 32) {
        if (kt + 32 <= kt_hi) { BI_ISSUE(kt + 32, s ^ 1); asm volatile("s_waitcnt vmcnt(4)" ::: "memory"); }
        else asm volatile("s_waitcnt vmcnt(0)" ::: "memory");
        const LAS unsigned char* Kt = stg + s * 8192; const LAS unsigned char* Vs = Kt + 2048;
        long kf[4], vf[2][2];
#pragma unroll
        for (int t = 0; t < 4; ++t) kf[t] = *(const LAS long*)(Kt + ka[t]);
#pragma unroll
        for (int b = 0; b < 2; ++b)
#pragma unroll
            for (int t = 0; t < 2; ++t) vf[b][t] = *(const LAS long*)(Vs + b * 1024 + va[t]);
#pragma unroll
        for (int g = 0; g < 2; ++g) {
            const int qg = q0 + 32 * g;
            if (kt >= qg - HALF && kt <= qg + HALF) {
                const LAS float* bt = tbl + (kt - qg + HALF) + 8 * hf - ql + 31;
                f32x16 sc;
#pragma unroll
                for (int r = 0; r < 16; ++r) sc[r] = bt[(r >> 3) * 16 + (r & 7)];
#pragma unroll
                for (int t = 0; t < 4; ++t) sc = __builtin_amdgcn_mfma_f32_32x32x16_fp8_fp8(kf[t], qf[g][t], sc, 0, 0, 0);
                float mx = sc[0];
#pragma unroll
                for (int r = 1; r < 16; ++r) mx = fmaxf(mx, sc[r]);
                mx = fmaxf(mx, __shfl_xor(mx, 32));
                const float mn = fmaxf(mr[g], mx), alpha = __builtin_amdgcn_exp2f(mr[g] - mn); mr[g] = mn;
                float ps = 0.f;
                const float mn4 = mn - 4.0f;
#pragma unroll
                for (int r = 0; r < 16; ++r) { sc[r] = __builtin_amdgcn_exp2f(sc[r] - mn4); ps += sc[r]; }
                lr[g] = lr[g] * alpha + ps;
                o[g][0] = o[g][0] * alpha; o[g][1] = o[g][1] * alpha;
                u32x2 p0, p1;
                p0.x = BQ_PK8(sc[0], sc[1], sc[2], sc[3]); p0.y = BQ_PK8(sc[4], sc[5], sc[6], sc[7]); p1.x = BQ_PK8(sc[8], sc[9], sc[10], sc[11]); p1.y = BQ_PK8(sc[12], sc[13], sc[14], sc[15]);
                const long pf0 = __builtin_bit_cast(long, p0), pf1 = __builtin_bit_cast(long, p1);
#pragma unroll
                for (int b = 0; b < 2; ++b) { o[g][b] = __builtin_amdgcn_mfma_f32_32x32x16_fp8_fp8(vf[b][0], pf0, o[g][b], 0, 0, 0); o[g][b] = __builtin_amdgcn_mfma_f32_32x32x16_fp8_fp8(vf[b][1], pf1, o[g][b], 0, 0, 0); }
            }
        }
        s ^= 1;
    }
#pragma unroll
    for (int g = 0; g < 2; ++g) {
        const float lt = lr[g] + __shfl_xor(lr[g], 32), inv = (1.0f / ACT8_SCALE) / lt;
        const size_t qtok = tok0 + (size_t)(q0 + 32 * g + ql) * dil;
        bf16_t* orow = out0 + qtok * ldo;
#pragma unroll
        for (int b = 0; b < 2; ++b)
#pragma unroll
            for (int i = 0; i < 4; ++i) {
                if constexpr (OUT8) { *(unsigned*)((unsigned char*)out0 + qtok * ldo + 32 * b + 8 * i + 4 * hf) = pg8::pack_fp8x4(o[g][b][4 * i], o[g][b][4 * i + 1], o[g][b][4 * i + 2], o[g][b][4 * i + 3], inv * ACT8_SCALE); }
                else { u32x2 w; w.x = cvt_pk_bf16(o[g][b][4 * i] * inv, o[g][b][4 * i + 1] * inv); w.y = cvt_pk_bf16(o[g][b][4 * i + 2] * inv, o[g][b][4 * i + 3] * inv);
                    *(u32x2*)(orow + 32 * b + 8 * i + 4 * hf) = w; } }
        if (lse_out && hf == 0) lse_out[qtok * 16] = mr[g] + __builtin_amdgcn_logf(lt) - 4.0f;
    }
#undef BI_GLDS
#undef BI_ISSUE
#undef BQ_PK8
}

struct PlainSched {
    const char* A; const char* B; unsigned lda, ldb; int nM, nN, G, c; size_t co_m, co_n;
    __device__ __forceinline__ bool next(int i, pg8::Unit& u) const {
        const long L = (long)i * G + c; if (L >= (long)nM * nN) return false;
        int pm, pn; pg8::tile_order(nM, nN, (int)L, pm, pn);
        u.A = A + (size_t)pm * 256 * lda; u.B = B + (size_t)pn * 256 * ldb; u.ldb = ldb; u.hsb = 128u * ldb; u.co = (size_t)pm * co_m + (size_t)pn * co_n; u.tag = 0; return true;
    }
};
struct QkvSched {
    const char* hn; const char* Wqk; const char* Wv; int nNqk, nvp, nMv, dshift, G, c; int ldqk; unsigned rs = 2048u;
    __device__ __forceinline__ bool next(int i, pg8::Unit& u) const {
        long L = (long)i * G + c; const int n0 = 64 * nNqk, nv = nMv * 64;
        if (L < n0) { int pm, pn; pg8::tile_order(64, nNqk, (int)L, pm, pn);
            u.A = hn + (size_t)pm * 256 * rs; u.B = Wqk + (size_t)pn * 256 * rs; u.ldb = rs; u.hsb = 128u * rs; u.co = (size_t)pm * 256 * ldqk + (size_t)pn * 256; u.tag = 0; return true; }
        L -= n0; if (L >= (long)nvp * nv) return false;
        const int g = (int)(L / nv); int pm, pn; pg8::tile_order(nMv, 64, (int)(L % nv), pm, pn);
        const int d = 1 << (dshift * g), b = pn >> 3, nn = (pn & 7) * 256;
        size_t tok; unsigned ldb, hsb;
        if (d == 1) { tok = (size_t)b * SEQ + nn; ldb = rs; hsb = 128u * rs; }
        else if (d == 4) { tok = (size_t)b * SEQ + (size_t)(nn & 511) * 4 + (nn >> 9); ldb = 4u * rs; hsb = 128u * 4u * rs; }
        else { tok = (size_t)b * SEQ + (nn >> 7); ldb = 16u * rs; hsb = rs; }
        u.A = Wv + (size_t)(g * nMv + pm) * 256 * rs; u.B = hn + tok * rs; u.ldb = ldb; u.hsb = hsb;
        u.co = (size_t)(g * nMv + pm) * 256 * MTOK + (size_t)pn * 256; u.tag = 1; return true;
    }
};
struct MoeSched {
    const char* A; const char* B; unsigned lda, ldb; const int* panel; size_t estride; int nN, G, c; size_t co_m, co_n; int use_limit; const int* rows;
    __device__ __forceinline__ bool next(int i, pg8::Unit& u) const {
        const int nM = __builtin_amdgcn_readfirstlane(panel[0]); const long L = (long)i * G + c; const long lim = (use_limit && __builtin_amdgcn_readfirstlane(panel[3]) > 1) ? (long)__builtin_amdgcn_readfirstlane(panel[1]) : (long)nM * nN; if (L >= lim) return false;
        int pm, pn; pg8::tile_order(nM, nN, (int)L, pm, pn); const int e = __builtin_amdgcn_readfirstlane(panel[4 + pm]);
        u.A = rows ? A : A + (size_t)pm * 256 * lda; u.ridx = rows ? rows + pm * 256 : nullptr; u.B = B + (size_t)e * estride + (size_t)pn * 256 * ldb; u.ldb = ldb; u.hsb = 128u * ldb; u.co = (size_t)pm * co_m + (size_t)pn * co_n; u.tag = 0; return true;
    }
};
struct MoeDown8Sched {
    const char* A; const char* B; const int* panel; int G, c;
    __device__ __forceinline__ bool next(int i, pg8::Unit& u) const {
        const int nM = __builtin_amdgcn_readfirstlane(panel[0]); const long L = (long)i * G + c; const long lim = __builtin_amdgcn_readfirstlane(panel[3]) > 1 ? (long)__builtin_amdgcn_readfirstlane(panel[1]) : (long)nM * 4; if (L >= lim) return false;
        int pm, pn; pg8::tile_order(nM, 4, (int)L, pm, pn); const int e = __builtin_amdgcn_readfirstlane(panel[4 + pm]);
        u.A = A + (size_t)pm * 256 * 3584; u.ridx = nullptr; u.B = B + (size_t)e * (3584 * 1024) + (size_t)pn * 256 * 3584; u.ldb = 3584u; u.hsb = 128u * 3584u; u.co = (size_t)pm * 256 * DM + (size_t)pn * 256; u.tag = 0; return true;
    }
};
struct MoeSplitSched {
    const char* A; const char* B; const int* panel; size_t estride; int c;
    __device__ __forceinline__ bool next(int i, pg8::Unit& u) const {
        const int S = __builtin_amdgcn_readfirstlane(panel[3]), rem = __builtin_amdgcn_readfirstlane(panel[2]); if (i > 0 || S <= 1 || c >= rem * S) return false;
        const int q = c / S, ks = c - q * S, ksub = DFF / S;
        int pm, pn; pg8::tile_order(__builtin_amdgcn_readfirstlane(panel[0]), 4, __builtin_amdgcn_readfirstlane(panel[1]) + q, pm, pn); const int e = __builtin_amdgcn_readfirstlane(panel[4 + pm]);
        u.A = A + (size_t)pm * 256 * 3584 + (size_t)ks * ksub; u.B = B + (size_t)e * estride + (size_t)pn * 256 * 3584 + (size_t)ks * ksub; u.ldb = 3584u; u.hsb = 128u * 3584u; u.co = (size_t)c * 65536; u.tag = 0; return true;
    }
};

__device__ __forceinline__ void moe_route(const Frame& F, const bf16_t* x, const float* gain, const float* router, bf16_t* hn, int* e12, float* g1o, float* g2o, int* cnt_wg) {
    LAS int* cnt = (LAS int*)(F.lds + 32768);
    f32x4 R[4][8];
#pragma unroll
    for (int j = 0; j < 4; ++j) { const f32x4* rp = (const f32x4*)(router + (size_t)(4 * F.lane_() + 256 * j) * NE);
#pragma unroll
        for (int q = 0; q < 8; ++q) R[j][q] = rp[q]; }
    f32x4 g[4]; load_row(gain, F.lane_(), g);
    for (int ch = F.c; ch < MTOK / 64; ch += F.G) {
        if (F.tid_() < 8) cnt[F.tid_()] = 0;
        const int m0 = ch * 64 + F.wave_() * 8;
        u32x2 raw[4][4];
#pragma unroll
        for (int i = 0; i < 4; ++i) { const u32x2* xr = (const u32x2*)(x + (size_t)(m0 + i) * DM) + F.lane_();
#pragma unroll
            for (int j = 0; j < 4; ++j) raw[i][j] = xr[64 * j]; }
        __syncthreads();
        int my_e = 0; float my_ga = 0.f, my_gb = 0.f;
#pragma unroll
        for (int i = 0; i < 8; ++i) {
            const int m = m0 + i;
            f32x4 v[4];
#pragma unroll
            for (int j = 0; j < 4; ++j) v[j] = (f32x4){bf_lo(raw[i & 3][j].x), bf_hi(raw[i & 3][j].x), bf_lo(raw[i & 3][j].y), bf_hi(raw[i & 3][j].y)};
            if (i < 4) { const u32x2* xr = (const u32x2*)(x + (size_t)(m + 4) * DM) + F.lane_();
#pragma unroll
                for (int j = 0; j < 4; ++j) raw[i & 3][j] = xr[64 * j]; }
            const float rstd = row_rstd(v);
#pragma unroll
            for (int j = 0; j < 4; ++j) v[j] = v[j] * rstd * g[j];
            { unsigned char* hr = (unsigned char*)hn + (size_t)m * DM + 4 * F.lane_();
#pragma unroll
              for (int j = 0; j < 4; ++j) *(unsigned*)(hr + 256 * j) = pg8::pack_fp8x4(v[j].x, v[j].y, v[j].z, v[j].w, 1.0f); }
            f32x4 l0 = (f32x4){0.f, 0.f, 0.f, 0.f}, l1 = l0;
#pragma unroll
            for (int j = 0; j < 4; ++j)
#pragma unroll
                for (int z = 0; z < 4; ++z) { l0 += R[j][2 * z] * v[j][z]; l1 += R[j][2 * z + 1] * v[j][z]; }
            float lg[8] = {l0.x, l0.y, l0.z, l0.w, l1.x, l1.y, l1.z, l1.w};
            { const int ln = F.lane_(); const bool h5 = (ln & 32) != 0, h4 = (ln & 16) != 0, h3 = (ln & 8) != 0;
              float a4[4];
#pragma unroll
              for (int k = 0; k < 4; ++k) { const float keep = h5 ? lg[4 + k] : lg[k], give = h5 ? lg[k] : lg[4 + k]; a4[k] = keep + __shfl_xor(give, 32); }
              float a2[2];
#pragma unroll
              for (int k = 0; k < 2; ++k) { const float keep = h4 ? a4[2 + k] : a4[k], give = h4 ? a4[k] : a4[2 + k]; a2[k] = keep + __shfl_xor(give, 16); }
              float a1; { const float keep = h3 ? a2[1] : a2[0], give = h3 ? a2[0] : a2[1]; a1 = keep + __shfl_xor(give, 8); }
              a1 += __shfl_xor(a1, 4); a1 += __shfl_xor(a1, 2); a1 += __shfl_xor(a1, 1);
#pragma unroll
              for (int e = 0; e < 8; ++e) lg[e] = __shfl(a1, 8 * e); }
            int e1 = 0; float v1 = lg[0];
#pragma unroll
            for (int e = 1; e < 8; ++e) if (lg[e] > v1) { v1 = lg[e]; e1 = e; }
            int e2 = -1; float v2 = -3.4e38f;
#pragma unroll
            for (int e = 0; e < 8; ++e) if (e != e1 && lg[e] > v2) { v2 = lg[e]; e2 = e; }
            const float ex = __expf(v2 - v1), ga = 1.0f / (1.0f + ex), gb = ex * ga;
            const bool mine = F.lane_() == i;
            my_e = mine ? (e1 | (e2 << 8)) : my_e; my_ga = mine ? ga : my_ga; my_gb = mine ? gb : my_gb;
            if (i & 1) __builtin_amdgcn_sched_barrier(0);
        }
        if (F.lane_() < 8) { const int m = m0 + F.lane_(); e12[m] = my_e; g1o[m] = my_ga; g2o[m] = my_gb; atomicAdd((int*)&cnt[my_e & 255], 1); atomicAdd((int*)&cnt[my_e >> 8], 1); }
        __syncthreads();
        if (F.tid_() < 8) cnt_wg[ch * 8 + F.tid_()] = cnt[F.tid_()];
        __syncthreads();
    }
}
__device__ __forceinline__ void moe_assign(const Frame& F, const int* e12, const int* cnt_wg, int* p1o, int* p2o, int* panel, int* rowtok) {
    LAS int* psum = (LAS int*)F.lds;
    LAS int* tot = psum + 512; LAS int* base = tot + 8; LAS int* off = base + 8;
    LAS int* plist = off + 16;
    for (int ch = F.c; ch < MTOK / 64; ch += F.G) {
        { const int e = F.tid_() & 7, part = F.tid_() >> 3; int s = 0;
#pragma unroll
          for (int q = 0; q < 4; ++q) s += cnt_wg[(4 * part + q) * 8 + e];
          psum[part * 8 + e] = s; }
        __syncthreads();
        if (F.tid_() < 8) { const int e = F.tid_(); int t = 0, b = 0; for (int p = 0; p < 64; ++p) { const int s = psum[p * 8 + e]; if (p < (ch >> 2)) b += s; t += s; }
            for (int q = 0; q < (ch & 3); ++q) b += cnt_wg[(4 * (ch >> 2) + q) * 8 + e];
            tot[e] = t; base[e] = b; }
        __syncthreads();
        if (F.tid_() == 0) { int o = 0; for (int e = 0; e < 8; ++e) { off[e] = o; o += (tot[e] + 255) & ~255; } off[8] = o; }
        __syncthreads();
        if (F.wave_() == 0) {
            const int m = ch * 64 + F.lane_(); const int ee = e12[m]; const int e1 = ee & 255, e2 = ee >> 8; int p1 = 0, p2 = 0;
#pragma unroll
            for (int e = 0; e < 8; ++e) { const unsigned long long mk = __ballot(e1 == e || e2 == e); const int rk = __popcll(mk & ((1ull << F.lane_()) - 1ull));
                if (e1 == e) p1 = off[e] + base[e] + rk; if (e2 == e) p2 = off[e] + base[e] + rk; }
            p1o[m] = p1; p2o[m] = p2; rowtok[p1] = m; rowtok[p2] = m;
        }
        __syncthreads();
        if (ch < 8) { const int e = ch; for (int r = off[e] + tot[e] + F.tid_(); r < off[e + 1]; r += NWAVES * 64) rowtok[r] = 0; }
        if (ch == 0) { const int P_ = off[8] >> 8, U_ = 4 * P_, full_ = (U_ / F.G) * F.G, rem_ = U_ - full_;
            const int S_ = (!MOE_SPLIT || rem_ == 0) ? 1 : (rem_ * 7 <= F.G ? 7 : (rem_ * 4 <= F.G ? 4 : 1));
            if (F.tid_() == 0) { panel[0] = P_; panel[1] = full_; panel[2] = rem_; panel[3] = S_; }
            for (int L = F.tid_(); L < U_; L += NWAVES * 64) { int pm, pn; pg8::tile_order(P_, 4, L, pm, pn); panel[160 + pm * 4 + pn] = (S_ > 1 && L >= full_) ? L - full_ : -1; }
            if (F.tid_() < NPANEL_MAX) { const int r = F.tid_() * 256; int e = 0;
#pragma unroll
                for (int q = 1; q < 8; ++q) if (r >= off[q]) e = q;
                panel[4 + F.tid_()] = e; } }
        __syncthreads();
    }
}
__device__ __forceinline__ void moe_add_row(const Frame& F, f32x4 (&v)[4], const bf16_t* ys, const int pos, const float gt) {
    const u32x2* ya = (const u32x2*)(ys + (size_t)pos * DM) + F.lane_();
#pragma unroll
    for (int j = 0; j < 4; ++j) { const u32x2 a = ya[64 * j]; v[j].x += gt * bf_lo(a.x); v[j].y += gt * bf_hi(a.x); v[j].z += gt * bf_lo(a.y); v[j].w += gt * bf_hi(a.y); }
}
__device__ __forceinline__ void moe_reduce_parts(const Frame& F, const float* part, const int* panel, bf16_t* ys) {
    const int S = panel[3], rem = panel[2]; if (S <= 1) return;
    const int gw = F.c * NWAVES + F.wave_(), NGW = F.G * NWAVES;
    for (int it = gw; it < rem * 64; it += NGW) {
        const int q = it >> 6, r0 = (it & 63) * 4; int pm, pn; pg8::tile_order(panel[0], 4, panel[1] + q, pm, pn);
#pragma unroll
        for (int rr = 0; rr < 4; ++rr) {
            const float* pp = part + (size_t)q * S * 65536 + (size_t)(r0 + rr) * 256 + 4 * F.lane_(); f32x4 t[7];
#pragma unroll
            for (int ks = 0; ks < 7; ++ks) t[ks] = (ks < S) ? *(const f32x4*)(pp + (size_t)ks * 65536) : (f32x4){0.f, 0.f, 0.f, 0.f};
            const f32x4 s = ((t[0] + t[1]) + (t[2] + t[3])) + ((t[4] + t[5]) + t[6]);
            u32x2 w; w.x = cvt_pk_bf16(s.x, s.y); w.y = cvt_pk_bf16(s.z, s.w);
            *(u32x2*)(ys + (size_t)(pm * 256 + r0 + rr) * DM + pn * 256 + 4 * F.lane_()) = w;
        }
    }
}
__device__ __forceinline__ void moe_combine(const Frame& F, const bf16_t* x, const bf16_t* ys, const float* part, const int* panel, const int* p1, const int* p2, const float* g1, const float* g2, const float* gain, bf16_t* xo, bf16_t* hn, float* outf) {
    const int gw = F.c * NWAVES + F.wave_(), NGW = F.G * NWAVES, lane = F.lane_();
    f32x4 g[4]; load_row(gain, lane, g);
    for (int m0 = gw; m0 < MTOK; m0 += 2 * NGW) {
        const int m1 = (m0 + NGW < MTOK) ? m0 + NGW : m0; const bool two = m1 != m0;
        const int pa0 = p1[m0], pb0 = p2[m0], pa1 = p1[m1], pb1 = p2[m1]; const float ga0 = g1[m0], gb0 = g2[m0], ga1 = g1[m1], gb1 = g2[m1];
        f32x4 v[4], w[4]; load_row(x + (size_t)m0 * DM, lane, v); load_row(x + (size_t)m1 * DM, lane, w);
        u32x2 ya[4], yb[4], yc[4], yd[4];
        { const u32x2* a = (const u32x2*)(ys + (size_t)pa0 * DM) + lane; const u32x2* b = (const u32x2*)(ys + (size_t)pb0 * DM) + lane;
          const u32x2* c = (const u32x2*)(ys + (size_t)pa1 * DM) + lane; const u32x2* d = (const u32x2*)(ys + (size_t)pb1 * DM) + lane;
#pragma unroll
          for (int j = 0; j < 4; ++j) { ya[j] = a[64 * j]; yb[j] = b[64 * j]; yc[j] = c[64 * j]; yd[j] = d[64 * j]; } }
#pragma unroll
        for (int j = 0; j < 4; ++j) {
            v[j].x += ga0 * bf_lo(ya[j].x) + gb0 * bf_lo(yb[j].x); v[j].y += ga0 * bf_hi(ya[j].x) + gb0 * bf_hi(yb[j].x); v[j].z += ga0 * bf_lo(ya[j].y) + gb0 * bf_lo(yb[j].y); v[j].w += ga0 * bf_hi(ya[j].y) + gb0 * bf_hi(yb[j].y);
            w[j].x += ga1 * bf_lo(yc[j].x) + gb1 * bf_lo(yd[j].x); w[j].y += ga1 * bf_hi(yc[j].x) + gb1 * bf_hi(yd[j].x); w[j].z += ga1 * bf_lo(yc[j].y) + gb1 * bf_lo(yd[j].y); w[j].w += ga1 * bf_hi(yc[j].y) + gb1 * bf_hi(yd[j].y); }
        if (xo) { store_row_bf16(xo + (size_t)m0 * DM, lane, v); if (two) store_row_bf16(xo + (size_t)m1 * DM, lane, w); }
        const float rv = row_rstd(v), rw = row_rstd(w);
#pragma unroll
        for (int j = 0; j < 4; ++j) { v[j] = v[j] * rv * g[j]; w[j] = w[j] * rw * g[j]; }
        if (outf) { f32x4* o = (f32x4*)(outf + (size_t)m0 * DM) + lane; f32x4* o2 = (f32x4*)(outf + (size_t)m1 * DM) + lane;
#pragma unroll
            for (int j = 0; j < 4; ++j) { o[64 * j] = v[j]; if (two) o2[64 * j] = w[j]; } }
        else { store_row_fp8((unsigned char*)hn + (size_t)m0 * DM, lane, v); if (two) store_row_fp8((unsigned char*)hn + (size_t)m1 * DM, lane, w); }
    }
}


__global__ void __launch_bounds__(NWAVES * 64, 2) enc_fwd(Args args) {
    extern __shared__ __attribute__((aligned(16))) unsigned char lds_raw[];
    Frame F;
    F.lds = (LAS unsigned char*)lds_raw;
    F.G = gridDim.x; F.c = blockIdx.x; F.vcu = (F.G % 8 == 0) ? (F.c % 8) * (F.G / 8) + F.c / 8 : F.c;
    unsigned char* ws = args.ws;
    volatile LAS unsigned* MISC = (volatile LAS unsigned*)(F.lds + MISC_OFF);
    for (int u = F.tid_(); u < (LDS_BYTES - LDSCTL_OFF) / 4; u += NWAVES * 64) ((LAS unsigned*)(F.lds + LDSCTL_OFF))[u] = 0u;
    __syncthreads();
#if MK_MULTI
    #define GRID_BAR() do { } while (0)
#else
    XcdBarrier bar = xcd_barrier_post((unsigned*)(ws + WS_CTL) + CW_BAR, MISC + 8);
    #define GRID_BAR() xcd_barrier(bar)
#endif
    const int lo = args.ph_lo, hi = args.ph_hi;
#define IN(k) (lo <= (k) && (k) < hi)
#define SEAM(k) do { if (IN((k) + 1)) GRID_BAR(); } while (0)
#define PREP(k) ((((unsigned long long)(PROBE_MASK) >> (k)) & 1ull) ? PROBE_N : 1)
#define PH_BEGIN(k) if (IN(k)) { const unsigned long long t0_ = ((((unsigned long long)(SLOW_MASK)) >> (k)) & 1ull) ? wall_clock64() : 0ull; for (int rep_ = 0; rep_ < PREP(k); ++rep_) {
#define PH_END(k) } SEAM(k); if (((((unsigned long long)(SLOW_MASK)) >> (k)) & 1ull) ) { const unsigned long long t1_ = wall_clock64(), te_ = t1_ + 8ull * (t1_ - t0_); while (wall_clock64() < te_) __builtin_amdgcn_s_sleep(32); } }

    const float* x_in = args.in[0]; const float* rel_bias = args.in[1]; const float* norm_mix = args.in[2]; const float* norm_ffn = args.in[3]; const float* norm_final = args.in[4];
    bf16_t* Wb = (bf16_t*)(ws + WS_W);
    float* gtab = (float*)(ws + WS_TAB); float* misc = (float*)(ws + WS_MISC);
    int* r_e12 = (int*)(ws + WS_ROUTE); float* r_g1 = (float*)(ws + WS_ROUTE + 65536); float* r_g2 = (float*)(ws + WS_ROUTE + 2 * 65536);
    int* r_p1 = (int*)(ws + WS_ROUTE + 3 * 65536); int* r_p2 = (int*)(ws + WS_ROUTE + 4 * 65536);
    int* cnt_wg = (int*)(ws + WS_CNT); int* panel = (int*)(ws + WS_PANEL);
    bf16_t* XA = (bf16_t*)(ws + WS_XA); bf16_t* XB = (bf16_t*)(ws + WS_XB);
    bf16_t* HN = (bf16_t*)(ws + WS_HN); bf16_t* BUFA = (bf16_t*)(ws + WS_BUFA); bf16_t* BUFB = (bf16_t*)(ws + WS_BUFB); bf16_t* BUFC = (bf16_t*)(ws + WS_BUFC);
    bf16_t* BIG = (bf16_t*)(ws + WS_BIG); bf16_t* VT = (bf16_t*)(ws + WS_VT); bf16_t* OG = (bf16_t*)(ws + WS_OG); float* LSE = (float*)(ws + WS_LSE);
    int* rowtok = (int*)(ws + WS_ROUTE + 512 * 1024);
    bf16_t* YS = OG; float* PART = (float*)(ws + WS_PART); float* PS = (float*)(ws + WS_PS);
    LAS float* RTAB = (LAS float*)(F.lds + RING_BYTES + 1024);
    LAS unsigned char* ring = F.lds;
    unsigned char* X8 = (unsigned char*)HN;

#define PLAIN_GEMM(EPI, Aptr, Bptr, K_, lda_, ldb_, nM_, nN_, com_, con_) do { \
        PlainSched S_{(const char*)(Aptr), (const char*)(Bptr), (unsigned)(lda_), (unsigned)(ldb_), (nM_), (nN_), F.G, F.c, (size_t)(com_), (size_t)(con_)}; \
        pg8::gemm_phase(ring, (K_), (unsigned)(lda_), S_, EPI); } while (0)

#define DENSE_FFN(p, l, xr, xo) \
    PH_BEGIN(p) pg8::EpiSwiglu8T<true, 11, true> E_{(unsigned char*)BIG, DFF, PS, (const char*)(xr), RTAB}; PLAIN_GEMM(E_, (xr), Wb + W_F_GU + (size_t)(l) * 7168 * 1024, 1024, 2048, 2048, 64, 28, 256 * DFF, 128); PH_END(p) \
    PH_BEGIN((p) + 1) pg8::EpiResidT<false, true, 3> E_{(xr), (xo), PS, X8}; PlainSched S_{(const char*)BIG, (const char*)(Wb + W_F_D + (size_t)(l) * 3584 * 1024), 3584u, 3584u, 64, 4, F.G, F.c, (size_t)256 * DM, (size_t)256}; \
        pg8::gemm_phase<false, F8_DN>(ring, 1792, 3584u, S_, E_); PH_END((p) + 1)
#define DENSE_FFN8(p, l, xr, xo) \
    PH_BEGIN(p) pg8::EpiSwiglu8T<true> E_{(unsigned char*)BIG, DFF, PS, (const char*)X8, RTAB}; PlainSched S_{(const char*)X8, (const char*)(Wb + W_F_GU + (size_t)(l) * 7168 * 1024), 1024u, 1024u, 64, 28, F.G, F.c, (size_t)256 * DFF, (size_t)128}; \
        pg8::gemm_phase<false, F8_GU>(ring, 512, 1024u, S_, E_); PH_END(p) \
    PH_BEGIN((p) + 1) pg8::EpiResidT<false, true, 3> E_{(xr), (xo), PS, X8}; PlainSched S_{(const char*)BIG, (const char*)(Wb + W_F_D + (size_t)(l) * 3584 * 1024), 3584u, 3584u, 64, 4, F.G, F.c, (size_t)256 * DM, (size_t)256}; \
        pg8::gemm_phase<false, F8_DN>(ring, 1792, 3584u, S_, E_); PH_END((p) + 1)

#define MOE_FFN(p, l, xr, gain) \
    PH_BEGIN(p) moe_route(F, (xr), (gain), args.in[20] + (size_t)(l) * DM * NE, HN, r_e12, r_g1, r_g2, cnt_wg); PH_END(p) \
    PH_BEGIN((p) + 1) moe_assign(F, r_e12, cnt_wg, r_p1, r_p2, panel, rowtok); PH_END((p) + 1) \
    PH_BEGIN((p) + 2) pg8::EpiSwiglu8 E_{(unsigned char*)BIG, DFF, nullptr, nullptr, nullptr}; MoeSched S_{(const char*)HN, (const char*)(Wb + W_M_GU) + (size_t)(l) * 8 * 7168 * 1024, 1024u, 1024u, panel, (size_t)7168 * 1024, 28, F.G, F.c, (size_t)256 * DFF, (size_t)128, 0, rowtok}; \
        pg8::gemm_phase<true, F8_GU>(ring, 512, 1024u, S_, E_); PH_END((p) + 2) \
    PH_BEGIN((p) + 3) pg8::EpiYs8 E_{YS}; MoeDown8Sched S_{(const char*)BIG, (const char*)(Wb + W_M_D) + (size_t)(l) * 8 * 3584 * 1024, panel, F.G, F.c}; \
        pg8::gemm_phase<false, F8_DN>(ring, 1792, 3584u, S_, E_); \
        { pg8::EpiPart E2_{PART, F8_DN_UNSCALE}; MoeSplitSched S2_{(const char*)BIG, (const char*)(Wb + W_M_D) + (size_t)(l) * 8 * 3584 * 1024, panel, (size_t)3584 * 1024, F.c}; \
          const int sp_ = panel[3] > 1 ? panel[3] : 1; pg8::gemm_phase<false, F8_DN>(ring, DFF / sp_ / 2, 3584u, S2_, E2_); } PH_END((p) + 3)

    PH_BEGIN(0)
        LAS unsigned* scr = (LAS unsigned*)(F.lds + F.wave_() * 8448);
        const unsigned gw = (unsigned)(F.c * NWAVES + F.wave_()), NGW = (unsigned)(F.G * NWAVES);
        int jn = 0;
        for (unsigned it = gw; it < g_jobs.nitems; it += NGW) {
            while (jn + 1 < NJOBS && g_jobs.j[jn + 1].item0 <= it) ++jn;
            const Job& jb = g_jobs.j[jn];
            conv_item(jb, args.in[jb.in] + jb.src, Wb + jb.dst, args.in[7], jb.rk ? args.in[jb.rk] + jb.ridx : nullptr, scr, it - jb.item0, F.lane_());
        }
        for (int i = F.c * NWAVES * 64 + F.tid_(); i < 16 * 4096; i += F.G * NWAVES * 64) { const int h = i >> 12, idx = i & 4095; gtab[i] = rel_bias[rel_bucket(idx - 2048) * 16 + h] * LOG2E; }
        if (F.c == 1) for (int i = F.tid_(); i < 4096; i += NWAVES * 64) ((unsigned char*)(ws + WS_BID))[i] = (unsigned char)rel_bucket(i - 2048);
        if (F.c == 0 && F.tid_() == 0) { const float* lv = args.in[12]; float s0 = 0.f, s1 = 0.f; for (int i = 0; i < 64; ++i) { s0 += lv[i] * lv[64 + i]; s1 += lv[128 + i] * lv[192 + i]; }
            const float lam_init = 0.8f - 0.6f * expf(-0.3f * 2.0f); misc[0] = expf(s0) - expf(s1) + lam_init; misc[1] = lam_init; }
        rms_phase(F, x_in, norm_mix, HN);
        PH_END(0)
#if EXTRA_BARS
    for (int xb_ = 0; xb_ < EXTRA_BARS; ++xb_) GRID_BAR();
#endif
    PH_BEGIN(1) pg8::EpiBf16 E_{BUFA, DM, BUFA, DM, nullptr, nullptr, nullptr}; PLAIN_GEMM(E_, HN, Wb + W_A_IN, 1024, 2048, 2048, 64, 4, 256 * DM, 256); PH_END(1)
    PH_BEGIN(2)
        for (int it = F.c * NWAVES * 64 + F.tid_(); it < MTOK * 128; it += F.G * NWAVES * 64) {
            const int g = __builtin_amdgcn_readfirstlane((it >> 6) & 3), cc = g * 32 + (it & 31), t = ((it >> 8) << 1) + ((it >> 5) & 1), s = t & (SEQ - 1);
            const bf16_t* base = BUFA + (size_t)(t - s) * DM + cc * 8;
            float a[8] = {0, 0, 0, 0, 0, 0, 0, 0};
#define POOL_WIN(HW) do { u32x4 w_[2 * (HW)]; \
                _Pragma("unroll") for (int i = 0; i < 2 * (HW); ++i) { int r = s - (HW) + i; r = r < 0 ? 0 : (r > SEQ - 1 ? SEQ - 1 : r); w_[i] = *(const u32x4*)(base + (size_t)r * DM); } \
                _Pragma("unroll") for (int i = 0; i < 2 * (HW); ++i) { const int r = s - (HW) + i; const float k_ = (r >= 0 && r < SEQ) ? 1.0f : 0.0f; \
                    a[0] += k_ * bf_lo(w_[i].x); a[1] += k_ * bf_hi(w_[i].x); a[2] += k_ * bf_lo(w_[i].y); a[3] += k_ * bf_hi(w_[i].y); \
                    a[4] += k_ * bf_lo(w_[i].z); a[5] += k_ * bf_hi(w_[i].z); a[6] += k_ * bf_lo(w_[i].w); a[7] += k_ * bf_hi(w_[i].w); } } while (0)
            if (g == 0) POOL_WIN(1); else if (g == 1) POOL_WIN(2); else if (g == 2) POOL_WIN(4); else POOL_WIN(8);
#undef POOL_WIN
            const int hw = 1 << g, lo_ = (s - hw) < 0 ? 0 : s - hw, hi_ = (s + hw) > SEQ ? SEQ : s + hw;
            const float ic = 1.0f / (float)(hi_ - lo_); const u32x4 w = *(const u32x4*)(base + (size_t)s * DM);
            u32x4 o; o.x = cvt_pk_bf16(a[0] * ic - bf_lo(w.x), a[1] * ic - bf_hi(w.x)); o.y = cvt_pk_bf16(a[2] * ic - bf_lo(w.y), a[3] * ic - bf_hi(w.y));
            o.z = cvt_pk_bf16(a[4] * ic - bf_lo(w.z), a[5] * ic - bf_hi(w.z)); o.w = cvt_pk_bf16(a[6] * ic - bf_lo(w.w), a[7] * ic - bf_hi(w.w));
            *(u32x4*)(BUFB + (size_t)t * DM + cc * 8) = o;
        }
        PH_END(2)
    PH_BEGIN(3)
        struct GrpSched { const char* A; const char* B; int G, c;
            __device__ __forceinline__ bool next(int i, pg8::Unit& u) const { const int L = i * G + c; if (L >= 256) return false; int pm, pn; pg8::tile_order(64, 4, L, pm, pn);
                u.A = A + (size_t)pm * 256 * 2048 + pn * 512; u.B = B + (size_t)pn * 65536 * 2; u.ldb = 512u; u.hsb = 128u * 512u; u.co = (size_t)pm * 256 * DM + pn * 256; u.tag = 0; return true; } };
        GrpSched S_{(const char*)BUFB, (const char*)(Wb + W_A_GRP), F.G, F.c}; pg8::EpiBf16 E_{BUFC, DM, BUFC, DM, nullptr, nullptr, nullptr};
        pg8::gemm_phase(ring, 256, 2048u, S_, E_); PH_END(3)
    PH_BEGIN(4) pg8::EpiResidT<true, true> E_{x_in, XA, PS}; PLAIN_GEMM(E_, BUFC, Wb + W_A_OUT, 1024, 2048, 2048, 64, 4, 256 * DM, 256); PH_END(4)
    DENSE_FFN(6, 0, XA, XB)
    PH_BEGIN(9)
        { QkvSched S_{(const char*)X8, (const char*)(Wb + W_B_QK), nullptr, 24, 0, 4, 2, F.G, F.c, 6144, 1024u};
          pg8::EpiBf16T<true, 10, 2> E_{BIG, 6144, VT, MTOK, PS, (const char*)X8, RTAB, F8_GU_UNSCALE}; pg8::gemm_phase<false, 1u>(ring, 512, 1024u, S_, E_); }
        { QkvSched S_{(const char*)XB, nullptr, (const char*)(Wb + W_B_V), 0, 3, 4, 2, F.G, F.c, 6144};
          pg8::EpiBf16T<true, 11, 2> E_{BIG, 6144, VT, MTOK, PS, (const char*)XB, RTAB}; pg8::gemm_phase(ring, 1024, 2048u, S_, E_); }
        PH_END(9)
    PH_BEGIN(10)
        LAS float* tbl = (LAS float*)(F.lds + BI_TAB + F.wave_() * 1280); LAS unsigned char* stgw = F.lds + F.wave_() * 16384;
        int lane10 = F.lane_(); asm volatile("" : "+v"(lane10));
        for (int i = 0; i < 6; ++i) {
            const int w = (i * F.G + F.vcu) * NWAVES + F.wave_(); if (w >= 3 * 4096) break;
            const int g = w >> 12, rest = w & 4095, b = rest >> 9, h = (rest >> 5) & 15, blk = rest & 31;
            const int dil = (g == 0) ? 1 : (g == 1 ? 4 : 16), L = SEQ / dil, nqb = L >> 6, r = blk / nqb, qb = blk % nqb;
            band_item64q<64>((const unsigned char*)BIG + g * 1024 + h * 64, (const unsigned char*)BIG + 3072 + g * 1024 + h * 64, 6144, (size_t)b * SEQ + r, dil, L, qb * 64,
                            (const unsigned char*)VT + (size_t)(g * 1024 + h * 64) * MTOK, (size_t)b * SEQ + (size_t)r * L, gtab + h * 4096, tbl, stgw, NEG_BIG, 0.f,
                            OG + (size_t)g * MTOK * DM + h * 64, DM, LSE + (size_t)g * MTOK * 16 + h, lane10);
        }
        PH_END(10)
    PH_BEGIN(11)
        { const int st_ = F.G * NWAVES * 64;
        for (int it0 = F.c * NWAVES * 64 + F.tid_(); it0 < MTOK * 128; it0 += 4 * st_) {
            u32x4 a[4], b[4], c[4]; float l0[4], l1[4], l2[4]; size_t of[4]; bool ok[4];
#pragma unroll
            for (int q = 0; q < 4; ++q) { const int it = it0 + q * st_; ok[q] = it < MTOK * 128; const int itc = ok[q] ? it : it0; const int t = itc >> 7, cc = itc & 127, h = cc >> 3;
                l0[q] = LSE[(size_t)t * 16 + h]; l1[q] = LSE[(size_t)(MTOK + t) * 16 + h]; l2[q] = LSE[(size_t)(2 * MTOK + t) * 16 + h];
                of[q] = (size_t)t * DM + cc * 8;
                a[q] = *(const u32x4*)(OG + of[q]); b[q] = *(const u32x4*)(OG + (size_t)MTOK * DM + of[q]); c[q] = *(const u32x4*)(OG + 2 * (size_t)MTOK * DM + of[q]); }
#pragma unroll
            for (int q = 0; q < 4; ++q) {
                const float mx = fmaxf(l0[q], fmaxf(l1[q], l2[q])); float w0 = __builtin_amdgcn_exp2f(l0[q] - mx), w1 = __builtin_amdgcn_exp2f(l1[q] - mx), w2 = __builtin_amdgcn_exp2f(l2[q] - mx);
                const float inv = 1.0f / (w0 + w1 + w2); w0 *= inv; w1 *= inv; w2 *= inv;
                u32x4 r;
                r.x = cvt_pk_bf16(w0 * bf_lo(a[q].x) + w1 * bf_lo(b[q].x) + w2 * bf_lo(c[q].x), w0 * bf_hi(a[q].x) + w1 * bf_hi(b[q].x) + w2 * bf_hi(c[q].x));
                r.y = cvt_pk_bf16(w0 * bf_lo(a[q].y) + w1 * bf_lo(b[q].y) + w2 * bf_lo(c[q].y), w0 * bf_hi(a[q].y) + w1 * bf_hi(b[q].y) + w2 * bf_hi(c[q].y));
                r.z = cvt_pk_bf16(w0 * bf_lo(a[q].z) + w1 * bf_lo(b[q].z) + w2 * bf_lo(c[q].z), w0 * bf_hi(a[q].z) + w1 * bf_hi(b[q].z) + w2 * bf_hi(c[q].z));
                r.w = cvt_pk_bf16(w0 * bf_lo(a[q].w) + w1 * bf_lo(b[q].w) + w2 * bf_lo(c[q].w), w0 * bf_hi(a[q].w) + w1 * bf_hi(b[q].w) + w2 * bf_hi(c[q].w));
                if (ok[q]) *(u32x4*)(BUFA + of[q]) = r; }
        } }
        PH_END(11)
    PH_BEGIN(12) pg8::EpiResid E_{XB, XA, nullptr}; PLAIN_GEMM(E_, BUFA, Wb + W_B_OUT, 1024, 2048, 2048, 64, 4, 256 * DM, 256); PH_END(12)
    MOE_FFN(13, 0, XA, norm_ffn + DM)
    PH_BEGIN(17) moe_reduce_parts(F, PART, panel, YS); GRID_BAR(); moe_combine(F, XA, YS, PART, panel, r_p1, r_p2, r_g1, r_g2, norm_mix + 2 * DM, XB, HN, nullptr); PH_END(17)
    PH_BEGIN(18)
        QkvSched S_{(const char*)HN, (const char*)(Wb + W_C_QK), (const char*)(Wb + W_C_V), 8, 1, 4, 0, F.G, F.c, 2048, 1024u};
        pg8::EpiBf16T<false, 11, 1> E_{BIG, 2048, VT, MTOK, nullptr, nullptr, nullptr, F8_GU_UNSCALE}; pg8::gemm_phase<false, 1u>(ring, 512, 1024u, S_, E_); PH_END(18)
    PH_BEGIN(19)
        int tid = F.tid_(); asm volatile("" : "+v"(tid)); const int lane = tid & 63, wv = F.wave_();
        const int j = wv & 1, sub = wv >> 1, ql = lane & 31, hf = lane >> 5, kp = keyperm(ql), half1 = wv >> 2;
        LAS float* tabL = (LAS float*)(F.lds + DA_TAB);
        LAS unsigned char* bidL = F.lds + DA_BID;
        LAS float* xch = (LAS float*)(F.lds + DA_XCH);
        const float lam = misc[0], post = 1.0f - misc[1];
        i32x8 ones8; { int o1_ = 0x38383838; asm volatile("" : "+v"(o1_));
#pragma unroll
            for (int q = 0; q < 8; ++q) ones8[q] = o1_; }
        for (int q = tid; q < 1024; q += NWAVES * 64) ((LAS unsigned*)bidL)[q] = ((const unsigned*)(ws + WS_BID))[q];
        unsigned ka[2], va[2];
#pragma unroll
        for (int t = 0; t < 2; ++t) { ka[t] = (unsigned)(kp * 64 + (((2 * hf + t) ^ ((kp >> 2) & 3)) << 4)); va[t] = (unsigned)(ql * 64 + (((2 * hf + t) ^ ((ql >> 2) & 3)) << 4)); }
        const int kr = 16 * (wv & 3) + (lane >> 2), kc = (lane & 3) ^ ((kr >> 2) & 3);
        const int vr = 16 * wv + (lane >> 2), vc = (lane & 3) ^ ((vr >> 2) & 3);
        const unsigned koff = (unsigned)((wv >> 2) * 64 + kr * 2048 + kc * 16), voff = (unsigned)vr * (unsigned)MTOK + (unsigned)(vc * 16);
#define pk8(a_, b_, c_, d_) ((unsigned)__builtin_amdgcn_cvt_pk_fp8_f32((c_), (d_), __builtin_amdgcn_cvt_pk_fp8_f32((a_), (b_), 0, false), true))
#define DA_GLDS(g, l) __builtin_amdgcn_global_load_lds((const unsigned*)(g), (LAS unsigned*)(l), 16, 0, 0)
#define DA_ISSUE(tile, stage) do { LAS unsigned char* sb_ = F.lds + DA_STG + (stage) * 32768 + wv * 1024; const size_t kt_ = (size_t)(tile) * 64; \
            DA_GLDS(K0g + kt_ * 2048 + koff, sb_); DA_GLDS(Vg + kt_ + voff, sb_ + 16384); } while (0)
#define DA_BAR() do { __builtin_amdgcn_s_barrier(); asm volatile("" ::: "memory"); } while (0)
#define DA_WAIT_TILE(more) do { if (more) asm volatile("s_waitcnt vmcnt(2) lgkmcnt(0)" ::: "memory"); else asm volatile("s_waitcnt vmcnt(0) lgkmcnt(0)" ::: "memory"); } while (0)
#define DA_WAIT_LDS() asm volatile("s_waitcnt lgkmcnt(0)" ::: "memory")
#define DA_SEG_A(t_, sg_) do { \
            const LAS unsigned char* Kt = F.lds + DA_STG + (sg_) * 32768 + j * 4096; \
            const int kt = (t_) * 64, rel_lo = kt - q0 - 31, rel_hi = kt + 63 - q0; \
            const i32x8 kfa = __builtin_shufflevector(*(const LAS i32x4*)(Kt + ka[0]), *(const LAS i32x4*)(Kt + ka[1]), 0, 1, 2, 3, 4, 5, 6, 7); \
            const i32x8 kfb = __builtin_shufflevector(*(const LAS i32x4*)(Kt + 2048 + ka[0]), *(const LAS i32x4*)(Kt + 2048 + ka[1]), 0, 1, 2, 3, 4, 5, 6, 7); \
            const bool cst = (rel_lo > 0 || rel_hi < 0) && (__builtin_amdgcn_readfirstlane((int)bidL[rel_lo + 2048]) == __builtin_amdgcn_readfirstlane((int)bidL[rel_hi + 2048])); \
            if (cst) { const float cu = tabL[j * 4096 + rel_lo + 2048]; \
                { const float c = cu - mhat; \
                  if (__any(c != c_last)) { c_last = c; \
                    _Pragma("unroll") for (int r = 0; r < 16; ++r) ci[r] = c; } } \
                asm volatile("s_waitcnt lgkmcnt(0)" ::: "memory"); \
                s0 = __builtin_amdgcn_mfma_scale_f32_32x32x64_f8f6f4(kfa, qf, ci, 0, 0, 0, 0, 0, 0); s1 = __builtin_amdgcn_mfma_scale_f32_32x32x64_f8f6f4(kfb, qf, ci, 0, 0, 0, 0, 0, 0); } \
            else { const LAS float* bt = tabL + j * 4096 + kt + 8 * hf - (q0 + ql) + 2048; \
                _Pragma("unroll") for (int r = 0; r < 16; ++r) { s0[r] = bt[(r >> 3) * 16 + (r & 7)] - mhat; s1[r] = bt[32 + (r >> 3) * 16 + (r & 7)] - mhat; } \
                asm volatile("s_waitcnt lgkmcnt(0)" ::: "memory"); \
                s0 = __builtin_amdgcn_mfma_scale_f32_32x32x64_f8f6f4(kfa, qf, s0, 0, 0, 0, 0, 0, 0); s1 = __builtin_amdgcn_mfma_scale_f32_32x32x64_f8f6f4(kfb, qf, s1, 0, 0, 0, 0, 0, 0); } \
            float mx = __builtin_fmaxf(s0[0], s1[0]), mx2 = __builtin_fmaxf(s0[1], s1[1]); \
            _Pragma("unroll") for (int r = 2; r < 16; r += 2) { mx = __builtin_fmaxf(__builtin_fmaxf(mx, s0[r]), s1[r]); mx2 = __builtin_fmaxf(__builtin_fmaxf(mx2, s0[r + 1]), s1[r + 1]); } \
            mx = __builtin_fmaxf(mx, mx2); \
            { const unsigned mu = __float_as_uint(mx); auto rr2 = __builtin_amdgcn_permlane32_swap(mu, mu, false, false); mx = fmaxf(__uint_as_float(rr2[0]), __uint_as_float(rr2[1])); } \
            if ((t_) == 0) { const float d0 = mx - 4.0f; mhat = d0; \
                _Pragma("unroll") for (int r = 0; r < 16; ++r) { s0[r] -= d0; s1[r] -= d0; } } \
            else if (__any(mx > 8.0f)) { const float dl = fmaxf(mx - 4.0f, 0.f), f = __builtin_amdgcn_exp2f(-dl); mhat += dl; o5 = o5 * f; \
                _Pragma("unroll") for (int r = 0; r < 16; ++r) { s0[r] -= dl; s1[r] -= dl; } \
                _Pragma("unroll") for (int bb = 0; bb < 4; ++bb) o[bb] = o[bb] * f; } \
        } while (0)
#define DA_SEG_B(sg_) do { \
            const LAS unsigned char* Vt_ = F.lds + DA_STG + (sg_) * 32768 + 16384; i32x8 vf8[4]; \
            _Pragma("unroll") for (int bb = 0; bb < 4; ++bb) { const i32x4 lo_ = *(const LAS i32x4*)(Vt_ + bb * 2048 + va[0]), hi_ = *(const LAS i32x4*)(Vt_ + bb * 2048 + va[1]); \
                vf8[bb] = __builtin_shufflevector(lo_, hi_, 0, 1, 2, 3, 4, 5, 6, 7); } \
            asm volatile("" ::: "memory"); \
            _Pragma("unroll") for (int r = 0; r < 16; ++r) { s0[r] = __builtin_amdgcn_exp2f(s0[r]); s1[r] = __builtin_amdgcn_exp2f(s1[r]); } \
            i32x8 p8; p8[0] = (int)pk8(s0[0], s0[1], s0[2], s0[3]); p8[1] = (int)pk8(s0[4], s0[5], s0[6], s0[7]); p8[2] = (int)pk8(s0[8], s0[9], s0[10], s0[11]); p8[3] = (int)pk8(s0[12], s0[13], s0[14], s0[15]); \
            p8[4] = (int)pk8(s1[0], s1[1], s1[2], s1[3]); p8[5] = (int)pk8(s1[4], s1[5], s1[6], s1[7]); p8[6] = (int)pk8(s1[8], s1[9], s1[10], s1[11]); p8[7] = (int)pk8(s1[12], s1[13], s1[14], s1[15]); \
            __builtin_amdgcn_s_setprio(1); \
            _Pragma("unroll") for (int bb = 0; bb < 4; ++bb) o[bb] = __builtin_amdgcn_mfma_scale_f32_32x32x64_f8f6f4(vf8[bb], p8, o[bb], 0, 0, 0, 0, 0, 0); \
            o5 = __builtin_amdgcn_mfma_scale_f32_32x32x64_f8f6f4(ones8, p8, o5, 0, 0, 0, 0, 0, 0);         \
            __builtin_amdgcn_s_setprio(0); \
        } while (0)
        int last_h = -1;
        for (int i = 0; i < 4; ++i) {
            const int u = i * F.G + F.vcu; if (u >= 1024) break;
            const int b = u >> 7, h = (u >> 4) & 7, qblk = u & 15;
            __syncthreads();
            if (h != last_h) { for (int q = tid; q < 2 * 4096; q += NWAVES * 64) tabL[q] = gtab[(2 * h) * 4096 + q]; last_h = h; }
            const size_t tok0 = (size_t)b * SEQ; const int q0 = qblk * 128 + sub * 32;
            const char* K0g = (const char*)BIG + tok0 * 2048 + 1024 + (2 * h) * 64;
            const char* Vg = (const char*)VT + (size_t)(h * 128) * MTOK + tok0;
            const size_t qtok = tok0 + q0 + ql;
            i32x8 qf; { const i32x4* qp_ = (const i32x4*)((const char*)BIG + qtok * 2048 + (2 * h + j) * 64 + 32 * hf); qf = __builtin_shufflevector(qp_[0], qp_[1], 0, 1, 2, 3, 4, 5, 6, 7); }
            DA_ISSUE(0, 0); DA_ISSUE(1, 1);
            f32x16 o[4];
#pragma unroll
            for (int bb = 0; bb < 4; ++bb) o[bb] = (f32x16){};
            float mhat = 0.f, c_last = __builtin_nanf("");
            f32x16 o5 = (f32x16){}, ci = (f32x16){};
            f32x16 s0, s1;
            DA_WAIT_TILE(true); DA_BAR();
            if (half1 == 0) {
                int sg = 0;
                for (int t = 0; t < 32; ++t) {
                    DA_SEG_A(t, sg); DA_WAIT_LDS(); DA_BAR();
                    if (t + 2 < 32) { const int s2 = (sg >= 1) ? sg - 1 : 2; DA_ISSUE(t + 2, s2); }
                    DA_SEG_B(sg); DA_WAIT_TILE(t + 2 < 32); DA_BAR();
                    sg = (sg == 2) ? 0 : sg + 1;
                }
                DA_BAR();
            } else {
                DA_BAR();
                int sg = 0;
                for (int t = 0; t < 32; ++t) {
                    if (t + 2 < 32) { const int s2 = (sg >= 1) ? sg - 1 : 2; DA_ISSUE(t + 2, s2); }
                    DA_SEG_A(t, sg); DA_WAIT_TILE(t + 2 < 32); DA_BAR();
                    DA_SEG_B(sg); DA_WAIT_LDS(); DA_BAR();
                    sg = (sg == 2) ? 0 : sg + 1;
                }
            }
            const float lt = o5[0], inv = (1.0f / ACT8_SCALE) / lt;
            __syncthreads();
            if (j == 1) {
#pragma unroll
                for (int bb = 0; bb < 4; ++bb)
#pragma unroll
                    for (int r = 0; r < 16; ++r) xch[(sub * 64 + bb * 16 + r) * 64 + lane] = o[bb][r] * inv;
            }
            __syncthreads();
            if (j == 0) {
                float ss = 0.f;
#pragma unroll
                for (int bb = 0; bb < 4; ++bb)
#pragma unroll
                    for (int r = 0; r < 16; ++r) { const float v = o[bb][r] * inv - lam * xch[(sub * 64 + bb * 16 + r) * 64 + lane]; o[bb][r] = v; ss += v * v; }
                ss += __shfl_xor(ss, 32);
                const float rstd = post / sqrtf(ss * (1.0f / 128.0f) + RMS_EPS);
                const float* sg_ = args.in[13];
                unsigned char* orow = (unsigned char*)BUFA + qtok * DM + h * 128;
                const float rs8 = rstd * ACT8_SCALE;
#pragma unroll
                for (int bb = 0; bb < 4; ++bb)
#pragma unroll
                    for (int i4 = 0; i4 < 4; ++i4) { const int d = 32 * bb + 8 * i4 + 4 * hf; const f32x4 gg = *(const f32x4*)(sg_ + d);
                        *(unsigned*)(orow + d) = pg8::pack_fp8x4(o[bb][4 * i4] * gg.x, o[bb][4 * i4 + 1] * gg.y, o[bb][4 * i4 + 2] * gg.z, o[bb][4 * i4 + 3] * gg.w, rs8); }
            }
        }
#undef DA_GLDS
#undef DA_ISSUE
#undef DA_BAR
#undef DA_WAIT_TILE
#undef DA_WAIT_LDS
#undef DA_SEG_A
#undef DA_SEG_B
        PH_END(19)
    PH_BEGIN(20) pg8::EpiResidT<false, true, 3> E_{XB, XA, PS, X8}; PlainSched S_{(const char*)BUFA, (const char*)(Wb + W_C_OUT), 1024u, 1024u, 64, 4, F.G, F.c, (size_t)256 * DM, (size_t)256}; pg8::gemm_phase<false, 1u>(ring, 512, 1024u, S_, E_); PH_END(20)
    DENSE_FFN8(22, 1, XA, XB)
    PH_BEGIN(25)
        QkvSched S_{(const char*)X8, (const char*)(Wb + W_D_QK), (const char*)(Wb + W_D_V), 5, 1, 1, 0, F.G, F.c, 1280, 1024u};
        pg8::EpiBf16T<true, 10, 2> E_{BIG, 1280, VT, MTOK, PS, (const char*)X8, RTAB, F8_GU_UNSCALE}; pg8::gemm_phase<false, 1u>(ring, 512, 1024u, S_, E_); PH_END(25)
    PH_BEGIN(26)
        LAS float* tbl = (LAS float*)(F.lds + BI_TAB + F.wave_() * 1280); LAS unsigned char* stgw = F.lds + F.wave_() * 16384;
        const float* sink = args.in[16];
        int lane26 = F.lane_(); asm volatile("" : "+v"(lane26));
        for (int i = 0; i < 2; ++i) {
            const int w = (i * F.G + F.vcu) * NWAVES + F.wave_(); if (w >= 4096) break;
            const int b = w >> 9, kvh = (w >> 7) & 3, qb = (w >> 2) & 31, qh = kvh * 4 + (w & 3);
            band_item64q<128, true>((const unsigned char*)BIG + qh * 64, (const unsigned char*)BIG + 1024 + kvh * 64, 1280, (size_t)b * SEQ, 1, SEQ, qb * 64,
                             (const unsigned char*)VT + (size_t)(kvh * 64) * MTOK, (size_t)b * SEQ, gtab + qh * 4096, tbl, stgw, sink[qh] * LOG2E, 1.0f,
                             (bf16_t*)((unsigned char*)BUFA + qh * 64), DM, nullptr, lane26);
        }
        PH_END(26)
    PH_BEGIN(27) pg8::EpiResidT<false, false, 2> E_{XB, XA, nullptr, nullptr}; PlainSched S_{(const char*)BUFA, (const char*)(Wb + W_D_OUT), 1024u, 1024u, 64, 4, F.G, F.c, (size_t)256 * DM, (size_t)256}; pg8::gemm_phase<false, 1u>(ring, 512, 1024u, S_, E_); PH_END(27)
    MOE_FFN(28, 1, XA, norm_ffn + 3 * DM)
    PH_BEGIN(32) moe_reduce_parts(F, PART, panel, YS); GRID_BAR(); moe_combine(F, XA, YS, PART, panel, r_p1, r_p2, r_g1, r_g2, norm_final, nullptr, nullptr, args.out); } }
#undef IN
#undef SEAM
}
constexpr int N_PHASES = 33;

extern "C" void kernel_launch(void* const* d_in, const int* in_sizes, int n_in, void* d_out, int out_size, void* d_ws, size_t ws_size, hipStream_t stream) {
    static int grid = 0;
    if (grid == 0) {
        if (n_in != 23 || out_size != MTOK * DM || ws_size < WS_END) { fprintf(stderr, "kernel_launch: unexpected problem (n_in %d, out %d, ws %zu, need %zu)\n", n_in, out_size, ws_size, (size_t)WS_END); grid = -1; return; }
        int dev = 0, cus = 0, per_cu = 0;
        if (hipGetDevice(&dev) != hipSuccess || hipDeviceGetAttribute(&cus, hipDeviceAttributeMultiprocessorCount, dev) != hipSuccess) { grid = -1; return; }
        if (hipFuncSetAttribute((const void*)enc_fwd, hipFuncAttributeMaxDynamicSharedMemorySize, LDS_BYTES) != hipSuccess) { fprintf(stderr, "kernel_launch: hipFuncSetAttribute failed\n"); grid = -1; return; }
        if (hipOccupancyMaxActiveBlocksPerMultiprocessor(&per_cu, (const void*)enc_fwd, NWAVES * 64, LDS_BYTES) != hipSuccess || per_cu < 1)
            fprintf(stderr, "kernel_launch: occupancy query reports %d workgroups per CU\n", per_cu);
        (void)hipGetLastError();
        grid = cus;
    }
    if (grid < 0) return;
    if (hipMemsetAsync((char*)d_ws + WS_CTL, 0, CTL_ZERO_BYTES, stream) != hipSuccess) return;
    Args a{};
    for (int i = 0; i < 23; ++i) a.in[i] = (const float*)d_in[i];
    a.out = (float*)d_out; a.ws = (unsigned char*)d_ws;
#if MK_MULTI
    for (int p = 0; p < N_PHASES; ++p) { a.ph_lo = p; a.ph_hi = p + 1; hipLaunchKernelGGL(enc_fwd, dim3(grid), dim3(NWAVES * 64), LDS_BYTES, stream, a); }
#else
    a.ph_lo = 0; a.ph_hi = N_PHASES;
    hipLaunchKernelGGL(enc_fwd, dim3(grid), dim3(NWAVES * 64), LDS_BYTES, stream, a);
#endif
}
```
